# Optimizing an MI355X kernel written in HIP

```python
import math
import jax
import jax.numpy as jnp
from jax import lax
import numpy as np

D_MODEL = 2048
BATCH = 2
SEQ = 4096
DEPTH = 4
DEC_BATCH = 8
DEC_SEQ = 8
PAST_LEN = 16384
PAGE_SIZE = 128

ATT_HEADS = 8
ATT_HEAD_DIM = 128
ATT_WIDTH = ATT_HEADS * ATT_HEAD_DIM
DILATED_PATTERNS = ((128, 1), (512, 4), (2048, 16))
ATT_WINDOW_MAX = 2048
ATT_BLOCK = 128
ATT_SCALE = ATT_HEAD_DIM ** -0.5
N_REL_BUCKETS = 32
REL_MAX_DIST = 2048
SSM_WIDTH = 512
SSM_GROUP = 16
SSM_GROUPS = SSM_WIDTH // SSM_GROUP
SSM_STATE = 64
SGU_WIDTH = 512
SGU_HEADS = 4
SGU_HEAD_DIM = SGU_WIDTH // SGU_HEADS
SGU_CHUNK = 128
MIX_WIDTH = ATT_WIDTH + SSM_WIDTH + SGU_WIDTH
IN_COLS = 3 * ATT_WIDTH + SSM_WIDTH + 2 * SGU_WIDTH
FFN_HIDDEN = -((-8 * D_MODEL) // (3 * 256)) * 256
EPS = 1e-6
NEG_INF = -1e30

kernel_name = 'hybrid_dilated_s5_gmlp_decoder_step'


def rmsnorm(x, g):
    xf = x.astype(jnp.float32)
    y = xf * lax.rsqrt(jnp.mean(xf * xf, axis=-1, keepdims=True) + EPS)
    return (y * g.astype(jnp.float32)).astype(x.dtype)


def layernorm_gain(x, g):
    xf = x.astype(jnp.float32)
    xc = xf - jnp.mean(xf, axis=-1, keepdims=True)
    y = xc * lax.rsqrt(jnp.mean(xc * xc, axis=-1, keepdims=True) + EPS)
    return (y * g.astype(jnp.float32)).astype(x.dtype)


def t5_bucket(dist):
    max_exact = N_REL_BUCKETS // 2
    df = jnp.maximum(dist, 1).astype(jnp.float32)
    large = max_exact + (jnp.log(df / max_exact) / math.log(REL_MAX_DIST / max_exact)
                         * (N_REL_BUCKETS - max_exact)).astype(jnp.int32)
    large = jnp.minimum(large, N_REL_BUCKETS - 1)
    return jnp.where(dist < max_exact, dist, large)


def strided_bias(rel_bias, dilation, n_steps):
    dist = jnp.arange(n_steps + 1, dtype=jnp.int32) * dilation
    return rel_bias[t5_bucket(dist)].astype(jnp.float32)


def mix_by_denominators(outs, lses):
    wts = jax.nn.softmax(jnp.stack(lses, axis=0), axis=0)
    return sum(wts[i][..., None] * outs[i].astype(jnp.float32) for i in range(len(outs)))


def dilated_attn_prompt(q, k, v, rel_bias):
    N, L, H, E = q.shape
    QB = ATT_BLOCK
    outs, lses = [], []
    for window, d in DILATED_PATTERNS:
        nk = window // d
        Ls = L // d
        Lp = -(-Ls // QB) * QB
        nb = Lp // QB

        def sub(t):
            t = t.reshape(N, Ls, d, H, E)
            return jnp.pad(t, ((0, 0), (0, Lp - Ls), (0, 0), (0, 0), (0, 0)))

        def band(t):
            t = jnp.pad(t, ((0, 0), (QB, 0), (0, 0), (0, 0), (0, 0))).reshape(N, nb + 1, QB, d, H, E)
            return jnp.concatenate([t[:, :-1], t[:, 1:]], axis=2)

        qb = sub(q).reshape(N, nb, QB, d, H, E)
        kb, vb = band(sub(k)), band(sub(v))
        s = jnp.einsum('nbqrhe,nbkrhe->nbrhqk', qb, kb).astype(jnp.float32) * ATT_SCALE
        qi = jnp.arange(QB)[:, None]
        kj = jnp.arange(2 * QB)[None, :]
        delta = QB + qi - kj
        band_ok = (delta >= 0) & (delta <= nk)
        blk = jnp.arange(nb)[:, None, None]
        valid = band_ok[None] & ((blk > 0) | (kj[None] >= QB))
        bias = strided_bias(rel_bias, d, nk)[jnp.clip(delta, 0, nk)]
        s = s + jnp.transpose(bias, (2, 0, 1))[None, None, None]
        s = jnp.where(valid[None, :, None, None], s, NEG_INF)
        lse = jax.nn.logsumexp(s, axis=-1)
        p = jnp.exp(s - lse[..., None])
        o = jnp.einsum('nbrhqk,nbkrhe->nbqrhe', p.astype(vb.dtype), vb)
        o = o.reshape(N, Lp, d, H, E)[:, :Ls].reshape(N, L, H, E)
        lse = jnp.transpose(lse, (0, 1, 4, 2, 3)).reshape(N, Lp, d, H)[:, :Ls].reshape(N, L, H)
        outs.append(o)
        lses.append(lse)
    return mix_by_denominators(outs, lses)


def dilated_attn_sample(q, k_all, v_all, rel_bias):
    N, T, H, E = q.shape
    W = k_all.shape[1] - T
    outs, lses = [], []
    for window, d in DILATED_PATTERNS:
        nk = window // d
        j = jnp.arange(nk + 1)
        idx = W + jnp.arange(T)[:, None] - j[None, :] * d
        valid = idx >= 0
        idxc = jnp.maximum(idx, 0)
        kg = k_all[:, idxc]
        vg = v_all[:, idxc]
        s = jnp.einsum('nthe,ntjhe->nthj', q, kg).astype(jnp.float32) * ATT_SCALE
        s = s + strided_bias(rel_bias, d, nk).T[None, None]
        s = jnp.where(valid[None, :, None, :], s, NEG_INF)
        lse = jax.nn.logsumexp(s, axis=-1)
        p = jnp.exp(s - lse[..., None])
        outs.append(jnp.einsum('nthj,ntjhe->nthe', p.astype(vg.dtype), vg))
        lses.append(lse)
    return mix_by_denominators(outs, lses)


def s5_scan(u, h0_re, h0_im, lam_re, lam_im, log_step, b_re, b_im, c_re, c_im, d_skip):
    f32 = jnp.float32
    u = u.astype(f32)
    lam_re = lam_re.astype(f32)
    lam_im = lam_im.astype(f32)
    step = jnp.exp(log_step.astype(f32))[:, None]
    mag = jnp.exp(lam_re * step)
    a_re = mag * jnp.cos(lam_im * step)
    a_im = mag * jnp.sin(lam_im * step)
    den = lam_re * lam_re + lam_im * lam_im
    coef_re = ((a_re - 1.0) * lam_re + a_im * lam_im) / den
    coef_im = (a_im * lam_re - (a_re - 1.0) * lam_im) / den
    b_re = b_re.astype(f32)
    b_im = b_im.astype(f32)
    bb_re = coef_re[..., None] * b_re - coef_im[..., None] * b_im
    bb_im = coef_re[..., None] * b_im + coef_im[..., None] * b_re
    x_re = jnp.einsum('nlgc,gpc->nlgp', u, bb_re)
    x_im = jnp.einsum('nlgc,gpc->nlgp', u, bb_im)
    h0_re = h0_re.astype(f32)
    h0_im = h0_im.astype(f32)
    x_re = x_re.at[:, 0].add(a_re * h0_re - a_im * h0_im)
    x_im = x_im.at[:, 0].add(a_re * h0_im + a_im * h0_re)
    ar = jnp.broadcast_to(a_re, x_re.shape)
    ai = jnp.broadcast_to(a_im, x_im.shape)

    def combine(e1, e2):
        a1r, a1i, b1r, b1i = e1
        a2r, a2i, b2r, b2i = e2
        return (a1r * a2r - a1i * a2i, a1r * a2i + a1i * a2r,
                a2r * b1r - a2i * b1i + b2r, a2r * b1i + a2i * b1r + b2i)

    _, _, h_re, h_im = lax.associative_scan(combine, (ar, ai, x_re, x_im), axis=1)
    y = (jnp.einsum('gcp,nlgp->nlgc', c_re.astype(f32), h_re)
         - jnp.einsum('gcp,nlgp->nlgc', c_im.astype(f32), h_im))
    y = y + d_skip.astype(f32).reshape(SSM_GROUPS, SSM_GROUP) * u
    return y, h_re[:, -1], h_im[:, -1]


def chunk_sgu(u, v, w_sp, b_sp):
    N, L = u.shape[:2]
    Lp = -(-L // SGU_CHUNK) * SGU_CHUNK
    vp = jnp.pad(v, ((0, 0), (0, Lp - L), (0, 0), (0, 0)))
    vc = vp.reshape(N, Lp // SGU_CHUNK, SGU_CHUNK, SGU_HEADS, SGU_HEAD_DIM)
    causal = jnp.tril(jnp.ones((SGU_CHUNK, SGU_CHUNK), w_sp.dtype))
    mixed = jnp.einsum('hts,ncshe->ncthe', w_sp * causal, vc) + b_sp.T[None, None, :, :, None]
    mixed = mixed.reshape(N, Lp, SGU_HEADS, SGU_HEAD_DIM)[:, :L]
    return u * mixed


def trunk_layer(x, p, rel_bias, cache_k=None, cache_v=None, h_re=None, h_im=None):
    N, L, _ = x.shape
    h = rmsnorm(x, p['g_pre_mix'])
    z = h @ p['w_in']
    A = ATT_WIDTH
    q = z[..., :A].reshape(N, L, ATT_HEADS, ATT_HEAD_DIM)
    k = z[..., A:2 * A].reshape(N, L, ATT_HEADS, ATT_HEAD_DIM)
    v = z[..., 2 * A:3 * A].reshape(N, L, ATT_HEADS, ATT_HEAD_DIM)
    o0 = 3 * A
    u_ssm = z[..., o0:o0 + SSM_WIDTH]
    u_sgu = z[..., o0 + SSM_WIDTH:o0 + SSM_WIDTH + SGU_WIDTH]
    v_sgu = z[..., o0 + SSM_WIDTH + SGU_WIDTH:]
    if cache_k is None:
        o_att = dilated_attn_prompt(q, k, v, rel_bias)
        n_keep = min(ATT_WINDOW_MAX, L)
        new_k, new_v = k[:, L - n_keep:], v[:, L - n_keep:]
        h_re = jnp.zeros((N, SSM_GROUPS, SSM_STATE), jnp.float32)
        h_im = jnp.zeros((N, SSM_GROUPS, SSM_STATE), jnp.float32)
    else:
        k_all = jnp.concatenate([cache_k.astype(k.dtype), k], axis=1)
        v_all = jnp.concatenate([cache_v.astype(v.dtype), v], axis=1)
        o_att = dilated_attn_sample(q, k_all, v_all, rel_bias)
        new_k, new_v = k, v
    o_att = o_att.reshape(N, L, ATT_WIDTH).astype(x.dtype)
    y_ssm, hr, hi = s5_scan(u_ssm.reshape(N, L, SSM_GROUPS, SSM_GROUP), h_re, h_im,
                            p['ssm_lam_re'], p['ssm_lam_im'], p['ssm_log_step'],
                            p['ssm_b_re'], p['ssm_b_im'], p['ssm_c_re'], p['ssm_c_im'], p['ssm_d'])
    y_ssm = y_ssm.reshape(N, L, SSM_WIDTH)
    o_ssm = y_ssm * jax.nn.sigmoid(y_ssm @ p['ssm_w_glu'].astype(jnp.float32)
                                   + p['ssm_b_glu'].astype(jnp.float32))
    o_ssm = o_ssm.astype(x.dtype)
    gu = jax.nn.gelu(u_sgu)
    gv = layernorm_gain(jax.nn.gelu(v_sgu), p['sgu_g'])
    o_sgu = chunk_sgu(gu.reshape(N, L, SGU_HEADS, SGU_HEAD_DIM),
                      gv.reshape(N, L, SGU_HEADS, SGU_HEAD_DIM),
                      p['sgu_w'], p['sgu_b']).reshape(N, L, SGU_WIDTH)
    g = p['g_mix_out']
    mixed = jnp.concatenate([rmsnorm(o_att, g[:A]),
                             rmsnorm(o_ssm, g[A:A + SSM_WIDTH]),
                             rmsnorm(o_sgu, g[A + SSM_WIDTH:])], axis=-1)
    x = x + rmsnorm(mixed @ p['w_out'], p['g_post_mix'])
    h = rmsnorm(x, p['g_pre_ffn'])
    f = (jax.nn.silu(h @ p['w_gate']) * (h @ p['w_up'])) @ p['w_down']
    x = x + rmsnorm(f, p['g_post_ffn'])
    return x, (new_k, new_v, hr, hi, gv)


def setup_inputs(seed: int = 0) -> dict:
    key = jax.random.key(seed)
    k = jax.random.split(key, 30)
    f32 = jnp.float32

    def nrm(kk, shape, scale):
        return jax.random.normal(kk, shape, f32) * scale

    def gain(kk, shape):
        return 1.0 + 0.02 * jax.random.normal(kk, shape, f32)

    w_buf = min(ATT_WINDOW_MAX, PAST_LEN)
    G, P, CG = SSM_GROUPS, SSM_STATE, SSM_GROUP
    n_idx = jnp.arange(P, dtype=f32)[None, None, :]
    return {
        'x_prompt': nrm(k[0], (BATCH, SEQ, D_MODEL), 1.0),
        'x_sample': nrm(k[1], (DEC_BATCH, DEC_SEQ, D_MODEL), 1.0),
        'cache_attn_k': nrm(k[2], (DEPTH, DEC_BATCH, w_buf, ATT_HEADS, ATT_HEAD_DIM), 1.0),
        'cache_attn_v': nrm(k[3], (DEPTH, DEC_BATCH, w_buf, ATT_HEADS, ATT_HEAD_DIM), 1.0),
        'state_ssm_re': nrm(k[4], (DEPTH, DEC_BATCH, G, P), 0.5),
        'state_ssm_im': nrm(k[5], (DEPTH, DEC_BATCH, G, P), 0.5),
        'rel_bias': nrm(k[6], (N_REL_BUCKETS, ATT_HEADS), 0.5),
        'w_in': nrm(k[7], (DEPTH, D_MODEL, IN_COLS), D_MODEL ** -0.5),
        'w_out': nrm(k[8], (DEPTH, MIX_WIDTH, D_MODEL), MIX_WIDTH ** -0.5),
        'g_pre_mix': gain(k[9], (DEPTH, D_MODEL)),
        'g_post_mix': gain(k[10], (DEPTH, D_MODEL)),
        'g_mix_out': gain(k[11], (DEPTH, MIX_WIDTH)),
        'ssm_lam_re': -0.5 + nrm(k[12], (DEPTH, G, P), 0.01),
        'ssm_lam_im': math.pi * n_idx + nrm(k[13], (DEPTH, G, P), 0.01),
        'ssm_log_step': jax.random.uniform(k[14], (DEPTH, G), f32, math.log(1e-3), math.log(1e-1)),
        'ssm_b_re': nrm(k[15], (DEPTH, G, P, CG), (2 * CG) ** -0.5),
        'ssm_b_im': nrm(k[16], (DEPTH, G, P, CG), (2 * CG) ** -0.5),
        'ssm_c_re': nrm(k[17], (DEPTH, G, CG, P), P ** -0.5),
        'ssm_c_im': nrm(k[18], (DEPTH, G, CG, P), P ** -0.5),
        'ssm_d': nrm(k[19], (DEPTH, SSM_WIDTH), 1.0),
        'ssm_w_glu': nrm(k[20], (DEPTH, SSM_WIDTH, SSM_WIDTH), SSM_WIDTH ** -0.5),
        'ssm_b_glu': nrm(k[21], (DEPTH, SSM_WIDTH), 0.02),
        'sgu_g': gain(k[22], (DEPTH, SGU_WIDTH)),
        'sgu_w': nrm(k[23], (DEPTH, SGU_HEADS, SGU_CHUNK, SGU_CHUNK), SGU_CHUNK ** -0.5),
        'sgu_b': gain(k[24], (DEPTH, SGU_HEADS, SGU_CHUNK)),
        'g_pre_ffn': gain(k[25], (DEPTH, D_MODEL)),
        'g_post_ffn': gain(k[26], (DEPTH, D_MODEL)),
        'w_gate': nrm(k[27], (DEPTH, D_MODEL, FFN_HIDDEN), D_MODEL ** -0.5),
        'w_up': nrm(k[28], (DEPTH, D_MODEL, FFN_HIDDEN), D_MODEL ** -0.5),
        'w_down': nrm(k[29], (DEPTH, FFN_HIDDEN, D_MODEL), FFN_HIDDEN ** -0.5),
    }


def reference(x_prompt, x_sample, cache_attn_k, cache_attn_v, state_ssm_re, state_ssm_im,
              rel_bias, w_in, w_out, g_pre_mix, g_post_mix, g_mix_out,
              ssm_lam_re, ssm_lam_im, ssm_log_step, ssm_b_re, ssm_b_im, ssm_c_re, ssm_c_im,
              ssm_d, ssm_w_glu, ssm_b_glu, sgu_g, sgu_w, sgu_b,
              g_pre_ffn, g_post_ffn, w_gate, w_up, w_down):
    xp, xs = x_prompt, x_sample
    kp_l, vp_l, rp_l, ip_l = [], [], [], []
    ks_l, vs_l, rs_l, is_l, us_l = [], [], [], [], []
    for l in range(DEPTH):
        p = {'w_in': w_in[l], 'w_out': w_out[l], 'g_pre_mix': g_pre_mix[l],
             'g_post_mix': g_post_mix[l], 'g_mix_out': g_mix_out[l],
             'ssm_lam_re': ssm_lam_re[l], 'ssm_lam_im': ssm_lam_im[l],
             'ssm_log_step': ssm_log_step[l], 'ssm_b_re': ssm_b_re[l], 'ssm_b_im': ssm_b_im[l],
             'ssm_c_re': ssm_c_re[l], 'ssm_c_im': ssm_c_im[l], 'ssm_d': ssm_d[l],
             'ssm_w_glu': ssm_w_glu[l], 'ssm_b_glu': ssm_b_glu[l],
             'sgu_g': sgu_g[l], 'sgu_w': sgu_w[l], 'sgu_b': sgu_b[l],
             'g_pre_ffn': g_pre_ffn[l], 'g_post_ffn': g_post_ffn[l],
             'w_gate': w_gate[l], 'w_up': w_up[l], 'w_down': w_down[l]}
        xp, (nk, nv, hr, hi, _) = trunk_layer(xp, p, rel_bias)
        kp_l.append(nk)
        vp_l.append(nv)
        rp_l.append(hr)
        ip_l.append(hi)
        xs, (nk, nv, hr, hi, sv) = trunk_layer(xs, p, rel_bias, cache_attn_k[l], cache_attn_v[l],
                                               state_ssm_re[l], state_ssm_im[l])
        ks_l.append(nk)
        vs_l.append(nv)
        rs_l.append(hr)
        is_l.append(hi)
        us_l.append(sv)
    return (xp, xs, jnp.stack(kp_l), jnp.stack(vp_l), jnp.stack(rp_l), jnp.stack(ip_l),
            jnp.stack(ks_l), jnp.stack(vs_l), jnp.stack(rs_l), jnp.stack(is_l), jnp.stack(us_l))
```

```cpp
#include <hip/hip_runtime.h>
#include <cstdio>
#include <cstdint>
#define MK_PER_PHASE 0
#define FAST_ATTN 1
#define FAST_SSM 1
#define FAST_SGU 1
constexpr int NWAVES = 8;
#ifndef MK_PER_PHASE
#define MK_PER_PHASE 0
#endif
constexpr int DM = 2048, MP = 8192, MS = 64, MREAL = 8256, MTOT = 8448, SEQ = 4096;
constexpr int AW = 1024, SW = 512, GW = 512, INC = 4608, FF = 5632, FF2 = 11264, DEPTH = 4;
constexpr int N_PHASES = 1 + 8 * DEPTH;
constexpr float EPS = 1e-6f;
constexpr float LOG2E = 1.4426950408889634f;
constexpr float QSCALE = 0.08838834764831845f * 1.4426950408889634f;

constexpr size_t O_YP = 0, O_YS = 16777216, O_NKP = 16908288, O_NVP = 33685504, O_SRP = 50462720, O_SIP = 50479104, O_NKS = 50495488,
                 O_NVS = 50757632, O_SRS = 51019776, O_SIS = 51085312, O_SGV = 51150848, O_END = 51281920;
constexpr size_t MiB = 1u << 20;
constexpr size_t WS_CTL = 0, CTL_ZERO_BYTES = 1 * MiB;
constexpr size_t WS_WIN = 1 * MiB, SZ_WIN = (size_t)INC * DM * 2;
constexpr size_t WS_WOUT = WS_WIN + DEPTH * SZ_WIN, SZ_WOUT = (size_t)DM * DM * 2;
constexpr size_t WS_WGU = WS_WOUT + DEPTH * SZ_WOUT, SZ_WGU = (size_t)FF2 * DM * 2;
constexpr size_t WS_WDN = WS_WGU + DEPTH * SZ_WGU, SZ_WDN = (size_t)DM * FF * 2;
constexpr size_t WS_XN = WS_WDN + DEPTH * SZ_WDN;
constexpr size_t WS_Q = WS_XN + (size_t)MTOT * DM * 2;
constexpr size_t WS_K = WS_Q + (size_t)MTOT * AW * 2;
constexpr size_t WS_V = WS_K + (size_t)MTOT * AW * 2;
constexpr size_t WS_U = WS_V + (size_t)MTOT * AW * 2;
constexpr size_t WS_GU = WS_U + (size_t)MTOT * SW * 2;
constexpr size_t WS_GV = WS_GU + (size_t)MTOT * GW * 2;
constexpr size_t WS_MIX = WS_GV + (size_t)MTOT * GW * 2;
constexpr size_t WS_T = WS_MIX + (size_t)MTOT * DM * 2;
constexpr size_t WS_H = WS_T + (size_t)MTOT * DM * 4;
constexpr size_t WS_Y = WS_H + (size_t)MTOT * FF * 2;
constexpr size_t WS_RS = WS_Y + (size_t)MTOT * SW * 4;
constexpr size_t WS_BIAS = WS_RS + 65536;
constexpr size_t WS_WGLU = WS_BIAS + 65536;
constexpr size_t WS_WM = WS_WGLU + (size_t)DEPTH * 512 * 512 * 2;
constexpr size_t WS_AP = WS_WM + (size_t)DEPTH * 4 * 128 * 128 * 2;
constexpr size_t WS_BBF = WS_AP + (size_t)DEPTH * 32 * 64 * 8 * 4;
constexpr size_t WS_CF = WS_BBF + (size_t)DEPTH * 32 * 8 * 64 * 8 * 2;
constexpr size_t WS_SLOC = WS_CF + (size_t)DEPTH * 32 * 4 * 64 * 8 * 2;
constexpr size_t WS_END = WS_SLOC + (size_t)2 * 16 * 8 * 32 * 64 * 2 * 4;
constexpr size_t WS_OBUF = WS_H;
constexpr size_t WS_LSE = WS_T;
constexpr size_t WS_SATT = WS_T + 1 * MiB;
static_assert((size_t)3 * 8192 * 1024 * 2 <= (size_t)MTOT * FF * 2 && (size_t)3 * 8192 * 8 * 4 <= MiB, "overlays");
static_assert(WS_XN % 256 == 0 && WS_Q % 256 == 0 && WS_U % 256 == 0 && WS_MIX % 256 == 0 && WS_T % 256 == 0 && WS_H % 256 == 0 && WS_Y % 256 == 0 && WS_RS % 256 == 0, "ws alignment");
constexpr int CW_BAR = 4096;
constexpr int RING_OFF = 0, RING_BYTES = 131072;
constexpr int LDSCTL_OFF = RING_BYTES, MISC_OFF = LDSCTL_OFF + 320;
constexpr int LDS_BYTES = 147456;

namespace pg8 {
#define PG8_LAS __attribute__((address_space(3)))
typedef unsigned short bf16_t;
typedef short bf16x8 __attribute__((ext_vector_type(8)));
typedef float f32x4 __attribute__((ext_vector_type(4)));
typedef unsigned u32x4 __attribute__((ext_vector_type(4)));
constexpr int BM = 256, BK = 64, HALF = 128, HTB = HALF * BK * 2  , STAGE_BYTES = 8 * HTB, NXCD = 8, WGM = 8;

__host__ __device__ __forceinline__ int lds_byte(int r, int c) { const int st = (r >> 4) * 2 + (c >> 5), rr = r & 15, cc = c & 31, ob = rr * 64 + cc * 2; return st * 1024 + (ob ^ (((ob >> 9) & 1) << 5)); }
__host__ __device__ __forceinline__ void stage_rc(int b, int& R, int& C) { const int st = b / 1024, sb = b % 1024, swz = sb ^ (((sb >> 9) & 1) << 5); R = (st >> 1) * 16 + swz / 64; C = (st & 1) * 32 + (swz % 64) / 2; }
__host__ __device__ __forceinline__ int perm32(int rho) { const int n = rho >> 4, i = rho & 15; return 8 * (i >> 2) + 4 * n + (i & 3); }

struct Unit { int pm, pn; };
struct Gemm { const bf16_t* A; const bf16_t* Bt; int M, N, K; };

struct StaticOrder {
    int nM, nN, nwg, G, c;
    __host__ __device__ void init(int M, int N, int G_, int c_) { nM = M / BM; nN = N / BM; nwg = nM * nN; G = G_; c = c_; }
    __host__ __device__ bool next(int i, Unit& u) const {
        const long L = (long)i * G + c; if (L >= nwg) return false;
        int wgid = (int)L; { const int q = nwg / NXCD, r = nwg % NXCD, xcd = wgid % NXCD, off = wgid / NXCD; wgid = (xcd < r ? xcd * (q + 1) : r * (q + 1) + (xcd - r) * q) + off; }
        const int nig = WGM * nN, gid = wgid / nig, fm = gid * WGM, gsz = (nM - fm) < WGM ? (nM - fm) : WGM;
        u.pm = fm + ((wgid % nig) % gsz); u.pn = (wgid % nig) / gsz; return true;
    }
    __device__ __forceinline__ void a_ready(const Unit&) const {}
    __device__ __forceinline__ void done(const Unit&) const {}
};
__device__ __forceinline__ unsigned cvt_pk_bf16(float lo, float hi) { unsigned r; asm volatile("v_cvt_pk_bf16_f32 %0, %1, %2" : "=v"(r) : "v"(lo), "v"(hi)); return r; }
template <class Epi, class Sched, bool ALIGN_EPI = false, bool SP2 = false>
__device__ __forceinline__ void gemm_phase(PG8_LAS unsigned char* lds, const Gemm g, const Sched& S, const Epi& E) {
    int tid_raw = threadIdx.x; asm volatile("" : "+v"(tid_raw));
    const int tid = tid_raw, wid = __builtin_amdgcn_readfirstlane(tid >> 6), lane = tid & 63, wr = wid >> 2, wc = wid & 3, fr = lane & 15, fq = lane >> 4;
    const int K = g.K, nt = K / BK;
    unsigned voffA[2], voffB[2];
#pragma unroll
    for (int i = 0; i < 2; ++i) { int R, C; stage_rc(tid * 16 + i * 8192, R, C); const int Rb = Epi::PERM ? ((R & ~31) + perm32(R & 31)) : R;
        voffA[i] = (unsigned)(R * K + C) * 2u; voffB[i] = (unsigned)(Rb * K + C) * 2u; }
    const size_t kstep = (size_t)(BK * 2);
    const size_t hstep = (size_t)HALF * K * 2;
    const size_t tstep = 2 * hstep;
    const unsigned ldsw = (unsigned)wid * 1024u;
    const int aoff = lds_byte(wr * 64 + fr, fq * 8), boff = lds_byte(wc * 32 + fr, fq * 8);
#define PG8_SA(b, h) (((b) * 2 + (h)) * HTB)
#define PG8_SB(b, h) ((4 + (b) * 2 + (h)) * HTB)
#define PG8_STAGE(bufoff, gbase, voff) do { _Pragma("unroll") for (int _i = 0; _i < 2; ++_i) \
        __builtin_amdgcn_global_load_lds((const unsigned*)((const char*)(gbase) + (voff)[_i]), (PG8_LAS unsigned*)(lds + (bufoff) + ldsw + _i * 8192), 16, 0, 0); } while (0)
#define PG8_LDA(dst, b, h) do { _Pragma("unroll") for (int m = 0; m < 4; ++m) _Pragma("unroll") for (int k = 0; k < 2; ++k) dst[m][k] = *(const PG8_LAS bf16x8*)(lds + PG8_SA(b, h) + aoff + m * 2048 + k * 1024); } while (0)
#define PG8_LDB(dst, b, h) do { _Pragma("unroll") for (int n = 0; n < 2; ++n) _Pragma("unroll") for (int k = 0; k < 2; ++k) dst[n][k] = *(const PG8_LAS bf16x8*)(lds + PG8_SB(b, h) + boff + n * 2048 + k * 1024); } while (0)
#define PG8_MMA(ai, bj, At, Bt) do { __builtin_amdgcn_s_setprio(1); _Pragma("unroll") for (int m = 0; m < 4; ++m) _Pragma("unroll") for (int n = 0; n < 2; ++n) _Pragma("unroll") for (int k = 0; k < 2; ++k) \
        acc[ai][bj][m][n] = __builtin_amdgcn_mfma_f32_16x16x32_bf16(Bt[n][k], At[m][k], acc[ai][bj][m][n], 0, 0, 0); __builtin_amdgcn_s_setprio(0); } while (0)
#define PG8_WAIT_V(n) asm volatile("s_waitcnt vmcnt(" #n ")" ::: "memory")
#define PG8_WAIT_L(n) asm volatile("s_waitcnt lgkmcnt(" #n ")" ::: "memory")
#define PG8_BAR __builtin_amdgcn_s_barrier()
#define PG8_SCHED __builtin_amdgcn_sched_barrier(0)
    Unit cur, nxt; int ui = 0;
    if (!S.next(0, cur)) return;
    f32x4 acc[2][2][4][2];
#pragma unroll
    for (int a = 0; a < 2; ++a)
#pragma unroll
        for (int b = 0; b < 2; ++b)
#pragma unroll
            for (int m = 0; m < 4; ++m)
#pragma unroll
                for (int n = 0; n < 2; ++n) acc[a][b][m][n] = (f32x4){0.f, 0.f, 0.f, 0.f};
    bf16x8 At[4][2], B0[2][2], B1[2][2];
    const char* cA = (const char*)g.A + (size_t)cur.pm * tstep; const char* cB = (const char*)g.Bt + (size_t)cur.pn * tstep;
    S.a_ready(cur);
    if constexpr (SP2) {
        PG8_STAGE(PG8_SB(0, 0), cB, voffB); PG8_STAGE(PG8_SB(0, 1), cB + hstep, voffB); PG8_STAGE(PG8_SA(0, 0), cA, voffA); PG8_STAGE(PG8_SA(0, 1), cA + hstep, voffA);
        if (wr == 1) PG8_BAR;
        PG8_WAIT_V(2); PG8_BAR;
        PG8_STAGE(PG8_SB(1, 0), cB + kstep, voffB); PG8_STAGE(PG8_SA(1, 0), cA + kstep, voffA); PG8_STAGE(PG8_SB(1, 1), cB + hstep + kstep, voffB);
        PG8_WAIT_V(6); PG8_BAR;
    } else {
        PG8_STAGE(PG8_SB(0, 0), cB, voffB); PG8_STAGE(PG8_SA(0, 0), cA, voffA); PG8_STAGE(PG8_SB(0, 1), cB + hstep, voffB); PG8_STAGE(PG8_SA(0, 1), cA + hstep, voffA);
        if (wr == 1) PG8_BAR;
        PG8_WAIT_V(4); PG8_BAR;
        PG8_STAGE(PG8_SB(1, 0), cB + kstep, voffB); PG8_STAGE(PG8_SA(1, 0), cA + kstep, voffA); PG8_STAGE(PG8_SB(1, 1), cB + hstep + kstep, voffB);
        PG8_WAIT_V(6); PG8_BAR;
    }
    for (;;) {
        const bool has_next = S.next(ui + 1, nxt);
        const char* nA = has_next ? (const char*)g.A + (size_t)nxt.pm * tstep : cA; const char* nB = has_next ? (const char*)g.Bt + (size_t)nxt.pn * tstep : cB;
        for (int t = 0; t < nt; t += 2) {
            const bool last = (t == nt - 2);
            const char* a1 = cA + (size_t)(t + 1) * kstep;
            const char* a2 = last ? nA : cA + (size_t)(t + 2) * kstep; const char* b2 = last ? nB : cB + (size_t)(t + 2) * kstep;
            const char* a3 = a2 + kstep; const char* b3 = b2 + kstep;
            if (last && has_next) S.a_ready(nxt);
            if constexpr (SP2) {
            PG8_LDB(B0, 0, 0); PG8_LDB(B1, 0, 1); PG8_SCHED; PG8_LDA(At, 0, 0); PG8_STAGE(PG8_SA(1, 1), a1 + hstep, voffA);
            PG8_WAIT_V(8); PG8_WAIT_L(0); PG8_BAR; PG8_MMA(0, 0, At, B0); PG8_MMA(0, 1, At, B1); PG8_BAR; PG8_SCHED;
            PG8_LDA(At, 0, 1); PG8_STAGE(PG8_SB(0, 0), b2, voffB); PG8_STAGE(PG8_SB(0, 1), b2 + hstep, voffB); PG8_STAGE(PG8_SA(0, 0), a2, voffA);
            PG8_WAIT_V(8); PG8_WAIT_L(0); PG8_BAR; PG8_MMA(1, 0, At, B0); PG8_MMA(1, 1, At, B1); PG8_BAR; PG8_SCHED;
            PG8_LDB(B0, 1, 0); PG8_LDB(B1, 1, 1); PG8_SCHED; PG8_LDA(At, 1, 0); PG8_STAGE(PG8_SA(0, 1), a2 + hstep, voffA);
            PG8_WAIT_V(8); PG8_WAIT_L(0); PG8_BAR; PG8_MMA(0, 0, At, B0); PG8_MMA(0, 1, At, B1); PG8_BAR; PG8_SCHED;
            PG8_LDA(At, 1, 1); PG8_STAGE(PG8_SB(1, 0), b3, voffB); PG8_STAGE(PG8_SB(1, 1), b3 + hstep, voffB); PG8_STAGE(PG8_SA(1, 0), a3, voffA);
            PG8_WAIT_V(8); PG8_WAIT_L(0); PG8_BAR; PG8_MMA(1, 0, At, B0); PG8_MMA(1, 1, At, B1); PG8_BAR; PG8_SCHED;
            } else {
            PG8_LDB(B0, 0, 0); PG8_SCHED; PG8_LDA(At, 0, 0); PG8_STAGE(PG8_SA(1, 1), a1 + hstep, voffA);
            PG8_WAIT_L(8); PG8_BAR; PG8_WAIT_L(0); PG8_MMA(0, 0, At, B0); PG8_BAR; PG8_SCHED;
            PG8_LDB(B1, 0, 1); PG8_STAGE(PG8_SB(0, 0), b2, voffB);
            PG8_BAR; PG8_WAIT_L(0); PG8_MMA(0, 1, At, B1); PG8_BAR;
            PG8_LDA(At, 0, 1); PG8_STAGE(PG8_SA(0, 0), a2, voffA);
            PG8_BAR; PG8_WAIT_L(0); PG8_MMA(1, 0, At, B0); PG8_BAR; PG8_SCHED;
            PG8_STAGE(PG8_SB(0, 1), b2 + hstep, voffB);
            PG8_WAIT_V(6); PG8_BAR; PG8_MMA(1, 1, At, B1); PG8_BAR;
            PG8_LDB(B0, 1, 0); PG8_SCHED; PG8_LDA(At, 1, 0); PG8_STAGE(PG8_SA(0, 1), a2 + hstep, voffA);
            PG8_WAIT_L(8); PG8_BAR; PG8_WAIT_L(0); PG8_MMA(0, 0, At, B0); PG8_BAR; PG8_SCHED;
            PG8_LDB(B1, 1, 1); PG8_STAGE(PG8_SB(1, 0), b3, voffB);
            PG8_BAR; PG8_WAIT_L(0); PG8_MMA(0, 1, At, B1); PG8_BAR;
            PG8_LDA(At, 1, 1); PG8_STAGE(PG8_SA(1, 0), a3, voffA);
            PG8_BAR; PG8_WAIT_L(0); PG8_MMA(1, 0, At, B0); PG8_BAR; PG8_SCHED;
            PG8_STAGE(PG8_SB(1, 1), b3 + hstep, voffB);
            PG8_WAIT_V(6); PG8_BAR; PG8_MMA(1, 1, At, B1); PG8_BAR;
            }
        }
        if constexpr (ALIGN_EPI) { if (wr == 0) PG8_BAR; }
        if constexpr (!Epi::AFTER_DRAIN) { E(acc, cur, wr, wc, fr, fq); S.done(cur); }
        if (!has_next) break;
#pragma unroll
        for (int a = 0; a < 2; ++a)
#pragma unroll
            for (int b = 0; b < 2; ++b)
#pragma unroll
                for (int m = 0; m < 4; ++m)
#pragma unroll
                    for (int n = 0; n < 2; ++n) acc[a][b][m][n] = (f32x4){0.f, 0.f, 0.f, 0.f};
        cur = nxt; cA = nA; cB = nB; ++ui;
        if constexpr (ALIGN_EPI) { if (wr == 1) PG8_BAR; }
    }
    PG8_WAIT_V(0);
    if constexpr (!ALIGN_EPI) { if (wr == 0) PG8_BAR; }
    PG8_BAR;
    if constexpr (Epi::AFTER_DRAIN) { E.fused(acc, cur, wr, wc, fr, fq, lds, wid, lane); S.done(cur); }
#undef PG8_SA
#undef PG8_SB
#undef PG8_STAGE
#undef PG8_LDA
#undef PG8_LDB
#undef PG8_MMA
#undef PG8_WAIT_V
#undef PG8_WAIT_L
#undef PG8_BAR
#undef PG8_SCHED
}
}

namespace pg8 {
__device__ __forceinline__ float fast_sigmoid(float w) { return __builtin_amdgcn_rcpf(1.0f + __builtin_amdgcn_exp2f(-1.4426950408889634f * w)); }
__device__ __forceinline__ float gelu_tanh(float x) { return x * fast_sigmoid(1.5957691216057308f * (x + 0.044715f * x * x * x)); }

struct EpiF32 {
    static constexpr bool PERM = false, AFTER_DRAIN = false;
    float* C; int ldc;
    __device__ __forceinline__ void operator()(const f32x4 (&acc)[2][2][4][2], const Unit& u, int wr, int wc, int fr, int fq) const {
        const int row0 = u.pm * BM + wr * 64 + fr, col0 = u.pn * BM + wc * 32 + 4 * fq;
#pragma unroll
        for (int ai = 0; ai < 2; ++ai)
#pragma unroll
            for (int m = 0; m < 4; ++m) { float* rowp = C + (size_t)(row0 + ai * HALF + m * 16) * ldc + col0;
#pragma unroll
                for (int bj = 0; bj < 2; ++bj)
#pragma unroll
                    for (int n = 0; n < 2; ++n) *(f32x4*)(rowp + bj * HALF + n * 16) = acc[ai][bj][m][n]; }
    }
};

struct EpiIn {
    static constexpr bool PERM = true, AFTER_DRAIN = false;
    unsigned char* ws; float* out; int layer;
    __device__ __forceinline__ void operator()(const f32x4 (&acc)[2][2][4][2], const Unit& u, int wr, int wc, int fr, int fq) const {
        const int row0 = u.pm * BM + wr * 64 + fr;
        const int pn = u.pn;
#pragma unroll
        for (int ai = 0; ai < 2; ++ai)
#pragma unroll
            for (int m = 0; m < 4; ++m) {
                const int row = row0 + ai * HALF + m * 16;
                const float r = ((const float*)(ws + WS_RS))[row];
#pragma unroll
                for (int bj = 0; bj < 2; ++bj) {
                    f32x4 v0 = acc[ai][bj][m][0] * r, v1 = acc[ai][bj][m][1] * r;
                    const int col = pn * BM + bj * HALF + wc * 32 + 8 * fq;
                    bf16_t* dst;
                    if (pn < 4) dst = (bf16_t*)(ws + WS_Q) + (size_t)row * 1024 + col;
                    else if (pn < 8) dst = (bf16_t*)(ws + WS_K) + (size_t)row * 1024 + (col - 1024);
                    else if (pn < 12) dst = (bf16_t*)(ws + WS_V) + (size_t)row * 1024 + (col - 2048);
                    else if (pn < 14) dst = (bf16_t*)(ws + WS_U) + (size_t)row * 512 + (col - 3072);
                    else if (pn < 16) dst = (bf16_t*)(ws + WS_GU) + (size_t)row * 512 + (col - 3584);
                    else dst = (bf16_t*)(ws + WS_GV) + (size_t)row * 512 + (col - 4096);
                    if (pn >= 4 && pn < 12) {
                        const int c2 = (pn < 8) ? col - 1024 : col - 2048;
                        float* o = nullptr;
                        if (row < 8192) { const int b = row >> 12, t = row & 4095;
                            if (t >= 2048) o = out + ((pn < 8) ? O_NKP : O_NVP) + ((size_t)((layer * 2 + b) * 2048 + (t - 2048))) * 1024 + c2; }
                        else if (row < 8256) o = out + ((pn < 8) ? O_NKS : O_NVS) + ((size_t)(layer * 64 + (row - 8192))) * 1024 + c2;
                        if (o) { *(f32x4*)o = v0; *(f32x4*)(o + 4) = v1; }
                    }
                    if (pn >= 14) {
#pragma unroll
                        for (int j = 0; j < 4; ++j) { v0[j] = gelu_tanh(v0[j]); v1[j] = gelu_tanh(v1[j]); }
                    }
                    u32x4 w; w.x = cvt_pk_bf16(v0[0], v0[1]); w.y = cvt_pk_bf16(v0[2], v0[3]); w.z = cvt_pk_bf16(v1[0], v1[1]); w.w = cvt_pk_bf16(v1[2], v1[3]);
                    *(u32x4*)dst = w;
                }
            }
    }
};

struct EpiGU {
    static constexpr bool PERM = true, AFTER_DRAIN = false;
    unsigned char* ws;
    __device__ __forceinline__ void operator()(const f32x4 (&acc)[2][2][4][2], const Unit& u, int wr, int wc, int fr, int fq) const {
        const int row0 = u.pm * BM + wr * 64 + fr, j0 = u.pn * HALF + wc * 32 + 8 * fq;
#pragma unroll
        for (int ai = 0; ai < 2; ++ai)
#pragma unroll
            for (int m = 0; m < 4; ++m) {
                const int row = row0 + ai * HALF + m * 16;
                const float r = ((const float*)(ws + WS_RS))[row];
                float o[8];
#pragma unroll
                for (int n = 0; n < 2; ++n)
#pragma unroll
                    for (int j = 0; j < 4; ++j) { const float g = acc[ai][0][m][n][j] * r, up = acc[ai][1][m][n][j] * r; o[4 * n + j] = g * fast_sigmoid(g) * up; }
                u32x4 w; w.x = cvt_pk_bf16(o[0], o[1]); w.y = cvt_pk_bf16(o[2], o[3]); w.z = cvt_pk_bf16(o[4], o[5]); w.w = cvt_pk_bf16(o[6], o[7]);
                *(u32x4*)((bf16_t*)(ws + WS_H) + (size_t)row * 5632 + j0) = w;
            }
    }
};
}

#define GAS __attribute__((address_space(1)))
#define LAS __attribute__((address_space(3)))
typedef unsigned short bf16;
typedef unsigned v4u __attribute__((ext_vector_type(4)));
typedef unsigned v2u __attribute__((ext_vector_type(2)));
typedef float f32x4 __attribute__((ext_vector_type(4)));
typedef float f32x2v __attribute__((ext_vector_type(2)));
typedef short bf16x8 __attribute__((ext_vector_type(8)));
typedef GAS unsigned gu32;
#define RLX_AGENT __ATOMIC_RELAXED, __HIP_MEMORY_SCOPE_AGENT
#define LDS_WAIT() asm volatile("s_waitcnt lgkmcnt(0)" ::: "memory")
#define VM_WAIT() asm volatile("s_waitcnt vmcnt(0)" ::: "memory")
__device__ __forceinline__ unsigned f2bf(float f) { unsigned u = __builtin_bit_cast(unsigned, f); return (u + 0x7fffu + ((u >> 16) & 1u)) >> 16; }
__device__ __forceinline__ unsigned pk2(float lo, float hi) { return f2bf(lo) | (f2bf(hi) << 16); }
__device__ __forceinline__ float bf_lo(unsigned w) { return __builtin_bit_cast(float, w << 16); }
__device__ __forceinline__ float bf_hi(unsigned w) { return __builtin_bit_cast(float, w & 0xffff0000u); }
__device__ __forceinline__ float bf2f(bf16 b) { return __builtin_bit_cast(float, ((unsigned)b) << 16); }

#define XB_TMO      128
#define XB_XCNT(j)  (256  + 64 * (j))
#define XB_XSUB(j)  (1280 + 64 * (j))
#define XB_XGEN(j)  (2304 + 64 * (j))
#define XB_TOP      3328
#define XB_TOPGEN   3392
#define XCD_BAR_WORDS 3456
#define XB_SPIN_CAP (1u << 18)

__device__ __forceinline__ unsigned xb_ld(unsigned* p)              { return __hip_atomic_load(p, __ATOMIC_RELAXED, __HIP_MEMORY_SCOPE_AGENT); }
__device__ __forceinline__ unsigned xb_add(unsigned* p, unsigned v) { return __hip_atomic_fetch_add(p, v, __ATOMIC_RELAXED, __HIP_MEMORY_SCOPE_AGENT); }
__device__ __forceinline__ unsigned xb_xcc_id() { return (unsigned)__builtin_amdgcn_s_getreg((3 << 11) | 20) & 0xFu; }
#define XB_SPIN(cond, bar) do { unsigned _sp = 0; while (cond) { __builtin_amdgcn_s_sleep(1); \
    if ((++_sp & 255u) == 0u) { if (xb_ld(&(bar)[XB_TMO])) break; if (_sp > XB_SPIN_CAP) { atomicAdd(&(bar)[XB_TMO], 1u); break; } } } } while (0)

struct XcdBarrier {
    unsigned* bar; unsigned x;
    volatile LAS unsigned* st;
};

__device__ __forceinline__ XcdBarrier xcd_barrier_post(unsigned* bar, volatile LAS unsigned* st) {
    XcdBarrier b; b.bar = bar; b.x = xb_xcc_id(); b.st = st;
    if (threadIdx.x == 0) (void)xb_add(&bar[XB_XCNT(b.x)], 1u);
    return b;
}
__device__ __forceinline__ void xcd_barrier_complete(unsigned* bar, unsigned x, unsigned& nloc, unsigned& nx) {
    const unsigned G = gridDim.x * gridDim.y * gridDim.z;
    unsigned sum, cnt, mine, sp = 0u;
    for (;;) {
        sum = 0u; cnt = 0u; mine = 0u;
#pragma unroll
        for (unsigned j = 0; j < 16; ++j) { const unsigned c = xb_ld(&bar[XB_XCNT(j)]); sum += c; cnt += (c > 0u) ? 1u : 0u; mine = (j == x) ? c : mine; }
        if (sum == G) break;
        __builtin_amdgcn_s_sleep(1);
        if ((++sp & 255u) == 0u) { if (xb_ld(&bar[XB_TMO])) break; if (sp > XB_SPIN_CAP) { atomicAdd(&bar[XB_TMO], 1u); break; } }
    }
    nloc = mine > 0u ? mine : 1u; nx = cnt > 0u ? cnt : 1u;
}

__device__ __forceinline__ void xcd_barrier(const XcdBarrier& b) {
    asm volatile("s_waitcnt vmcnt(0)" ::: "memory");
    __syncthreads();
    if (threadIdx.x == 0) {
        unsigned* bar = b.bar;
        __builtin_amdgcn_s_waitcnt(0);
        unsigned nloc = b.st[0], nx = b.st[1];
        if (nloc == 0u) { xcd_barrier_complete(bar, b.x, nloc, nx); b.st[0] = nloc; b.st[1] = nx; }
        const unsigned old = xb_add(&bar[XB_XSUB(b.x)], 1u);
        const unsigned gen = old / nloc;
        if (old + 1u == (gen + 1u) * nloc) {
            __builtin_amdgcn_fence(__ATOMIC_RELEASE, "agent");
            asm volatile("s_waitcnt vmcnt(0)" ::: "memory");
            const unsigned og = xb_add(&bar[XB_TOP], 1u);
            const unsigned tg = og / nx;
            if (og + 1u == (tg + 1u) * nx) xb_add(&bar[XB_TOPGEN], 1u);
            else XB_SPIN(xb_ld(&bar[XB_TOPGEN]) == tg, bar);
            __builtin_amdgcn_fence(__ATOMIC_ACQUIRE, "agent");
            xb_add(&bar[XB_XGEN(b.x)], 1u);
            asm volatile("s_waitcnt vmcnt(0)" ::: "memory");
        } else {
            XB_SPIN(xb_ld(&bar[XB_XGEN(b.x)]) == gen, bar);
            __builtin_amdgcn_fence(__ATOMIC_ACQUIRE, "agent");
            asm volatile("s_waitcnt vmcnt(0)" ::: "memory");
        }
    }
    __syncthreads();
}


#ifndef MK_FUSED_MIXERS
#define MK_FUSED_MIXERS 1
#endif
#ifndef FAST_ATTN
#define FAST_ATTN 0
#endif
#ifndef FAST_SSM
#define FAST_SSM 0
#endif
#ifndef FAST_SGU
#define FAST_SGU 0
#endif
struct Frame {
    LAS unsigned char* lds;
    volatile LAS unsigned* MISC;
    gu32* ctl;
    int tid, lane, wave;
    int vcu, G;
    const float* const* inp;
    float* out;
    unsigned char* ws;
};
#define F_IN(k) (F.inp[(k)])
#define F_WS(type, off) ((type*)(F.ws + (off)))
enum { I_XP = 0, I_XS, I_CK, I_CV, I_SRE, I_SIM, I_RELB, I_WIN, I_WOUT, I_GPREMIX, I_GPOSTMIX, I_GMIXOUT, I_LAMRE, I_LAMIM, I_LOGSTEP, I_BRE, I_BIM, I_CRE, I_CIM,
       I_SSMD, I_WGLU, I_BGLU, I_SGUG, I_SGUW, I_SGUB, I_GPREFFN, I_GPOSTFFN, I_WGATE, I_WUP, I_WDOWN };

__device__ __forceinline__ float wave_sum(float v) {
#pragma unroll
    for (int o = 1; o < 64; o <<= 1) v += __shfl_xor(v, o);
    return v;
}

__device__ __forceinline__ void p0_transpose_item(const float* W, int K, int N, bf16* WT, LAS float* scr, int item, int lane, const float* kscale, float cscale, int cs_limit, int mode) {
    const int nblk = N / 32, kb = item / nblk, nb = item % nblk, k0 = 64 * kb, n0 = 32 * nb;
    const float cs = (n0 < cs_limit) ? cscale : 1.0f;
#pragma unroll 8
    for (int i = 0; i < 32; ++i) { const int kk = 2 * i + (lane >> 5); float v = W[(size_t)(k0 + kk) * N + n0 + (lane & 31)]; if (kscale) v *= kscale[k0 + kk]; scr[kk * 33 + (lane & 31)] = v * cs; }
    LDS_WAIT(); asm volatile("" ::: "memory");
    const int c = lane & 7;
#pragma unroll
    for (int j = 0; j < 4; ++j) { const int n = (lane >> 3) + 8 * j; const LAS float* s = scr + (8 * c) * 33 + n;
        v4u o; o.x = pk2(s[0 * 33], s[1 * 33]); o.y = pk2(s[2 * 33], s[3 * 33]); o.z = pk2(s[4 * 33], s[5 * 33]); o.w = pk2(s[6 * 33], s[7 * 33]);
        const int col = n0 + n; const int row = (mode == 0) ? col : (256 * (col >> 7) + (col & 127) + (mode == 2 ? 128 : 0));
        *(GAS v4u*)(WT + (size_t)row * K + k0 + 8 * c) = o; }
    LDS_WAIT(); asm volatile("" ::: "memory");
}
__device__ __forceinline__ int t5_bucket(int dist) {
    if (dist < 16) return dist;
    int large = 16 + (int)(logf((float)dist / 16.0f) / logf(128.0f) * 16.0f);
    return large < 31 ? large : 31;
}
__device__ __forceinline__ void p0_prologue(Frame& F) {
    LAS float* scr = (LAS float*)(F.lds + RING_OFF + F.wave * 16384);
    const int gw = F.vcu * NWAVES + F.wave, NGW = F.G * NWAVES;
    constexpr int I_IN = (DM / 64) * (INC / 32), I_OUT = (DM / 64) * (DM / 32), I_G = (DM / 64) * (FF / 32), I_D = (FF / 64) * (DM / 32);
    constexpr int I_GLU = (SW / 64) * (SW / 32);
    constexpr int PER_L = I_IN + I_OUT + 2 * I_G + I_D + I_GLU;
    for (int it = gw; it < DEPTH * PER_L; it += NGW) {
        const int l = it / PER_L; int r = it % PER_L;
        if (r < I_IN) { p0_transpose_item(F_IN(I_WIN) + (size_t)l * DM * INC, DM, INC, F_WS(bf16, WS_WIN) + (size_t)l * INC * DM, scr, r, F.lane, F_IN(I_GPREMIX) + l * DM, QSCALE, AW, 0); continue; } r -= I_IN;
        if (r < I_OUT) { p0_transpose_item(F_IN(I_WOUT) + (size_t)l * DM * DM, DM, DM, F_WS(bf16, WS_WOUT) + (size_t)l * DM * DM, scr, r, F.lane, nullptr, 1.f, 0, 0); continue; } r -= I_OUT;
        if (r < I_G) { p0_transpose_item(F_IN(I_WGATE) + (size_t)l * DM * FF, DM, FF, F_WS(bf16, WS_WGU) + (size_t)l * FF2 * DM, scr, r, F.lane, F_IN(I_GPREFFN) + l * DM, 1.f, 0, 1); continue; } r -= I_G;
        if (r < I_G) { p0_transpose_item(F_IN(I_WUP) + (size_t)l * DM * FF, DM, FF, F_WS(bf16, WS_WGU) + (size_t)l * FF2 * DM, scr, r, F.lane, F_IN(I_GPREFFN) + l * DM, 1.f, 0, 2); continue; } r -= I_G;
        if (r < I_D) { p0_transpose_item(F_IN(I_WDOWN) + (size_t)l * FF * DM, FF, DM, F_WS(bf16, WS_WDN) + (size_t)l * DM * FF, scr, r, F.lane, nullptr, 1.f, 0, 0); continue; } r -= I_D;
        p0_transpose_item(F_IN(I_WGLU) + (size_t)l * SW * SW, SW, SW, F_WS(bf16, WS_WGLU) + (size_t)l * SW * SW, scr, r, F.lane, nullptr, 1.f, 0, 0);
    }
    for (int i = gw * 64 + F.lane; i < DEPTH * 32 * 64; i += NGW * 64) {
        const int p = i & 63, g = (i >> 6) & 31, l = i >> 11;
        const float lr = F_IN(I_LAMRE)[i], li = F_IN(I_LAMIM)[i], step = expf(F_IN(I_LOGSTEP)[l * 32 + g]);
        const float mag = expf(lr * step), are = mag * cosf(li * step), aim = mag * sinf(li * step);
        const float den = lr * lr + li * li, cre_ = ((are - 1.0f) * lr + aim * li) / den, cim_ = (aim * lr - (are - 1.0f) * li) / den;
        float pr = are, pim = aim; float* ap = F_WS(float, WS_AP) + (size_t)i * 8; ap[0] = are; ap[1] = aim;
        for (int k = 0; k < 5; ++k) { const float nr = pr * pr - pim * pim, ni = 2.0f * pr * pim; pr = nr; pim = ni; }
        ap[2] = pr; ap[3] = pim;
        for (int k = 0; k < 3; ++k) { const float nr = pr * pr - pim * pim, ni = 2.0f * pr * pim; pr = nr; pim = ni; }
        ap[4] = pr; ap[5] = pim; ap[6] = 0.f; ap[7] = 0.f;
        bf16* BB = F_WS(bf16, WS_BBF) + ((size_t)(l * 32 + g) * 8) * 512; bf16* CFp = F_WS(bf16, WS_CF) + ((size_t)(l * 32 + g) * 4) * 512;
        const int mt = p >> 4, rowi = p & 15;
        for (int c = 0; c < 16; ++c) { const float br = F_IN(I_BRE)[(size_t)i * 16 + c], bi = F_IN(I_BIM)[(size_t)i * 16 + c];
            const int ln = rowi + 16 * (c >> 3), j = c & 7;
            BB[(mt * 64 + ln) * 8 + j] = (bf16)f2bf(cre_ * br - cim_ * bi); BB[((4 + mt) * 64 + ln) * 8 + j] = (bf16)f2bf(cre_ * bi + cim_ * br);
            const int lc = c + 16 * ((p >> 3) & 3), jc = p & 7;
            CFp[((p >> 5) * 64 + lc) * 8 + jc] = (bf16)f2bf(F_IN(I_CRE)[(((size_t)l * 32 + g) * 16 + c) * 64 + p]);
            CFp[((2 + (p >> 5)) * 64 + lc) * 8 + jc] = (bf16)f2bf(-F_IN(I_CIM)[(((size_t)l * 32 + g) * 16 + c) * 64 + p]); }
        for (int g4 = 2; g4 < 4; ++g4) for (int j = 0; j < 8; ++j) { BB[(mt * 64 + rowi + 16 * g4) * 8 + j] = 0; BB[((4 + mt) * 64 + rowi + 16 * g4) * 8 + j] = 0; }
    }
    for (int i = gw * 64 + F.lane; i < DEPTH * 4 * 128 * 128; i += NGW * 64) { const int s = i & 127, t = (i >> 7) & 127; F_WS(bf16, WS_WM)[i] = (s <= t) ? (bf16)f2bf(F_IN(I_SGUW)[i]) : (bf16)0; }
    for (int m = gw; m < MTOT; m += NGW) {
        GAS v2u* xo = (GAS v2u*)(F_WS(bf16, WS_XN) + (size_t)m * DM) + F.lane;
        if (m < MREAL) {
            const float* src = (m < MP) ? F_IN(I_XP) + (size_t)m * DM : F_IN(I_XS) + (size_t)(m - MP) * DM;
            const GAS f32x4* xr = (const GAS f32x4*)src + F.lane; GAS f32x4* xw = (GAS f32x4*)(F.out + (size_t)m * DM) + F.lane;
            f32x4 v[8]; float s = 0.f;
#pragma unroll
            for (int j = 0; j < 8; ++j) { v[j] = xr[64 * j]; s += (v[j].x * v[j].x + v[j].y * v[j].y) + (v[j].z * v[j].z + v[j].w * v[j].w); }
            s = wave_sum(s);
#pragma unroll
            for (int j = 0; j < 8; ++j) { xw[64 * j] = v[j]; v2u w; w.x = pk2(v[j].x, v[j].y); w.y = pk2(v[j].z, v[j].w); xo[64 * j] = w; }
            if (F.lane == 0) F_WS(float, WS_RS)[m] = 1.0f / sqrtf(s * (1.0f / DM) + EPS);
        } else {
#pragma unroll
            for (int j = 0; j < 8; ++j) { v2u w; w.x = 0u; w.y = 0u; xo[64 * j] = w; }
            if (F.lane == 0) F_WS(float, WS_RS)[m] = 0.f;
        }
    }
    for (int i = gw * 64 + F.lane; i < 3 * 8 * 129; i += NGW * 64) {
        const int jj = i % 129, h = (i / 129) % 8, pi = i / (129 * 8); const int d = pi == 0 ? 1 : (pi == 1 ? 4 : 16);
        F_WS(float, WS_BIAS)[i] = F_IN(I_RELB)[t5_bucket(jj * d) * 8 + h] * LOG2E;
    }
}

__device__ __forceinline__ void norm_rows(Frame& F, const float* g) {
    const int gw = F.vcu * NWAVES + F.wave, NGW = F.G * NWAVES;
    for (int m = gw; m < MREAL; m += NGW) {
        const GAS f32x4* tr = (const GAS f32x4*)(F_WS(float, WS_T) + (size_t)m * DM) + F.lane; GAS f32x4* xw = (GAS f32x4*)(F.out + (size_t)m * DM) + F.lane;
        const GAS f32x4* gr = (const GAS f32x4*)g + F.lane; GAS v2u* xo = (GAS v2u*)(F_WS(bf16, WS_XN) + (size_t)m * DM) + F.lane;
        f32x4 tv[8]; float s = 0.f;
#pragma unroll
        for (int j = 0; j < 8; ++j) { tv[j] = tr[64 * j]; s += (tv[j].x * tv[j].x + tv[j].y * tv[j].y) + (tv[j].z * tv[j].z + tv[j].w * tv[j].w); }
        const float r = 1.0f / sqrtf(wave_sum(s) * (1.0f / DM) + EPS);
        float s2 = 0.f;
#pragma unroll
        for (int j = 0; j < 8; ++j) { const f32x4 xv = xw[64 * j], gv = gr[64 * j]; tv[j] = xv + tv[j] * r * gv; s2 += (tv[j].x * tv[j].x + tv[j].y * tv[j].y) + (tv[j].z * tv[j].z + tv[j].w * tv[j].w); }
        s2 = wave_sum(s2);
#pragma unroll
        for (int j = 0; j < 8; ++j) { xw[64 * j] = tv[j]; v2u w; w.x = pk2(tv[j].x, tv[j].y); w.y = pk2(tv[j].z, tv[j].w); xo[64 * j] = w; }
        if (F.lane == 0) F_WS(float, WS_RS)[m] = 1.0f / sqrtf(s2 * (1.0f / DM) + EPS);
    }
}


typedef short s16x4 __attribute__((ext_vector_type(4)));
typedef short v4i16_t __attribute__((ext_vector_type(4)));
typedef LAS const char* lds_cptr;
#define MFMA16(a, b, c) __builtin_amdgcn_mfma_f32_16x16x32_bf16((a), (b), (c), 0, 0, 0)
__device__ __forceinline__ unsigned off_b(unsigned row, unsigned ch) { return 256u * row + 16u * (ch ^ (((row & 3u) << 2) | ((row >> 2) & 3u))); }
__device__ __forceinline__ unsigned tr_addr16(unsigned lane, unsigned c, unsigned ks, unsigned t) {
    const unsigned g = lane >> 4, q = (lane & 15u) >> 2, p = lane & 3u;
    return off_b(32u * ks + 8u * g + 4u * t + q, 2u * c + (p >> 1)) + 8u * (p & 1u);
}
__device__ __forceinline__ s16x4 vtr(lds_cptr p) { return __builtin_bit_cast(s16x4, __builtin_amdgcn_ds_read_tr16_b64_v4i16((LAS v4i16_t*)p)); }
__device__ __forceinline__ unsigned cvtpk(float lo, float hi) { unsigned r; asm volatile("v_cvt_pk_bf16_f32 %0, %1, %2" : "=v"(r) : "v"(lo), "v"(hi)); return r; }

constexpr int LDS_X_OFF = 132096;
constexpr int ATT_UNITS = 1536;

__device__ __forceinline__ void attn_unit(LAS unsigned char* lds, unsigned char* ws, int unit, int tid) {
    const int lane = tid & 63, w = __builtin_amdgcn_readfirstlane(tid >> 6);
    const int pi = unit >> 9, r2 = unit & 511, n = r2 >> 8, h = (r2 >> 5) & 7, rb = r2 & 31;
    const int dsh = 2 * pi, d = 1 << dsh, nbs = 5 - dsh;
    const int r = rb >> nbs, b = rb & ((1 << nbs) - 1);
    const bf16* Kg = (const bf16*)(ws + WS_K); const bf16* Vg = (const bf16*)(ws + WS_V); const bf16* Qg = (const bf16*)(ws + WS_Q);
    LAS unsigned char* Kimg = lds; LAS unsigned char* Vimg = lds + 65536; LAS float* btab = (LAS float*)(lds + LDS_X_OFF);
    {
        const int ch = tid & 15, jr = tid >> 4;
        v4u kv[8], vv[8];
#pragma unroll
        for (int p = 0; p < 8; ++p) { const int j = p * 32 + jr; const int tk = r + d * (128 * (b - 1) + j);
            if (tk >= 0) { const size_t off = ((size_t)(n * SEQ + tk)) * AW + h * 128 + ch * 8; kv[p] = *(const v4u*)(Kg + off); vv[p] = *(const v4u*)(Vg + off); }
            else { kv[p] = (v4u){0u, 0u, 0u, 0u}; vv[p] = (v4u){0u, 0u, 0u, 0u}; } }
#pragma unroll
        for (int p = 0; p < 8; ++p) { const int j = p * 32 + jr; const unsigned o = off_b(j, ch); *(LAS v4u*)(Kimg + o) = kv[p]; *(LAS v4u*)(Vimg + o) = vv[p]; }
        if (tid < 129) btab[tid] = ((const float*)(ws + WS_BIAS))[(pi * 8 + h) * 129 + tid];
    }
    __syncthreads();
    const int q = lane & 15, g4 = lane >> 4, qi = 16 * w + q;
    const int rowq = n * SEQ + r + d * (128 * b + qi);
    bf16x8 qf[4];
#pragma unroll
    for (int s = 0; s < 4; ++s) qf[s] = *(const bf16x8*)(Qg + (size_t)rowq * AW + h * 128 + 32 * s + 8 * g4);
    const int ks0 = w >> 1;
    f32x4 sacc[5][2];
    {
        const int rr = lane & 15;
#pragma unroll
        for (int kb = 0; kb < 5; ++kb)
#pragma unroll
            for (int t = 0; t < 2; ++t) {
                const int j = 32 * (ks0 + kb) + 8 * (rr >> 2) + 4 * t + (rr & 3);
                f32x4 acc = (f32x4){0.f, 0.f, 0.f, 0.f};
#pragma unroll
                for (int s = 0; s < 4; ++s) { const bf16x8 kf = *(const LAS bf16x8*)(Kimg + off_b(j, 4 * s + g4)); acc = MFMA16(kf, qf[s], acc); }
                sacc[kb][t] = acc;
            }
    }
    float mx = -3.0e38f;
#pragma unroll
    for (int kb = 0; kb < 5; ++kb)
#pragma unroll
        for (int t = 0; t < 2; ++t)
#pragma unroll
            for (int i = 0; i < 4; ++i) {
                const int j = 32 * (ks0 + kb) + 8 * g4 + 4 * t + i; const int delta = 128 + qi - j;
                const bool valid = (delta >= 0) && (delta <= 128) && (b > 0 || j >= 128);
                const int dc = delta < 0 ? 0 : (delta > 128 ? 128 : delta);
                const float sv = valid ? sacc[kb][t][i] + btab[dc] : -1.0e30f;
                sacc[kb][t][i] = sv; mx = fmaxf(mx, sv);
            }
    mx = fmaxf(mx, __shfl_xor(mx, 16)); mx = fmaxf(mx, __shfl_xor(mx, 32));
    float ls = 0.f;
    bf16x8 pf[5];
#pragma unroll
    for (int kb = 0; kb < 5; ++kb) {
        float p[8];
#pragma unroll
        for (int t = 0; t < 2; ++t)
#pragma unroll
            for (int i = 0; i < 4; ++i) { p[4 * t + i] = __builtin_amdgcn_exp2f(sacc[kb][t][i] - mx); ls += p[4 * t + i]; }
        v4u pk; pk.x = cvtpk(p[0], p[1]); pk.y = cvtpk(p[2], p[3]); pk.z = cvtpk(p[4], p[5]); pk.w = cvtpk(p[6], p[7]);
        pf[kb] = __builtin_bit_cast(bf16x8, pk);
    }
    ls += __shfl_xor(ls, 16); ls += __shfl_xor(ls, 32);
    const float inv = 1.0f / ls;
    bf16* Og = (bf16*)(ws + WS_OBUF) + ((size_t)pi * MP + rowq) * AW + h * 128;
#pragma unroll
    for (int c = 0; c < 8; ++c) {
        f32x4 oacc = (f32x4){0.f, 0.f, 0.f, 0.f};
#pragma unroll
        for (int kb = 0; kb < 5; ++kb) {
            const s16x4 lo = vtr((lds_cptr)(Vimg + tr_addr16(lane, c, ks0 + kb, 0))), hi = vtr((lds_cptr)(Vimg + tr_addr16(lane, c, ks0 + kb, 1)));
            const bf16x8 vf = __builtin_shufflevector(lo, hi, 0, 1, 2, 3, 4, 5, 6, 7);
            oacc = MFMA16(vf, pf[kb], oacc);
        }
        v2u ow; ow.x = cvtpk(oacc[0] * inv, oacc[1] * inv); ow.y = cvtpk(oacc[2] * inv, oacc[3] * inv);
        *(v2u*)(Og + 16 * c + 4 * g4) = ow;
    }
    if (g4 == 0) ((float*)(ws + WS_LSE))[((size_t)pi * MP + rowq) * 8 + h] = mx + __builtin_amdgcn_logf(ls);
    __syncthreads();
}

__device__ __forceinline__ void attn_sample_task(unsigned char* ws, const float* const* inp, float* out, int l, int task, int lane) {
    const int rs_ = task >> 3, h = task & 7, n = rs_ >> 3, t = rs_ & 7, row = MP + rs_;
    const unsigned qw = ((const unsigned*)((const bf16*)(ws + WS_Q) + (size_t)row * AW + h * 128))[lane];
    const float q0 = bf_lo(qw), q1 = bf_hi(qw);
    float m = -3.0e38f, ls = 0.f, o0 = 0.f, o1 = 0.f;
#pragma nounroll
    for (int pi = 0; pi < 3; ++pi) {
        const int d = 1 << (2 * pi);
        const float* bt = (const float*)(ws + WS_BIAS) + (pi * 8 + h) * 129;
#pragma nounroll
        for (int jj = 0; jj <= 128; ++jj) {
            const int idx = 2048 + t - jj * d; const float *kp, *vp;
            if (idx < 2048) { const size_t off = ((((size_t)l * 8 + n) * 2048 + idx) * 8 + h) * 128; kp = inp[I_CK] + off; vp = inp[I_CV] + off; }
            else { const size_t off = (((size_t)l * 8 + n) * 8 + (idx - 2048)) * 1024 + h * 128; kp = out + O_NKS + off; vp = out + O_NVS + off; }
            const f32x2v kk = ((const f32x2v*)kp)[lane], vv = ((const f32x2v*)vp)[lane];
            const float s = wave_sum(q0 * kk.x + q1 * kk.y) + bt[jj];
            const float mn = fmaxf(m, s), al = exp2f(m - mn), p = exp2f(s - mn);
            ls = ls * al + p; o0 = o0 * al + p * vv.x; o1 = o1 * al + p * vv.y; m = mn;
        }
    }
    const float inv = 1.0f / ls; f32x2v ov; ov.x = o0 * inv; ov.y = o1 * inv;
    ((f32x2v*)((float*)(ws + WS_SATT) + (size_t)rs_ * AW + h * 128))[lane] = ov;
}

__device__ __forceinline__ void attn_combine_row(unsigned char* ws, const float* const* inp, int l, int row, int lane) {
    float o[16];
    if (row < MP) {
        const int h = lane >> 3; const float* L = (const float*)(ws + WS_LSE);
        const float l0 = L[((size_t)0 * MP + row) * 8 + h], l1 = L[((size_t)1 * MP + row) * 8 + h], l2 = L[((size_t)2 * MP + row) * 8 + h];
        const float mm = fmaxf(l0, fmaxf(l1, l2)); float w0 = exp2f(l0 - mm), w1 = exp2f(l1 - mm), w2 = exp2f(l2 - mm);
        const float is = 1.0f / (w0 + w1 + w2); w0 *= is; w1 *= is; w2 *= is;
        const bf16* O = (const bf16*)(ws + WS_OBUF);
#pragma unroll
        for (int half = 0; half < 2; ++half) {
            const v4u a = *(const v4u*)(O + ((size_t)0 * MP + row) * AW + 16 * lane + 8 * half), b = *(const v4u*)(O + ((size_t)1 * MP + row) * AW + 16 * lane + 8 * half),
                      c = *(const v4u*)(O + ((size_t)2 * MP + row) * AW + 16 * lane + 8 * half);
            o[8 * half + 0] = w0 * bf_lo(a.x) + w1 * bf_lo(b.x) + w2 * bf_lo(c.x); o[8 * half + 1] = w0 * bf_hi(a.x) + w1 * bf_hi(b.x) + w2 * bf_hi(c.x);
            o[8 * half + 2] = w0 * bf_lo(a.y) + w1 * bf_lo(b.y) + w2 * bf_lo(c.y); o[8 * half + 3] = w0 * bf_hi(a.y) + w1 * bf_hi(b.y) + w2 * bf_hi(c.y);
            o[8 * half + 4] = w0 * bf_lo(a.z) + w1 * bf_lo(b.z) + w2 * bf_lo(c.z); o[8 * half + 5] = w0 * bf_hi(a.z) + w1 * bf_hi(b.z) + w2 * bf_hi(c.z);
            o[8 * half + 6] = w0 * bf_lo(a.w) + w1 * bf_lo(b.w) + w2 * bf_lo(c.w); o[8 * half + 7] = w0 * bf_hi(a.w) + w1 * bf_hi(b.w) + w2 * bf_hi(c.w);
        }
    } else {
        const f32x4* S = (const f32x4*)((const float*)(ws + WS_SATT) + (size_t)(row - MP) * AW + 16 * lane);
#pragma unroll
        for (int k = 0; k < 4; ++k) { const f32x4 v = S[k]; o[4 * k] = v.x; o[4 * k + 1] = v.y; o[4 * k + 2] = v.z; o[4 * k + 3] = v.w; }
    }
    float ss = 0.f;
#pragma unroll
    for (int k = 0; k < 16; ++k) ss += o[k] * o[k];
    const float r = 1.0f / sqrtf(wave_sum(ss) * (1.0f / AW) + EPS);
    const f32x4* g = (const f32x4*)(inp[I_GMIXOUT] + l * DM + 16 * lane);
    v4u w0, w1; const f32x4 g0 = g[0], g1 = g[1], g2 = g[2], g3 = g[3];
    w0.x = pk2(o[0] * r * g0.x, o[1] * r * g0.y); w0.y = pk2(o[2] * r * g0.z, o[3] * r * g0.w); w0.z = pk2(o[4] * r * g1.x, o[5] * r * g1.y); w0.w = pk2(o[6] * r * g1.z, o[7] * r * g1.w);
    w1.x = pk2(o[8] * r * g2.x, o[9] * r * g2.y); w1.y = pk2(o[10] * r * g2.z, o[11] * r * g2.w); w1.z = pk2(o[12] * r * g3.x, o[13] * r * g3.y); w1.w = pk2(o[14] * r * g3.z, o[15] * r * g3.w);
    v4u* dst = (v4u*)((bf16*)(ws + WS_MIX) + (size_t)row * DM + 16 * lane); dst[0] = w0; dst[1] = w1;
}

constexpr int XW_STRIDE = 528, XW_BYTES = 16 * XW_STRIDE;
__device__ __forceinline__ void ssm_pass1_unit(LAS unsigned char* xw, unsigned char* ws, int l, int wu, int lane) {
    const int g = wu & 31, sc = (wu >> 5) & 15, n = wu >> 9, q = lane & 15, g4 = lane >> 4;
    const bf16* BB = (const bf16*)(ws + WS_BBF) + ((size_t)(l * 32 + g) * 8) * 512;
    bf16x8 bb[8];
#pragma unroll
    for (int mt = 0; mt < 8; ++mt) bb[mt] = *(const bf16x8*)(BB + (mt * 64 + lane) * 8);
    const float* ap = (const float*)(ws + WS_AP) + ((size_t)(l * 32 + g) * 64 + lane) * 8;
    const float are = ap[0], aim = ap[1];
    float hr = 0.f, hi_ = 0.f;
    const bf16* U = (const bf16*)(ws + WS_U); float* SL = (float*)(ws + WS_SLOC);
#pragma nounroll
    for (int tt = 0; tt < 16; ++tt) {
        const int row0 = n * SEQ + sc * 256 + tt * 16;
        bf16x8 uf = (bf16x8){0, 0, 0, 0, 0, 0, 0, 0};
        if (g4 < 2) uf = *(const bf16x8*)(U + (size_t)(row0 + q) * SW + g * 16 + 8 * g4);
#pragma unroll
        for (int mt = 0; mt < 8; ++mt) { const f32x4 dd = MFMA16(bb[mt], uf, ((f32x4){0.f, 0.f, 0.f, 0.f})); *(LAS f32x4*)(xw + q * XW_STRIDE + (16 * mt + 4 * g4) * 4) = dd; }
        asm volatile("s_waitcnt lgkmcnt(0)" ::: "memory");
#pragma unroll
        for (int t = 0; t < 16; ++t) { const float xr = *(const LAS float*)(xw + t * XW_STRIDE + lane * 4), xi = *(const LAS float*)(xw + t * XW_STRIDE + 256 + lane * 4);
            const float nr = are * hr - aim * hi_ + xr, ni = are * hi_ + aim * hr + xi; hr = nr; hi_ = ni; }
        asm volatile("s_waitcnt lgkmcnt(0)" ::: "memory");
        if (tt & 1) { f32x2v e; e.x = hr; e.y = hi_; ((f32x2v*)SL)[((((size_t)n * 16 + sc) * 8 + (tt >> 1)) * 32 + g) * 64 + lane] = e; }
    }
}
constexpr int YB_OFF = 8 * XW_BYTES, YB_STRIDE = 1040, RED_OFF = YB_OFF + 32 * YB_STRIDE;
constexpr int SSM2_UNITS = 264;
__device__ __forceinline__ void ssm_pass2_unit(LAS unsigned char* lds, unsigned char* ws, const float* const* inp, float* out, int l, int unit, int tid) {
    const int lane = tid & 63, w = __builtin_amdgcn_readfirstlane(tid >> 6), q = lane & 15, g4 = lane >> 4;
    const bool samp = unit >= 256;
    const int n = samp ? unit - 256 : unit >> 7, c32 = unit & 127;
    const int row0 = samp ? MP + n * 8 : n * SEQ + c32 * 32, ntile = samp ? 1 : 2;
    LAS unsigned char* xw = lds + w * XW_BYTES; LAS unsigned char* ybuf = lds + YB_OFF; LAS float* red = (LAS float*)(lds + RED_OFF);
    const bf16* U = (const bf16*)(ws + WS_U); const f32x2v* SL = (const f32x2v*)(ws + WS_SLOC);
#pragma nounroll
    for (int gi = 0; gi < 4; ++gi) {
        const int g = 4 * w + gi;
        const bf16* BB = (const bf16*)(ws + WS_BBF) + ((size_t)(l * 32 + g) * 8) * 512; const bf16* CFp = (const bf16*)(ws + WS_CF) + ((size_t)(l * 32 + g) * 4) * 512;
        const float* ap = (const float*)(ws + WS_AP) + ((size_t)(l * 32 + g) * 64 + lane) * 8;
        const float are = ap[0], aim = ap[1];
        float hr = 0.f, hi_ = 0.f;
        if (!samp) {
            const int sc = c32 >> 3, c2 = c32 & 7; const float a32r = ap[2], a32i = ap[3], a256r = ap[4], a256i = ap[5];
#pragma nounroll
            for (int s2 = 0; s2 < sc; ++s2) { const f32x2v e = SL[((((size_t)n * 16 + s2) * 8 + 7) * 32 + g) * 64 + lane];
                const float nr = a256r * hr - a256i * hi_ + e.x, ni = a256r * hi_ + a256i * hr + e.y; hr = nr; hi_ = ni; }
#pragma nounroll
            for (int k = 0; k < c2; ++k) { const float nr = a32r * hr - a32i * hi_, ni = a32r * hi_ + a32i * hr; hr = nr; hi_ = ni; }
            if (c2 > 0) { const f32x2v e = SL[((((size_t)n * 16 + sc) * 8 + (c2 - 1)) * 32 + g) * 64 + lane]; hr += e.x; hi_ += e.y; }
        } else { hr = inp[I_SRE][(((size_t)l * 8 + n) * 32 + g) * 64 + lane]; hi_ = inp[I_SIM][(((size_t)l * 8 + n) * 32 + g) * 64 + lane]; }
        const f32x4 dsk = *(const f32x4*)(inp[I_SSMD] + l * SW + 16 * g + 4 * g4);
#pragma nounroll
        for (int tt = 0; tt < ntile; ++tt) {
            const int rowt = row0 + tt * 16;
            bf16x8 uf = (bf16x8){0, 0, 0, 0, 0, 0, 0, 0};
            if (g4 < 2) uf = *(const bf16x8*)(U + (size_t)(rowt + q) * SW + g * 16 + 8 * g4);
#pragma unroll
            for (int mt = 0; mt < 8; ++mt) { const bf16x8 bbf = *(const bf16x8*)(BB + (mt * 64 + lane) * 8);
                const f32x4 dd = MFMA16(bbf, uf, ((f32x4){0.f, 0.f, 0.f, 0.f})); *(LAS f32x4*)(xw + q * XW_STRIDE + (16 * mt + 4 * g4) * 4) = dd; }
            asm volatile("s_waitcnt lgkmcnt(0)" ::: "memory");
#pragma unroll
            for (int t = 0; t < 16; ++t) { const float xr = *(const LAS float*)(xw + t * XW_STRIDE + lane * 4), xi = *(const LAS float*)(xw + t * XW_STRIDE + 256 + lane * 4);
                const float nr = are * hr - aim * hi_ + xr, ni = are * hi_ + aim * hr + xi; hr = nr; hi_ = ni;
                asm volatile("" ::: "memory");
                *(LAS bf16*)(xw + t * XW_STRIDE + lane * 2) = (bf16)f2bf(hr); *(LAS bf16*)(xw + t * XW_STRIDE + 128 + lane * 2) = (bf16)f2bf(hi_);
                if (samp && t == 7) { out[O_SRS + (((size_t)l * 8 + n) * 32 + g) * 64 + lane] = hr; out[O_SIS + (((size_t)l * 8 + n) * 32 + g) * 64 + lane] = hi_; } }
            asm volatile("s_waitcnt lgkmcnt(0)" ::: "memory");
            f32x4 yacc = (f32x4){0.f, 0.f, 0.f, 0.f};
#pragma unroll
            for (int ks = 0; ks < 4; ++ks) { const bf16x8 cf = *(const bf16x8*)(CFp + (ks * 64 + lane) * 8); const bf16x8 hf = *(const LAS bf16x8*)(xw + q * XW_STRIDE + (32 * ks + 8 * g4) * 2); yacc = MFMA16(cf, hf, yacc); }
            const v2u uw = *(const v2u*)(U + (size_t)(rowt + q) * SW + 16 * g + 4 * g4);
            const float y0 = yacc[0] + dsk.x * bf_lo(uw.x), y1 = yacc[1] + dsk.y * bf_hi(uw.x), y2 = yacc[2] + dsk.z * bf_lo(uw.y), y3 = yacc[3] + dsk.w * bf_hi(uw.y);
            v2u yw; yw.x = cvtpk(y0, y1); yw.y = cvtpk(y2, y3);
            *(LAS v2u*)(ybuf + (tt * 16 + q) * YB_STRIDE + (16 * g + 4 * g4) * 2) = yw;
            asm volatile("s_waitcnt lgkmcnt(0)" ::: "memory");
        }
        if (!samp && c32 == 127) { out[O_SRP + (((size_t)l * 2 + n) * 32 + g) * 64 + lane] = hr; out[O_SIP + (((size_t)l * 2 + n) * 32 + g) * 64 + lane] = hi_; }
    }
    __syncthreads();
    f32x4 acc[2][4];
#pragma unroll
    for (int mt = 0; mt < 2; ++mt)
#pragma unroll
        for (int nt = 0; nt < 4; ++nt) acc[mt][nt] = (f32x4){0.f, 0.f, 0.f, 0.f};
    const bf16* Wg = (const bf16*)(ws + WS_WGLU) + (size_t)l * 512 * 512;
#pragma unroll 2
    for (int ks = 0; ks < 16; ++ks) {
        bf16x8 af[2];
#pragma unroll
        for (int mt = 0; mt < 2; ++mt) af[mt] = *(const LAS bf16x8*)(ybuf + (16 * mt + q) * YB_STRIDE + (32 * ks + 8 * g4) * 2);
#pragma unroll
        for (int nt = 0; nt < 4; ++nt) { const bf16x8 bfr = *(const bf16x8*)(Wg + (size_t)(64 * w + 16 * nt + q) * 512 + 32 * ks + 8 * g4);
#pragma unroll
            for (int mt = 0; mt < 2; ++mt) acc[mt][nt] = MFMA16(bfr, af[mt], acc[mt][nt]); }
    }
#pragma unroll
    for (int mt = 0; mt < 2; ++mt) { const int t = 16 * mt + q; float ss = 0.f;
#pragma unroll
        for (int nt = 0; nt < 4; ++nt) { const int n0 = 64 * w + 16 * nt + 4 * g4; const f32x4 bg = *(const f32x4*)(inp[I_BGLU] + l * SW + n0);
            const v2u yw = *(const LAS v2u*)(ybuf + t * YB_STRIDE + n0 * 2);
            f32x4 o; o.x = bf_lo(yw.x) * pg8::fast_sigmoid(acc[mt][nt].x + bg.x); o.y = bf_hi(yw.x) * pg8::fast_sigmoid(acc[mt][nt].y + bg.y);
            o.z = bf_lo(yw.y) * pg8::fast_sigmoid(acc[mt][nt].z + bg.z); o.w = bf_hi(yw.y) * pg8::fast_sigmoid(acc[mt][nt].w + bg.w);
            acc[mt][nt] = o; ss += (o.x * o.x + o.y * o.y) + (o.z * o.z + o.w * o.w); }
        ss += __shfl_xor(ss, 16); ss += __shfl_xor(ss, 32);
        if (g4 == 0) red[t * 8 + w] = ss; }
    __syncthreads();
#pragma unroll
    for (int mt = 0; mt < 2; ++mt) { const int t = 16 * mt + q; const LAS f32x4* rp = (const LAS f32x4*)(red + t * 8); const f32x4 r0 = rp[0], r1 = rp[1];
        const float r = 1.0f / sqrtf(((r0.x + r0.y) + (r0.z + r0.w) + (r1.x + r1.y) + (r1.z + r1.w)) * (1.0f / SW) + EPS);
        const bool valid = !samp || t < 8;
        if (valid) {
#pragma unroll
            for (int nt = 0; nt < 4; ++nt) { const int n0 = 64 * w + 16 * nt + 4 * g4; const f32x4 gg = *(const f32x4*)(inp[I_GMIXOUT] + l * DM + 1024 + n0);
                v2u ow; ow.x = cvtpk(acc[mt][nt].x * r * gg.x, acc[mt][nt].y * r * gg.y); ow.y = cvtpk(acc[mt][nt].z * r * gg.z, acc[mt][nt].w * r * gg.w);
                *(v2u*)((bf16*)(ws + WS_MIX) + (size_t)(row0 + t) * DM + 1024 + n0) = ow; } } }
    __syncthreads();
}

constexpr int SGU_UNITS = 72, SGU_RED_OFF = LDS_X_OFF + 1024;
__device__ __forceinline__ void sgu_unit(LAS unsigned char* lds, unsigned char* ws, const float* const* inp, float* out, int l, int unit, int tid) {
    const int lane = tid & 63, w = __builtin_amdgcn_readfirstlane(tid >> 6), q = lane & 15, g4 = lane >> 4;
    const bool samp = unit >= 64;
    const int row0 = samp ? MP + 8 * (unit - 64) : (unit >> 5) * SEQ + (unit & 31) * 128, nrows = samp ? 8 : 128;
    LAS float* red = (LAS float*)(lds + SGU_RED_OFF);
    {
        const bf16* GVg = (const bf16*)(ws + WS_GV); const f32x4* sgp = (const f32x4*)(inp[I_SGUG] + l * GW + 8 * lane); const f32x4 sg0 = sgp[0], sg1 = sgp[1];
#pragma nounroll
        for (int k = 0; k < 16; ++k) { const int s = w + 8 * k; v4u pk = (v4u){0u, 0u, 0u, 0u};
            if (s < nrows) { const v4u raw = *(const v4u*)(GVg + (size_t)(row0 + s) * GW + 8 * lane);
                float x[8] = {bf_lo(raw.x), bf_hi(raw.x), bf_lo(raw.y), bf_hi(raw.y), bf_lo(raw.z), bf_hi(raw.z), bf_lo(raw.w), bf_hi(raw.w)};
                float sm = 0.f;
#pragma unroll
                for (int j = 0; j < 8; ++j) sm += x[j];
                const float mean = wave_sum(sm) * (1.0f / GW); float qq = 0.f;
#pragma unroll
                for (int j = 0; j < 8; ++j) { x[j] -= mean; qq += x[j] * x[j]; }
                const float rstd = 1.0f / sqrtf(wave_sum(qq) * (1.0f / GW) + EPS);
                x[0] *= rstd * sg0.x; x[1] *= rstd * sg0.y; x[2] *= rstd * sg0.z; x[3] *= rstd * sg0.w; x[4] *= rstd * sg1.x; x[5] *= rstd * sg1.y; x[6] *= rstd * sg1.z; x[7] *= rstd * sg1.w;
                if (samp) { f32x4* od = (f32x4*)(out + O_SGV + ((size_t)l * 64 + (row0 + s - MP)) * GW + 8 * lane); od[0] = (f32x4){x[0], x[1], x[2], x[3]}; od[1] = (f32x4){x[4], x[5], x[6], x[7]}; }
                pk.x = pk2(x[0], x[1]); pk.y = pk2(x[2], x[3]); pk.z = pk2(x[4], x[5]); pk.w = pk2(x[6], x[7]); }
            *(LAS v4u*)(lds + (lane >> 4) * 32768 + off_b(s, lane & 15)) = pk; }
    }
    __syncthreads();
    const int hh = w >> 1, th = w & 1;
    LAS unsigned char* img = lds + hh * 32768;
    const bf16* Wm = (const bf16*)(ws + WS_WM) + ((size_t)(l * 4 + hh) * 128) * 128;
    const bf16* GUg = (const bf16*)(ws + WS_GU);
#pragma nounroll
    for (int mp = 0; mp < 2; ++mp) {
        f32x4 acc[2][8];
#pragma unroll
        for (int m2 = 0; m2 < 2; ++m2)
#pragma unroll
            for (int c = 0; c < 8; ++c) acc[m2][c] = (f32x4){0.f, 0.f, 0.f, 0.f};
#pragma nounroll
        for (int ks = 0; ks <= 2 * th + mp; ++ks) {
            bf16x8 gf[8];
#pragma unroll
            for (int c = 0; c < 8; ++c) { const s16x4 lo = vtr((lds_cptr)(img + tr_addr16(lane, c, ks, 0))), hi = vtr((lds_cptr)(img + tr_addr16(lane, c, ks, 1))); gf[c] = __builtin_shufflevector(lo, hi, 0, 1, 2, 3, 4, 5, 6, 7); }
#pragma unroll
            for (int m2 = 0; m2 < 2; ++m2) { const bf16x8 wf = *(const bf16x8*)(Wm + (size_t)(64 * th + 32 * mp + 16 * m2 + q) * 128 + 32 * ks + 8 * g4);
#pragma unroll
                for (int c = 0; c < 8; ++c) acc[m2][c] = MFMA16(gf[c], wf, acc[m2][c]); }
        }
#pragma unroll
        for (int m2 = 0; m2 < 2; ++m2) { const int tl = 64 * th + 32 * mp + 16 * m2 + q; const bool valid = tl < nrows; const float bias = inp[I_SGUB][((size_t)l * 4 + hh) * 128 + tl]; float ss = 0.f;
#pragma unroll
            for (int c = 0; c < 8; ++c) { v2u gw2 = (v2u){0u, 0u}; if (valid) gw2 = *(const v2u*)(GUg + (size_t)(row0 + tl) * GW + hh * 128 + 16 * c + 4 * g4);
                v2u ow; ow.x = cvtpk(bf_lo(gw2.x) * (acc[m2][c].x + bias), bf_hi(gw2.x) * (acc[m2][c].y + bias)); ow.y = cvtpk(bf_lo(gw2.y) * (acc[m2][c].z + bias), bf_hi(gw2.y) * (acc[m2][c].w + bias));
                const float o0 = bf_lo(ow.x), o1 = bf_hi(ow.x), o2 = bf_lo(ow.y), o3 = bf_hi(ow.y); ss += (o0 * o0 + o1 * o1) + (o2 * o2 + o3 * o3);
                if (valid) *(v2u*)((bf16*)(ws + WS_MIX) + (size_t)(row0 + tl) * DM + 1536 + hh * 128 + 16 * c + 4 * g4) = ow; }
            ss += __shfl_xor(ss, 16); ss += __shfl_xor(ss, 32);
            if (g4 == 0) red[tl * 4 + hh] = ss; }
    }
    __syncthreads();
#pragma nounroll
    for (int mt = 0; mt < 4; ++mt) { const int tl = 64 * th + 16 * mt + q; const f32x4 rr = *(const LAS f32x4*)(red + tl * 4);
        const float r = 1.0f / sqrtf(((rr.x + rr.y) + (rr.z + rr.w)) * (1.0f / GW) + EPS);
        if (tl < nrows) {
#pragma unroll
            for (int c = 0; c < 8; ++c) { const int ch = hh * 128 + 16 * c + 4 * g4; const f32x4 gg = *(const f32x4*)(inp[I_GMIXOUT] + l * DM + 1536 + ch);
                v2u* mp_ = (v2u*)((bf16*)(ws + WS_MIX) + (size_t)(row0 + tl) * DM + 1536 + ch); const v2u ow = *mp_;
                v2u nw; nw.x = cvtpk(bf_lo(ow.x) * r * gg.x, bf_hi(ow.x) * r * gg.y); nw.y = cvtpk(bf_lo(ow.y) * r * gg.z, bf_hi(ow.y) * r * gg.w); *mp_ = nw; } } }
    __syncthreads();
}

__device__ __forceinline__ void attn_row_naive(Frame& F, int l, int row) {
    const int lane = F.lane; const bool samp = row >= MP;
    const int n = samp ? ((row - MP) >> 3) : (row >> 12), t = samp ? ((row - MP) & 7) : (row & 4095);
    float ssq = 0.f; float* tmp = F_WS(float, WS_T) + (size_t)row * DM;
#pragma nounroll
    for (int h = 0; h < 8; ++h) {
        const unsigned qw = ((const unsigned*)(F_WS(bf16, WS_Q) + (size_t)row * AW + h * 128))[lane];
        const float q0 = bf_lo(qw), q1 = bf_hi(qw);
        float m = -3.0e38f, ls = 0.f, o0 = 0.f, o1 = 0.f;
#pragma nounroll
        for (int pi = 0; pi < 3; ++pi) {
            const int d = pi == 0 ? 1 : (pi == 1 ? 4 : 16);
            const float* bt = F_WS(float, WS_BIAS) + (pi * 8 + h) * 129;
#pragma nounroll
            for (int jj = 0; jj <= 128; ++jj) {
                float k0, k1, v0, v1;
                if (!samp) { const int tk = t - jj * d; if (tk < 0) break;
                    const size_t off = ((size_t)(n * SEQ + tk)) * AW + h * 128;
                    const unsigned kw = ((const unsigned*)(F_WS(bf16, WS_K) + off))[lane], vw = ((const unsigned*)(F_WS(bf16, WS_V) + off))[lane];
                    k0 = bf_lo(kw); k1 = bf_hi(kw); v0 = bf_lo(vw); v1 = bf_hi(vw);
                } else { const int idx = 2048 + t - jj * d; const float *kp, *vp;
                    if (idx < 2048) { const size_t off = ((((size_t)l * 8 + n) * 2048 + idx) * 8 + h) * 128; kp = F_IN(I_CK) + off; vp = F_IN(I_CV) + off; }
                    else { const size_t off = (((size_t)l * 8 + n) * 8 + (idx - 2048)) * 1024 + h * 128; kp = F.out + O_NKS + off; vp = F.out + O_NVS + off; }
                    const f32x2v kk = ((const f32x2v*)kp)[lane], vv = ((const f32x2v*)vp)[lane]; k0 = kk.x; k1 = kk.y; v0 = vv.x; v1 = vv.y; }
                const float s = wave_sum(q0 * k0 + q1 * k1) + bt[jj];
                const float mn = fmaxf(m, s), al = exp2f(m - mn), p = exp2f(s - mn);
                ls = ls * al + p; o0 = o0 * al + p * v0; o1 = o1 * al + p * v1; m = mn;
            }
        }
        const float inv = 1.0f / ls; o0 *= inv; o1 *= inv; ssq += o0 * o0 + o1 * o1;
        f32x2v ov; ov.x = o0; ov.y = o1; ((f32x2v*)(tmp + h * 128))[lane] = ov;
    }
    const float r = 1.0f / sqrtf(wave_sum(ssq) * (1.0f / AW) + EPS);
    const float* g = F_IN(I_GMIXOUT) + l * DM;
#pragma nounroll
    for (int h = 0; h < 8; ++h) { const int col = h * 128 + 2 * lane; const f32x2v ov = ((const f32x2v*)(tmp + h * 128))[lane];
        ((unsigned*)(F_WS(bf16, WS_MIX) + (size_t)row * DM + col))[0] = pk2(ov.x * r * g[col], ov.y * r * g[col + 1]); }
}

__device__ __forceinline__ void ssm_seq_naive(Frame& F, int l, int seq, int g) {
    const int p = F.lane; const bool samp = seq >= 2; const int n = samp ? seq - 2 : seq;
    const int L = samp ? 8 : SEQ, row0 = samp ? MP + n * 8 : n * SEQ;
    const size_t gp = ((size_t)l * 32 + g) * 64 + p;
    const float lr = F_IN(I_LAMRE)[gp], li = F_IN(I_LAMIM)[gp], step = expf(F_IN(I_LOGSTEP)[l * 32 + g]);
    const float mag = expf(lr * step), are = mag * cosf(li * step), aim = mag * sinf(li * step);
    const float den = lr * lr + li * li, cre_ = ((are - 1.0f) * lr + aim * li) / den, cim_ = (aim * lr - (are - 1.0f) * li) / den;
    float bbr[16], bbi[16], ccr[16], cci[16];
#pragma unroll
    for (int c = 0; c < 16; ++c) { const float br = F_IN(I_BRE)[gp * 16 + c], bi = F_IN(I_BIM)[gp * 16 + c];
        bbr[c] = cre_ * br - cim_ * bi; bbi[c] = cre_ * bi + cim_ * br;
        ccr[c] = F_IN(I_CRE)[(((size_t)l * 32 + g) * 16 + c) * 64 + p]; cci[c] = F_IN(I_CIM)[(((size_t)l * 32 + g) * 16 + c) * 64 + p]; }
    float hr = 0.f, hi = 0.f;
    if (samp) { hr = F_IN(I_SRE)[(((size_t)l * 8 + n) * 32 + g) * 64 + p]; hi = F_IN(I_SIM)[(((size_t)l * 8 + n) * 32 + g) * 64 + p]; }
    const float dsk = (p < 16) ? F_IN(I_SSMD)[l * SW + g * 16 + p] : 0.f;
#pragma nounroll
    for (int t = 0; t < L; ++t) {
        const int row = row0 + t;
        const v4u ua = *(const v4u*)(F_WS(bf16, WS_U) + (size_t)row * SW + g * 16), ub = *(const v4u*)(F_WS(bf16, WS_U) + (size_t)row * SW + g * 16 + 8);
        float u[16];
        u[0] = bf_lo(ua.x); u[1] = bf_hi(ua.x); u[2] = bf_lo(ua.y); u[3] = bf_hi(ua.y); u[4] = bf_lo(ua.z); u[5] = bf_hi(ua.z); u[6] = bf_lo(ua.w); u[7] = bf_hi(ua.w);
        u[8] = bf_lo(ub.x); u[9] = bf_hi(ub.x); u[10] = bf_lo(ub.y); u[11] = bf_hi(ub.y); u[12] = bf_lo(ub.z); u[13] = bf_hi(ub.z); u[14] = bf_lo(ub.w); u[15] = bf_hi(ub.w);
        float xr = 0.f, xi = 0.f;
#pragma unroll
        for (int c = 0; c < 16; ++c) { xr += bbr[c] * u[c]; xi += bbi[c] * u[c]; }
        const float nhr = are * hr - aim * hi + xr, nhi = are * hi + aim * hr + xi; hr = nhr; hi = nhi;
        float ymine = 0.f;
#pragma unroll
        for (int c = 0; c < 16; ++c) { const float yc = wave_sum(ccr[c] * hr - cci[c] * hi) + 0.f; if (p == c) ymine = yc + dsk * u[c]; }
        if (p < 16) F_WS(float, WS_Y)[(size_t)row * SW + g * 16 + p] = ymine;
    }
    if (!samp) { F.out[O_SRP + (((size_t)l * 2 + n) * 32 + g) * 64 + p] = hr; F.out[O_SIP + (((size_t)l * 2 + n) * 32 + g) * 64 + p] = hi; }
    else { F.out[O_SRS + (((size_t)l * 8 + n) * 32 + g) * 64 + p] = hr; F.out[O_SIS + (((size_t)l * 8 + n) * 32 + g) * 64 + p] = hi; }
}

__device__ __forceinline__ void glu_row_naive(Frame& F, int l, int row) {
    const int lane = F.lane; const float* yrow = F_WS(float, WS_Y) + (size_t)row * SW; const float* W = F_IN(I_WGLU) + (size_t)l * SW * SW;
    float acc[8];
#pragma unroll
    for (int i = 0; i < 8; ++i) acc[i] = F_IN(I_BGLU)[l * SW + lane + 64 * i];
#pragma nounroll
    for (int k = 0; k < SW; ++k) { const float yk = yrow[k];
#pragma unroll
        for (int i = 0; i < 8; ++i) acc[i] += yk * W[(size_t)k * SW + lane + 64 * i]; }
    float o[8]; float ss = 0.f;
#pragma unroll
    for (int i = 0; i < 8; ++i) { o[i] = yrow[lane + 64 * i] * (1.0f / (1.0f + expf(-acc[i]))); ss += o[i] * o[i]; }
    const float r = 1.0f / sqrtf(wave_sum(ss) * (1.0f / SW) + EPS);
    const float* g = F_IN(I_GMIXOUT) + l * DM + 1024;
#pragma unroll
    for (int i = 0; i < 8; ++i) F_WS(bf16, WS_MIX)[(size_t)row * DM + 1024 + lane + 64 * i] = (bf16)f2bf(o[i] * r * g[lane + 64 * i]);
}

__device__ __forceinline__ void sgu_row_naive(Frame& F, int l, int row) {
    const int lane = F.lane; const bool samp = row >= MP;
    const int t = samp ? ((row - MP) & 7) : (row & 4095), tl = samp ? t : (t & 127), rowc = row - tl;
    float acc[8];
#pragma unroll
    for (int i = 0; i < 8; ++i) acc[i] = 0.f;
    const float* sg = F_IN(I_SGUG) + l * GW;
#pragma nounroll
    for (int sl = 0; sl <= tl; ++sl) {
        const int srow = rowc + sl; float xv[8]; float s = 0.f;
#pragma unroll
        for (int i = 0; i < 8; ++i) { xv[i] = bf2f(F_WS(bf16, WS_GV)[(size_t)srow * GW + lane + 64 * i]); s += xv[i]; }
        const float mean = wave_sum(s) * (1.0f / GW); float q = 0.f;
#pragma unroll
        for (int i = 0; i < 8; ++i) { xv[i] -= mean; q += xv[i] * xv[i]; }
        const float rstd = 1.0f / sqrtf(wave_sum(q) * (1.0f / GW) + EPS);
#pragma unroll
        for (int i = 0; i < 8; ++i) { const float gvv = xv[i] * rstd * sg[lane + 64 * i];
            const float w = F_IN(I_SGUW)[(((size_t)l * 4 + (i >> 1)) * 128 + tl) * 128 + sl];
            acc[i] += w * gvv;
            if (samp && sl == tl) F.out[O_SGV + ((size_t)l * 64 + (row - MP)) * GW + lane + 64 * i] = gvv; }
    }
    float o[8]; float ss = 0.f;
#pragma unroll
    for (int i = 0; i < 8; ++i) { const float mixed = acc[i] + F_IN(I_SGUB)[((size_t)l * 4 + (i >> 1)) * 128 + tl];
        o[i] = bf2f(F_WS(bf16, WS_GU)[(size_t)row * GW + lane + 64 * i]) * mixed; ss += o[i] * o[i]; }
    const float r = 1.0f / sqrtf(wave_sum(ss) * (1.0f / GW) + EPS);
    const float* g = F_IN(I_GMIXOUT) + l * DM + 1536;
#pragma unroll
    for (int i = 0; i < 8; ++i) F_WS(bf16, WS_MIX)[(size_t)row * DM + 1536 + lane + 64 * i] = (bf16)f2bf(o[i] * r * g[lane + 64 * i]);
}

struct ArgsN { const float* in[30]; float* out; unsigned char* ws; int l, pad; };
__global__ void __launch_bounds__(512) k_p2_naive(ArgsN a) {
    const int l = a.l, lane = threadIdx.x & 63, gw = blockIdx.x * 8 + (threadIdx.x >> 6), NGW = gridDim.x * 8; const float* const* inp = a.in; float* out = a.out; unsigned char* ws = a.ws;
    Frame F; F.lds = nullptr; F.MISC = nullptr; F.ctl = nullptr; F.tid = 0; F.lane = lane; F.wave = 0; F.vcu = 0; F.G = 0; F.inp = inp; F.out = out; F.ws = ws;
#if !FAST_SSM
    for (int k = gw; k < 320 * 6; k += NGW) if (k % 6 == 0) { const int task = k / 6; ssm_seq_naive(F, l, task / 32, task % 32); }
#endif
#if !FAST_ATTN
    for (int row = gw; row < MREAL; row += NGW) attn_row_naive(F, l, row);
#endif
#if !FAST_SGU
    for (int row = gw; row < MREAL; row += NGW) sgu_row_naive(F, l, row);
#endif
}
__global__ void __launch_bounds__(512, 2) k_p2_fast(ArgsN a) {
    extern __shared__ __attribute__((aligned(16))) unsigned char ldsf[];
    const int tid = threadIdx.x, lane = tid & 63, gw = blockIdx.x * 8 + (tid >> 6), NGW = gridDim.x * 8; (void)lane; (void)gw; (void)NGW;
#if FAST_ATTN
    for (int u = blockIdx.x; u < ATT_UNITS; u += gridDim.x) attn_unit((LAS unsigned char*)ldsf, a.ws, u, tid);
    for (int task = gw; task < 512; task += NGW) attn_sample_task(a.ws, a.in, a.out, a.l, task, lane);
#endif
#if FAST_SGU
    __syncthreads();
    for (int u = blockIdx.x; u < SGU_UNITS; u += gridDim.x) sgu_unit((LAS unsigned char*)ldsf, a.ws, a.in, a.out, a.l, u, tid);
#endif
#if FAST_SSM
    __syncthreads();
    for (int wu = gw; wu < 1024; wu += NGW) ssm_pass1_unit((LAS unsigned char*)ldsf + (tid >> 6) * XW_BYTES, a.ws, a.l, wu, lane);
#endif
}
__global__ void __launch_bounds__(512, 2) k_p3_fast(ArgsN a) {
    extern __shared__ __attribute__((aligned(16))) unsigned char ldsf[];
    const int tid = threadIdx.x, lane = tid & 63, gw = blockIdx.x * 8 + (tid >> 6), NGW = gridDim.x * 8; (void)lane; (void)gw; (void)NGW;
#if FAST_ATTN
    for (int row = gw; row < MREAL; row += NGW) attn_combine_row(a.ws, a.in, a.l, row, lane);
#endif
#if FAST_SSM
    __syncthreads();
    for (int u = blockIdx.x; u < SSM2_UNITS; u += gridDim.x) ssm_pass2_unit((LAS unsigned char*)ldsf, a.ws, a.in, a.out, a.l, u, tid);
#endif
}
__global__ void __launch_bounds__(512) k_p3_naive(ArgsN a) {
    const int l = a.l, lane = threadIdx.x & 63, gw = blockIdx.x * 8 + (threadIdx.x >> 6), NGW = gridDim.x * 8; const float* const* inp = a.in; float* out = a.out; unsigned char* ws = a.ws;
    Frame F; F.lds = nullptr; F.MISC = nullptr; F.ctl = nullptr; F.tid = 0; F.lane = lane; F.wave = 0; F.vcu = 0; F.G = 0; F.inp = inp; F.out = out; F.ws = ws;
#if !FAST_SSM
    for (int row = gw; row < MREAL; row += NGW) glu_row_naive(F, l, row);
#endif
}

struct Args { const float* in[30]; float* out; unsigned char* ws; int ph_lo, ph_hi, li, pad; };
__global__ void __launch_bounds__(NWAVES * 64, 2) fwd(Args args) {
    extern __shared__ __attribute__((aligned(16))) unsigned char lds[];
    Frame F;
    F.lds = (LAS unsigned char*)lds;
    F.MISC = (volatile LAS unsigned*)(F.lds + MISC_OFF);
    F.tid = threadIdx.x; F.lane = F.tid & 63; F.wave = __builtin_amdgcn_readfirstlane(F.tid >> 6);
    F.G = gridDim.x; { const int bx = blockIdx.x; F.vcu = (F.G % 8 == 0) ? (bx % 8) * (F.G / 8) + bx / 8 : bx; }
    unsigned char* ws = args.ws;
    F.ctl = (gu32*)(ws + WS_CTL);
    F.inp = args.in; F.out = args.out; F.ws = ws;
    for (int u = F.tid; u < (LDS_BYTES - LDSCTL_OFF) / 4; u += NWAVES * 64) ((LAS unsigned*)(F.lds + LDSCTL_OFF))[u] = 0u;
    __syncthreads();
    XcdBarrier bar; bar.bar = (unsigned*)(F.ctl + CW_BAR); bar.x = 0; bar.st = nullptr;
    if (!MK_PER_PHASE) bar = xcd_barrier_post((unsigned*)(F.ctl + CW_BAR), F.MISC + 8);
#define GRID_BAR() do { if (!MK_PER_PHASE) xcd_barrier(bar); } while (0)
    const int lo = args.ph_lo, hi = args.ph_hi;
#define IN(k) (lo <= (k) && (k) < hi)
#define BOTH(k) (IN(k) && IN((k) + 1))
    const int gw = F.vcu * NWAVES + F.wave, NGW = F.G * NWAVES;

    if (IN(0)) { p0_prologue(F); if (BOTH(0)) GRID_BAR(); }

    for (int l = 0; l < DEPTH; ++l) {
        const int pb = 1 + 8 * l;
        if (IN(pb + 0)) {
            pg8::Gemm g{F_WS(bf16, WS_XN), F_WS(bf16, WS_WIN) + (size_t)l * INC * DM, MTOT, INC, DM}; pg8::StaticOrder S; S.init(MTOT, INC, F.G, (int)blockIdx.x);
            pg8::EpiIn E{F.ws, F.out, l};
            pg8::gemm_phase<pg8::EpiIn, pg8::StaticOrder, true, true>(F.lds + RING_OFF, g, S, E);
            if (BOTH(pb + 0)) GRID_BAR();
        }
        if (IN(pb + 1)) {
#if MK_FUSED_MIXERS
            { int tl_ = threadIdx.x; asm volatile("" : "+v"(tl_));
              const int ln_ = tl_ & 63;
              for (int u = (int)blockIdx.x; u < ATT_UNITS; u += F.G) attn_unit(F.lds, F.ws, u, tl_);
              if (gw >= 512 && gw < 1024) attn_sample_task(F.ws, F.inp, F.out, l, gw - 512, ln_);
              __syncthreads();
              for (int u = F.G - 1 - (int)blockIdx.x; u < SGU_UNITS; u += F.G) sgu_unit(F.lds, F.ws, F.inp, F.out, l, u, tl_);
              __syncthreads();
              for (int wu = NGW - 1 - gw; wu < 1024; wu += NGW) ssm_pass1_unit(F.lds + (tl_ >> 6) * XW_BYTES, F.ws, l, wu, ln_); }
#endif
            if (BOTH(pb + 1)) GRID_BAR();
        }
        if (IN(pb + 2)) {
#if MK_FUSED_MIXERS
            { int tl_ = threadIdx.x; asm volatile("" : "+v"(tl_));
              const int ln_ = tl_ & 63;
              for (int row = gw; row < MREAL; row += NGW) attn_combine_row(F.ws, F.inp, l, row, ln_);
              __syncthreads();
              for (int u = (int)blockIdx.x; u < SSM2_UNITS; u += F.G) ssm_pass2_unit(F.lds, F.ws, F.inp, F.out, l, u, tl_); }
#endif
            if (BOTH(pb + 2)) GRID_BAR();
        }
        if (IN(pb + 3)) {
            pg8::Gemm g{F_WS(bf16, WS_MIX), F_WS(bf16, WS_WOUT) + (size_t)l * DM * DM, MTOT, DM, DM}; pg8::StaticOrder S; S.init(MTOT, DM, F.G, (int)blockIdx.x);
            pg8::EpiF32 E{F_WS(float, WS_T), DM};
            pg8::gemm_phase<pg8::EpiF32, pg8::StaticOrder, true, true>(F.lds + RING_OFF, g, S, E);
            if (BOTH(pb + 3)) GRID_BAR();
        }
        if (IN(pb + 4)) { norm_rows(F, F_IN(I_GPOSTMIX) + l * DM); if (BOTH(pb + 4)) GRID_BAR(); }
        if (IN(pb + 5)) {
            pg8::Gemm g{F_WS(bf16, WS_XN), F_WS(bf16, WS_WGU) + (size_t)l * FF2 * DM, MTOT, FF2, DM}; pg8::StaticOrder S; S.init(MTOT, FF2, F.G, (int)blockIdx.x);
            pg8::EpiGU E{F.ws};
            pg8::gemm_phase<pg8::EpiGU, pg8::StaticOrder, true, true>(F.lds + RING_OFF, g, S, E);
            if (BOTH(pb + 5)) GRID_BAR();
        }
        if (IN(pb + 6)) {
            pg8::Gemm g{F_WS(bf16, WS_H), F_WS(bf16, WS_WDN) + (size_t)l * DM * FF, MTOT, DM, FF}; pg8::StaticOrder S; S.init(MTOT, DM, F.G, (int)blockIdx.x);
            pg8::EpiF32 E{F_WS(float, WS_T), DM};
            pg8::gemm_phase<pg8::EpiF32, pg8::StaticOrder, true, true>(F.lds + RING_OFF, g, S, E);
            if (BOTH(pb + 6)) GRID_BAR();
        }
        if (IN(pb + 7)) { norm_rows(F, F_IN(I_GPOSTFFN) + l * DM); if (BOTH(pb + 7)) GRID_BAR(); }
    }
#undef IN
#undef BOTH
}

extern "C" void kernel_launch(void* const* d_in, const int* in_sizes, int n_in, void* d_out, int out_size, void* d_ws, size_t ws_size, hipStream_t stream) {
    static int grid = 0;
    if (grid == 0) {
        if (n_in != 30 || out_size < (int)O_END || ws_size < WS_END) { fprintf(stderr, "kernel_launch: unexpected problem shape (n_in %d out %d ws %zu)\n", n_in, out_size, ws_size); grid = -1; return; }
        int dev = 0, cus = 0;
        if (hipGetDevice(&dev) != hipSuccess || hipDeviceGetAttribute(&cus, hipDeviceAttributeMultiprocessorCount, dev) != hipSuccess) { grid = -1; return; }
#if MK_PER_PHASE
        (void)hipFuncSetAttribute((const void*)k_p2_fast, hipFuncAttributeMaxDynamicSharedMemorySize, LDS_BYTES); (void)hipFuncSetAttribute((const void*)k_p3_fast, hipFuncAttributeMaxDynamicSharedMemorySize, LDS_BYTES);
#endif
        if (hipFuncSetAttribute((const void*)fwd, hipFuncAttributeMaxDynamicSharedMemorySize, LDS_BYTES) != hipSuccess) { fprintf(stderr, "kernel_launch: hipFuncSetAttribute failed\n"); grid = -1; return; }
        int per_cu = 0;
        if (hipOccupancyMaxActiveBlocksPerMultiprocessor(&per_cu, (const void*)fwd, NWAVES * 64, LDS_BYTES) != hipSuccess || per_cu < 1) { fprintf(stderr, "kernel_launch: occupancy query says %d\n", per_cu); }
        (void)hipGetLastError();
        grid = cus;
    }
    if (grid < 0) return;
    if (hipMemsetAsync((char*)d_ws + WS_CTL, 0, CTL_ZERO_BYTES, stream) != hipSuccess) return;
    Args a{};
    for (int i = 0; i < 30; ++i) a.in[i] = (const float*)d_in[i];
    a.out = (float*)d_out; a.ws = (unsigned char*)d_ws; a.li = 0; a.pad = 0;
#if MK_PER_PHASE
    ArgsN an{}; for (int i = 0; i < 30; ++i) an.in[i] = (const float*)d_in[i]; an.out = (float*)d_out; an.ws = (unsigned char*)d_ws;
    for (int p = 0; p < N_PHASES; ++p) {
        const int k = (p == 0) ? -1 : (p - 1) % 8, l = (p - 1) / 8;
        if (k == 1) { an.l = l; hipLaunchKernelGGL(k_p2_naive, dim3(256), dim3(512), 0, stream, an); hipLaunchKernelGGL(k_p2_fast, dim3(256), dim3(512), LDS_BYTES, stream, an); }
        else if (k == 2) { an.l = l; hipLaunchKernelGGL(k_p3_naive, dim3(256), dim3(512), 0, stream, an); hipLaunchKernelGGL(k_p3_fast, dim3(256), dim3(512), LDS_BYTES, stream, an); }
        else { a.ph_lo = p; a.ph_hi = p + 1; hipLaunchKernelGGL(fwd, dim3(grid), dim3(NWAVES * 64), LDS_BYTES, stream, a); }
    }
#else
    a.ph_lo = 0; a.ph_hi = N_PHASES;
    hipLaunchKernelGGL(fwd, dim3(grid), dim3(NWAVES * 64), LDS_BYTES, stream, a);
#endif
}
```

```cpp
#include <hip/hip_runtime.h>
#include <cstdio>
#include <cstdint>
#define MK_PER_PHASE 0
#define FAST_ATTN 1
#define FAST_SSM 1
#define FAST_SGU 1
constexpr int NWAVES = 8;
#ifndef MK_PER_PHASE
#define MK_PER_PHASE 0
#endif
constexpr int DM = 2048, MP = 8192, MS = 64, MREAL = 8256, MTOT = 8448, SEQ = 4096;
constexpr int AW = 1024, SW = 512, GW = 512, INC = 4608, FF = 5632, FF2 = 11264, DEPTH = 4;
constexpr int N_PHASES = 1 + 8 * DEPTH;
constexpr float EPS = 1e-6f;
constexpr float LOG2E = 1.4426950408889634f;
constexpr float QSCALE = 0.08838834764831845f * 1.4426950408889634f;

constexpr size_t O_YP = 0, O_YS = 16777216, O_NKP = 16908288, O_NVP = 33685504, O_SRP = 50462720, O_SIP = 50479104, O_NKS = 50495488,
                 O_NVS = 50757632, O_SRS = 51019776, O_SIS = 51085312, O_SGV = 51150848, O_END = 51281920;
constexpr size_t MiB = 1u << 20;
constexpr size_t WS_CTL = 0, CTL_ZERO_BYTES = 1 * MiB;
constexpr size_t WS_WIN = 1 * MiB, SZ_WIN = (size_t)INC * DM * 2;
constexpr size_t WS_WOUT = WS_WIN + DEPTH * SZ_WIN, SZ_WOUT = (size_t)DM * DM * 2;
constexpr size_t WS_WGU = WS_WOUT + DEPTH * SZ_WOUT, SZ_WGU = (size_t)FF2 * DM * 2;
constexpr size_t WS_WDN = WS_WGU + DEPTH * SZ_WGU, SZ_WDN = (size_t)DM * FF * 2;
constexpr size_t WS_XN = WS_WDN + DEPTH * SZ_WDN;
constexpr size_t WS_Q = WS_XN + (size_t)MTOT * DM * 2;
constexpr size_t WS_K = WS_Q + (size_t)MTOT * AW * 2;
constexpr size_t WS_V = WS_K + (size_t)MTOT * AW * 2;
constexpr size_t WS_U = WS_V + (size_t)MTOT * AW * 2;
constexpr size_t WS_GU = WS_U + (size_t)MTOT * SW * 2;
constexpr size_t WS_GV = WS_GU + (size_t)MTOT * GW * 2;
constexpr size_t WS_MIX = WS_GV + (size_t)MTOT * GW * 2;
constexpr size_t WS_T = WS_MIX + (size_t)MTOT * DM * 2;
constexpr size_t WS_H = WS_T + (size_t)MTOT * DM * 4;
constexpr size_t WS_Y = WS_H + (size_t)MTOT * FF * 2;
constexpr size_t WS_RS = WS_Y + (size_t)MTOT * SW * 4;
constexpr size_t WS_BIAS = WS_RS + 65536;
constexpr size_t WS_WGLU = WS_BIAS + 65536;
constexpr size_t WS_WM = WS_WGLU + (size_t)DEPTH * 512 * 512 * 2;
constexpr size_t WS_AP = WS_WM + (size_t)DEPTH * 4 * 128 * 128 * 2;
constexpr size_t WS_BBF = WS_AP + (size_t)DEPTH * 32 * 64 * 8 * 4;
constexpr size_t WS_CF = WS_BBF + (size_t)DEPTH * 32 * 8 * 64 * 8 * 2;
constexpr size_t WS_SLOC = WS_CF + (size_t)DEPTH * 32 * 4 * 64 * 8 * 2;
constexpr size_t WS_END = WS_SLOC + (size_t)2 * 16 * 8 * 32 * 64 * 2 * 4;
constexpr size_t WS_OBUF = WS_H;
constexpr size_t WS_LSE = WS_T;
constexpr size_t WS_SATT = WS_T + 1 * MiB;
static_assert((size_t)3 * 8192 * 1024 * 2 <= (size_t)MTOT * FF * 2 && (size_t)3 * 8192 * 8 * 4 <= MiB, "overlays");
static_assert(WS_XN % 256 == 0 && WS_Q % 256 == 0 && WS_U % 256 == 0 && WS_MIX % 256 == 0 && WS_T % 256 == 0 && WS_H % 256 == 0 && WS_Y % 256 == 0 && WS_RS % 256 == 0, "ws alignment");
constexpr int CW_BAR = 4096;
constexpr int RING_OFF = 0, RING_BYTES = 131072;
constexpr int LDSCTL_OFF = RING_BYTES, MISC_OFF = LDSCTL_OFF + 320;
constexpr int LDS_BYTES = 147456;

namespace pg8 {
#define PG8_LAS __attribute__((address_space(3)))
typedef unsigned short bf16_t;
typedef short bf16x8 __attribute__((ext_vector_type(8)));
typedef float f32x4 __attribute__((ext_vector_type(4)));
typedef unsigned u32x4 __attribute__((ext_vector_type(4)));
constexpr int BM = 256, BK = 64, HALF = 128, HTB = HALF * BK * 2  , STAGE_BYTES = 8 * HTB, NXCD = 8, WGM = 8;

__host__ __device__ __forceinline__ int lds_byte(int r, int c) { const int st = (r >> 4) * 2 + (c >> 5), rr = r & 15, cc = c & 31, ob = rr * 64 + cc * 2; return st * 1024 + (ob ^ (((ob >> 9) & 1) << 5)); }
__host__ __device__ __forceinline__ void stage_rc(int b, int& R, int& C) { const int st = b / 1024, sb = b % 1024, swz = sb ^ (((sb >> 9) & 1) << 5); R = (st >> 1) * 16 + swz / 64; C = (st & 1) * 32 + (swz % 64) / 2; }
__host__ __device__ __forceinline__ int perm32(int rho) { const int n = rho >> 4, i = rho & 15; return 8 * (i >> 2) + 4 * n + (i & 3); }

struct Unit { int pm, pn; };
struct Gemm { const bf16_t* A; const bf16_t* Bt; int M, N, K; };

struct StaticOrder {
    int nM, nN, nwg, G, c;
    __host__ __device__ void init(int M, int N, int G_, int c_) { nM = M / BM; nN = N / BM; nwg = nM * nN; G = G_; c = c_; }
    __host__ __device__ bool next(int i, Unit& u) const {
        const long L = (long)i * G + c; if (L >= nwg) return false;
        int wgid = (int)L; { const int q = nwg / NXCD, r = nwg % NXCD, xcd = wgid % NXCD, off = wgid / NXCD; wgid = (xcd < r ? xcd * (q + 1) : r * (q + 1) + (xcd - r) * q) + off; }
        const int nig = WGM * nN, gid = wgid / nig, fm = gid * WGM, gsz = (nM - fm) < WGM ? (nM - fm) : WGM;
        u.pm = fm + ((wgid % nig) % gsz); u.pn = (wgid % nig) / gsz; return true;
    }
    __device__ __forceinline__ void a_ready(const Unit&) const {}
    __device__ __forceinline__ void done(const Unit&) const {}
};
__device__ __forceinline__ unsigned cvt_pk_bf16(float lo, float hi) { unsigned r; asm volatile("v_cvt_pk_bf16_f32 %0, %1, %2" : "=v"(r) : "v"(lo), "v"(hi)); return r; }
template <class Epi, class Sched, bool ALIGN_EPI = false, bool SP2 = false>
__device__ __forceinline__ void gemm_phase(PG8_LAS unsigned char* lds, const Gemm g, const Sched& S, const Epi& E) {
    int tid_raw = threadIdx.x; asm volatile("" : "+v"(tid_raw));
    const int tid = tid_raw, wid = __builtin_amdgcn_readfirstlane(tid >> 6), lane = tid & 63, wr = wid >> 2, wc = wid & 3, fr = lane & 15, fq = lane >> 4;
    const int K = g.K, nt = K / BK;
    unsigned voffA[2], voffB[2];
#pragma unroll
    for (int i = 0; i < 2; ++i) { int R, C; stage_rc(tid * 16 + i * 8192, R, C); const int Rb = Epi::PERM ? ((R & ~31) + perm32(R & 31)) : R;
        voffA[i] = (unsigned)(R * K + C) * 2u; voffB[i] = (unsigned)(Rb * K + C) * 2u; }
    const size_t kstep = (size_t)(BK * 2);
    const size_t hstep = (size_t)HALF * K * 2;
    const size_t tstep = 2 * hstep;
    const unsigned ldsw = (unsigned)wid * 1024u;
    const int aoff = lds_byte(wr * 64 + fr, fq * 8), boff = lds_byte(wc * 32 + fr, fq * 8);
#define PG8_SA(b, h) (((b) * 2 + (h)) * HTB)
#define PG8_SB(b, h) ((4 + (b) * 2 + (h)) * HTB)
#define PG8_STAGE(bufoff, gbase, voff) do { _Pragma("unroll") for (int _i = 0; _i < 2; ++_i) \
        __builtin_amdgcn_global_load_lds((const unsigned*)((const char*)(gbase) + (voff)[_i]), (PG8_LAS unsigned*)(lds + (bufoff) + ldsw + _i * 8192), 16, 0, 0); } while (0)
#define PG8_LDA(dst, b, h) do { _Pragma("unroll") for (int m = 0; m < 4; ++m) _Pragma("unroll") for (int k = 0; k < 2; ++k) dst[m][k] = *(const PG8_LAS bf16x8*)(lds + PG8_SA(b, h) + aoff + m * 2048 + k * 1024); } while (0)
#define PG8_LDB(dst, b, h) do { _Pragma("unroll") for (int n = 0; n < 2; ++n) _Pragma("unroll") for (int k = 0; k < 2; ++k) dst[n][k] = *(const PG8_LAS bf16x8*)(lds + PG8_SB(b, h) + boff + n * 2048 + k * 1024); } while (0)
#define PG8_MMA(ai, bj, At, Bt) do { __builtin_amdgcn_s_setprio(1); _Pragma("unroll") for (int m = 0; m < 4; ++m) _Pragma("unroll") for (int n = 0; n < 2; ++n) _Pragma("unroll") for (int k = 0; k < 2; ++k) \
        acc[ai][bj][m][n] = __builtin_amdgcn_mfma_f32_16x16x32_bf16(Bt[n][k], At[m][k], acc[ai][bj][m][n], 0, 0, 0); __builtin_amdgcn_s_setprio(0); } while (0)
#define PG8_WAIT_V(n) asm volatile("s_waitcnt vmcnt(" #n ")" ::: "memory")
#define PG8_WAIT_L(n) asm volatile("s_waitcnt lgkmcnt(" #n ")" ::: "memory")
#define PG8_BAR __builtin_amdgcn_s_barrier()
#define PG8_SCHED __builtin_amdgcn_sched_barrier(0)
    Unit cur, nxt; int ui = 0;
    if (!S.next(0, cur)) return;
    f32x4 acc[2][2][4][2];
#pragma unroll
    for (int a = 0; a < 2; ++a)
#pragma unroll
        for (int b = 0; b < 2; ++b)
#pragma unroll
            for (int m = 0; m < 4; ++m)
#pragma unroll
                for (int n = 0; n < 2; ++n) acc[a][b][m][n] = (f32x4){0.f, 0.f, 0.f, 0.f};
    bf16x8 At[4][2], B0[2][2], B1[2][2];
    const char* cA = (const char*)g.A + (size_t)cur.pm * tstep; const char* cB = (const char*)g.Bt + (size_t)cur.pn * tstep;
    S.a_ready(cur);
    if constexpr (SP2) {
        PG8_STAGE(PG8_SB(0, 0), cB, voffB); PG8_STAGE(PG8_SB(0, 1), cB + hstep, voffB); PG8_STAGE(PG8_SA(0, 0), cA, voffA); PG8_STAGE(PG8_SA(0, 1), cA + hstep, voffA);
        if (wr == 1) PG8_BAR;
        PG8_WAIT_V(2); PG8_BAR;
        PG8_STAGE(PG8_SB(1, 0), cB + kstep, voffB); PG8_STAGE(PG8_SA(1, 0), cA + kstep, voffA); PG8_STAGE(PG8_SB(1, 1), cB + hstep + kstep, voffB);
        PG8_WAIT_V(6); PG8_BAR;
    } else {
        PG8_STAGE(PG8_SB(0, 0), cB, voffB); PG8_STAGE(PG8_SA(0, 0), cA, voffA); PG8_STAGE(PG8_SB(0, 1), cB + hstep, voffB); PG8_STAGE(PG8_SA(0, 1), cA + hstep, voffA);
        if (wr == 1) PG8_BAR;
        PG8_WAIT_V(4); PG8_BAR;
        PG8_STAGE(PG8_SB(1, 0), cB + kstep, voffB); PG8_STAGE(PG8_SA(1, 0), cA + kstep, voffA); PG8_STAGE(PG8_SB(1, 1), cB + hstep + kstep, voffB);
        PG8_WAIT_V(6); PG8_BAR;
    }
    for (;;) {
        const bool has_next = S.next(ui + 1, nxt);
        const char* nA = has_next ? (const char*)g.A + (size_t)nxt.pm * tstep : cA; const char* nB = has_next ? (const char*)g.Bt + (size_t)nxt.pn * tstep : cB;
        for (int t = 0; t < nt; t += 2) {
            const bool last = (t == nt - 2);
            const char* a1 = cA + (size_t)(t + 1) * kstep;
            const char* a2 = last ? nA : cA + (size_t)(t + 2) * kstep; const char* b2 = last ? nB : cB + (size_t)(t + 2) * kstep;
            const char* a3 = a2 + kstep; const char* b3 = b2 + kstep;
            if (last && has_next) S.a_ready(nxt);
            if constexpr (SP2) {
            PG8_LDB(B0, 0, 0); PG8_LDB(B1, 0, 1); PG8_SCHED; PG8_LDA(At, 0, 0); PG8_STAGE(PG8_SA(1, 1), a1 + hstep, voffA);
            PG8_WAIT_V(8); PG8_WAIT_L(0); PG8_BAR; PG8_MMA(0, 0, At, B0); PG8_MMA(0, 1, At, B1); PG8_BAR; PG8_SCHED;
            PG8_LDA(At, 0, 1); PG8_STAGE(PG8_SB(0, 0), b2, voffB); PG8_STAGE(PG8_SB(0, 1), b2 + hstep, voffB); PG8_STAGE(PG8_SA(0, 0), a2, voffA);
            PG8_WAIT_V(8); PG8_WAIT_L(0); PG8_BAR; PG8_MMA(1, 0, At, B0); PG8_MMA(1, 1, At, B1); PG8_BAR; PG8_SCHED;
            PG8_LDB(B0, 1, 0); PG8_LDB(B1, 1, 1); PG8_SCHED; PG8_LDA(At, 1, 0); PG8_STAGE(PG8_SA(0, 1), a2 + hstep, voffA);
            PG8_WAIT_V(8); PG8_WAIT_L(0); PG8_BAR; PG8_MMA(0, 0, At, B0); PG8_MMA(0, 1, At, B1); PG8_BAR; PG8_SCHED;
            PG8_LDA(At, 1, 1); PG8_STAGE(PG8_SB(1, 0), b3, voffB); PG8_STAGE(PG8_SB(1, 1), b3 + hstep, voffB); PG8_STAGE(PG8_SA(1, 0), a3, voffA);
            PG8_WAIT_V(8); PG8_WAIT_L(0); PG8_BAR; PG8_MMA(1, 0, At, B0); PG8_MMA(1, 1, At, B1); PG8_BAR; PG8_SCHED;
            } else {
            PG8_LDB(B0, 0, 0); PG8_SCHED; PG8_LDA(At, 0, 0); PG8_STAGE(PG8_SA(1, 1), a1 + hstep, voffA);
            PG8_WAIT_L(8); PG8_BAR; PG8_WAIT_L(0); PG8_MMA(0, 0, At, B0); PG8_BAR; PG8_SCHED;
            PG8_LDB(B1, 0, 1); PG8_STAGE(PG8_SB(0, 0), b2, voffB);
            PG8_BAR; PG8_WAIT_L(0); PG8_MMA(0, 1, At, B1); PG8_BAR;
            PG8_LDA(At, 0, 1); PG8_STAGE(PG8_SA(0, 0), a2, voffA);
            PG8_BAR; PG8_WAIT_L(0); PG8_MMA(1, 0, At, B0); PG8_BAR; PG8_SCHED;
            PG8_STAGE(PG8_SB(0, 1), b2 + hstep, voffB);
            PG8_WAIT_V(6); PG8_BAR; PG8_MMA(1, 1, At, B1); PG8_BAR;
            PG8_LDB(B0, 1, 0); PG8_SCHED; PG8_LDA(At, 1, 0); PG8_STAGE(PG8_SA(0, 1), a2 + hstep, voffA);
            PG8_WAIT_L(8); PG8_BAR; PG8_WAIT_L(0); PG8_MMA(0, 0, At, B0); PG8_BAR; PG8_SCHED;
            PG8_LDB(B1, 1, 1); PG8_STAGE(PG8_SB(1, 0), b3, voffB);
            PG8_BAR; PG8_WAIT_L(0); PG8_MMA(0, 1, At, B1); PG8_BAR;
            PG8_LDA(At, 1, 1); PG8_STAGE(PG8_SA(1, 0), a3, voffA);
            PG8_BAR; PG8_WAIT_L(0); PG8_MMA(1, 0, At, B0); PG8_BAR; PG8_SCHED;
            PG8_STAGE(PG8_SB(1, 1), b3 + hstep, voffB);
            PG8_WAIT_V(6); PG8_BAR; PG8_MMA(1, 1, At, B1); PG8_BAR;
            }
        }
        if constexpr (ALIGN_EPI) { if (wr == 0) PG8_BAR; }
        if constexpr (!Epi::AFTER_DRAIN) { E(acc, cur, wr, wc, fr, fq); S.done(cur); }
        if (!has_next) break;
#pragma unroll
        for (int a = 0; a < 2; ++a)
#pragma unroll
            for (int b = 0; b < 2; ++b)
#pragma unroll
                for (int m = 0; m < 4; ++m)
#pragma unroll
                    for (int n = 0; n < 2; ++n) acc[a][b][m][n] = (f32x4){0.f, 0.f, 0.f, 0.f};
        cur = nxt; cA = nA; cB = nB; ++ui;
        if constexpr (ALIGN_EPI) { if (wr == 1) PG8_BAR; }
    }
    PG8_WAIT_V(0);
    if constexpr (!ALIGN_EPI) { if (wr == 0) PG8_BAR; }
    PG8_BAR;
    if constexpr (Epi::AFTER_DRAIN) { E.fused(acc, cur, wr, wc, fr, fq, lds, wid, lane); S.done(cur); }
#undef PG8_SA
#undef PG8_SB
#undef PG8_STAGE
#undef PG8_LDA
#undef PG8_LDB
#undef PG8_MMA
#undef PG8_WAIT_V
#undef PG8_WAIT_L
#undef PG8_BAR
#undef PG8_SCHED
}
}

namespace pg8 {
__device__ __forceinline__ float fast_sigmoid(float w) { return __builtin_amdgcn_rcpf(1.0f + __builtin_amdgcn_exp2f(-1.4426950408889634f * w)); }
__device__ __forceinline__ float gelu_tanh(float x) { return x * fast_sigmoid(1.5957691216057308f * (x + 0.044715f * x * x * x)); }

struct EpiF32 {
    static constexpr bool PERM = false, AFTER_DRAIN = false;
    float* C; int ldc;
    __device__ __forceinline__ void operator()(const f32x4 (&acc)[2][2][4][2], const Unit& u, int wr, int wc, int fr, int fq) const {
        const int row0 = u.pm * BM + wr * 64 + fr, col0 = u.pn * BM + wc * 32 + 4 * fq;
#pragma unroll
        for (int ai = 0; ai < 2; ++ai)
#pragma unroll
            for (int m = 0; m < 4; ++m) { float* rowp = C + (size_t)(row0 + ai * HALF + m * 16) * ldc + col0;
#pragma unroll
                for (int bj = 0; bj < 2; ++bj)
#pragma unroll
                    for (int n = 0; n < 2; ++n) *(f32x4*)(rowp + bj * HALF + n * 16) = acc[ai][bj][m][n]; }
    }
};

struct EpiIn {
    static constexpr bool PERM = true, AFTER_DRAIN = false;
    unsigned char* ws; float* out; int layer;
    __device__ __forceinline__ void operator()(const f32x4 (&acc)[2][2][4][2], const Unit& u, int wr, int wc, int fr, int fq) const {
        const int row0 = u.pm * BM + wr * 64 + fr;
        const int pn = u.pn;
#pragma unroll
        for (int ai = 0; ai < 2; ++ai)
#pragma unroll
            for (int m = 0; m < 4; ++m) {
                const int row = row0 + ai * HALF + m * 16;
                const float r = ((const float*)(ws + WS_RS))[row];
#pragma unroll
                for (int bj = 0; bj < 2; ++bj) {
                    f32x4 v0 = acc[ai][bj][m][0] * r, v1 = acc[ai][bj][m][1] * r;
                    const int col = pn * BM + bj * HALF + wc * 32 + 8 * fq;
                    bf16_t* dst;
                    if (pn < 4) dst = (bf16_t*)(ws + WS_Q) + (size_t)row * 1024 + col;
                    else if (pn < 8) dst = (bf16_t*)(ws + WS_K) + (size_t)row * 1024 + (col - 1024);
                    else if (pn < 12) dst = (bf16_t*)(ws + WS_V) + (size_t)row * 1024 + (col - 2048);
                    else if (pn < 14) dst = (bf16_t*)(ws + WS_U) + (size_t)row * 512 + (col - 3072);
                    else if (pn < 16) dst = (bf16_t*)(ws + WS_GU) + (size_t)row * 512 + (col - 3584);
                    else dst = (bf16_t*)(ws + WS_GV) + (size_t)row * 512 + (col - 4096);
                    if (pn >= 4 && pn < 12) {
                        const int c2 = (pn < 8) ? col - 1024 : col - 2048;
                        float* o = nullptr;
                        if (row < 8192) { const int b = row >> 12, t = row & 4095;
                            if (t >= 2048) o = out + ((pn < 8) ? O_NKP : O_NVP) + ((size_t)((layer * 2 + b) * 2048 + (t - 2048))) * 1024 + c2; }
                        else if (row < 8256) o = out + ((pn < 8) ? O_NKS : O_NVS) + ((size_t)(layer * 64 + (row - 8192))) * 1024 + c2;
                        if (o) { *(f32x4*)o = v0; *(f32x4*)(o + 4) = v1; }
                    }
                    if (pn >= 14) {
#pragma unroll
                        for (int j = 0; j < 4; ++j) { v0[j] = gelu_tanh(v0[j]); v1[j] = gelu_tanh(v1[j]); }
                    }
                    u32x4 w; w.x = cvt_pk_bf16(v0[0], v0[1]); w.y = cvt_pk_bf16(v0[2], v0[3]); w.z = cvt_pk_bf16(v1[0], v1[1]); w.w = cvt_pk_bf16(v1[2], v1[3]);
                    *(u32x4*)dst = w;
                }
            }
    }
};

struct EpiGU {
    static constexpr bool PERM = true, AFTER_DRAIN = false;
    unsigned char* ws;
    __device__ __forceinline__ void operator()(const f32x4 (&acc)[2][2][4][2], const Unit& u, int wr, int wc, int fr, int fq) const {
        const int row0 = u.pm * BM + wr * 64 + fr, j0 = u.pn * HALF + wc * 32 + 8 * fq;
#pragma unroll
        for (int ai = 0; ai < 2; ++ai)
#pragma unroll
            for (int m = 0; m < 4; ++m) {
                const int row = row0 + ai * HALF + m * 16;
                const float r = ((const float*)(ws + WS_RS))[row];
                float o[8];
#pragma unroll
                for (int n = 0; n < 2; ++n)
#pragma unroll
                    for (int j = 0; j < 4; ++j) { const float g = acc[ai][0][m][n][j] * r, up = acc[ai][1][m][n][j] * r; o[4 * n + j] = g * fast_sigmoid(g) * up; }
                u32x4 w; w.x = cvt_pk_bf16(o[0], o[1]); w.y = cvt_pk_bf16(o[2], o[3]); w.z = cvt_pk_bf16(o[4], o[5]); w.w = cvt_pk_bf16(o[6], o[7]);
                *(u32x4*)((bf16_t*)(ws + WS_H) + (size_t)row * 5632 + j0) = w;
            }
    }
};
}

#define GAS __attribute__((address_space(1)))
#define LAS __attribute__((address_space(3)))
typedef unsigned short bf16;
typedef unsigned v4u __attribute__((ext_vector_type(4)));
typedef unsigned v2u __attribute__((ext_vector_type(2)));
typedef float f32x4 __attribute__((ext_vector_type(4)));
typedef float f32x2v __attribute__((ext_vector_type(2)));
typedef short bf16x8 __attribute__((ext_vector_type(8)));
typedef GAS unsigned gu32;
#define RLX_AGENT __ATOMIC_RELAXED, __HIP_MEMORY_SCOPE_AGENT
#define LDS_WAIT() asm volatile("s_waitcnt lgkmcnt(0)" ::: "memory")
#define VM_WAIT() asm volatile("s_waitcnt vmcnt(0)" ::: "memory")
__device__ __forceinline__ unsigned f2bf(float f) { unsigned u = __builtin_bit_cast(unsigned, f); return (u + 0x7fffu + ((u >> 16) & 1u)) >> 16; }
__device__ __forceinline__ unsigned pk2(float lo, float hi) { return f2bf(lo) | (f2bf(hi) << 16); }
__device__ __forceinline__ float bf_lo(unsigned w) { return __builtin_bit_cast(float, w << 16); }
__device__ __forceinline__ float bf_hi(unsigned w) { return __builtin_bit_cast(float, w & 0xffff0000u); }
__device__ __forceinline__ float bf2f(bf16 b) { return __builtin_bit_cast(float, ((unsigned)b) << 16); }

#define XB_TMO      128
#define XB_XCNT(j)  (256  + 64 * (j))
#define XB_XSUB(j)  (1280 + 64 * (j))
#define XB_XGEN(j)  (2304 + 64 * (j))
#define XB_TOP      3328
#define XB_TOPGEN   3392
#define XCD_BAR_WORDS 3456
#define XB_SPIN_CAP (1u << 18)

__device__ __forceinline__ unsigned xb_ld(unsigned* p)              { return __hip_atomic_load(p, __ATOMIC_RELAXED, __HIP_MEMORY_SCOPE_AGENT); }
__device__ __forceinline__ unsigned xb_add(unsigned* p, unsigned v) { return __hip_atomic_fetch_add(p, v, __ATOMIC_RELAXED, __HIP_MEMORY_SCOPE_AGENT); }
__device__ __forceinline__ unsigned xb_xcc_id() { return (unsigned)__builtin_amdgcn_s_getreg((3 << 11) | 20) & 0xFu; }
#define XB_SPIN(cond, bar) do { unsigned _sp = 0; while (cond) { __builtin_amdgcn_s_sleep(1); \
    if ((++_sp & 255u) == 0u) { if (xb_ld(&(bar)[XB_TMO])) break; if (_sp > XB_SPIN_CAP) { atomicAdd(&(bar)[XB_TMO], 1u); break; } } } } while (0)

struct XcdBarrier {
    unsigned* bar; unsigned x;
    volatile LAS unsigned* st;
};

__device__ __forceinline__ XcdBarrier xcd_barrier_post(unsigned* bar, volatile LAS unsigned* st) {
    XcdBarrier b; b.bar = bar; b.x = xb_xcc_id(); b.st = st;
    if (threadIdx.x == 0) (void)xb_add(&bar[XB_XCNT(b.x)], 1u);
    return b;
}
__device__ __forceinline__ void xcd_barrier_complete(unsigned* bar, unsigned x, unsigned& nloc, unsigned& nx) {
    const unsigned G = gridDim.x * gridDim.y * gridDim.z;
    unsigned sum, cnt, mine, sp = 0u;
    for (;;) {
        sum = 0u; cnt = 0u; mine = 0u;
#pragma unroll
        for (unsigned j = 0; j < 16; ++j) { const unsigned c = xb_ld(&bar[XB_XCNT(j)]); sum += c; cnt += (c > 0u) ? 1u : 0u; mine = (j == x) ? c : mine; }
        if (sum == G) break;
        __builtin_amdgcn_s_sleep(1);
        if ((++sp & 255u) == 0u) { if (xb_ld(&bar[XB_TMO])) break; if (sp > XB_SPIN_CAP) { atomicAdd(&bar[XB_TMO], 1u); break; } }
    }
    nloc = mine > 0u ? mine : 1u; nx = cnt > 0u ? cnt : 1u;
}

__device__ __forceinline__ void xcd_barrier(const XcdBarrier& b) {
    asm volatile("s_waitcnt vmcnt(0)" ::: "memory");
    __syncthreads();
    if (threadIdx.x == 0) {
        unsigned* bar = b.bar;
        __builtin_amdgcn_s_waitcnt(0);
        unsigned nloc = b.st[0], nx = b.st[1];
        if (nloc == 0u) { xcd_barrier_complete(bar, b.x, nloc, nx); b.st[0] = nloc; b.st[1] = nx; }
        const unsigned old = xb_add(&bar[XB_XSUB(b.x)], 1u);
        const unsigned gen = old / nloc;
        if (old + 1u == (gen + 1u) * nloc) {
            __builtin_amdgcn_fence(__ATOMIC_RELEASE, "agent");
            asm volatile("s_waitcnt vmcnt(0)" ::: "memory");
            const unsigned og = xb_add(&bar[XB_TOP], 1u);
            const unsigned tg = og / nx;
            if (og + 1u == (tg + 1u) * nx) xb_add(&bar[XB_TOPGEN], 1u);
            else XB_SPIN(xb_ld(&bar[XB_TOPGEN]) == tg, bar);
            __builtin_amdgcn_fence(__ATOMIC_ACQUIRE, "agent");
            xb_add(&bar[XB_XGEN(b.x)], 1u);
            asm volatile("s_waitcnt vmcnt(0)" ::: "memory");
        } else {
            XB_SPIN(xb_ld(&bar[XB_XGEN(b.x)]) == gen, bar);
            __builtin_amdgcn_fence(__ATOMIC_ACQUIRE, "agent");
            asm volatile("s_waitcnt vmcnt(0)" ::: "memory");
        }
    }
    __syncthreads();
}


#ifndef MK_FUSED_MIXERS
#define MK_FUSED_MIXERS 1
#endif
#ifndef FAST_ATTN
#define FAST_ATTN 0
#endif
#ifndef FAST_SSM
#define FAST_SSM 0
#endif
#ifndef FAST_SGU
#define FAST_SGU 0
#endif
struct Frame {
    LAS unsigned char* lds;
    volatile LAS unsigned* MISC;
    gu32* ctl;
    int tid, lane, wave;
    int vcu, G;
    const float* const* inp;
    float* out;
    unsigned char* ws;
};
#define F_IN(k) (F.inp[(k)])
#define F_WS(type, off) ((type*)(F.ws + (off)))
enum { I_XP = 0, I_XS, I_CK, I_CV, I_SRE, I_SIM, I_RELB, I_WIN, I_WOUT, I_GPREMIX, I_GPOSTMIX, I_GMIXOUT, I_LAMRE, I_LAMIM, I_LOGSTEP, I_BRE, I_BIM, I_CRE, I_CIM,
       I_SSMD, I_WGLU, I_BGLU, I_SGUG, I_SGUW, I_SGUB, I_GPREFFN, I_GPOSTFFN, I_WGATE, I_WUP, I_WDOWN };

__device__ __forceinline__ float wave_sum(float v) {
#pragma unroll
    for (int o = 1; o < 64; o <<= 1) v += __shfl_xor(v, o);
    return v;
}

__device__ __forceinline__ void p0_transpose_item(const float* W, int K, int N, bf16* WT, LAS float* scr, int item, int lane, const float* kscale, float cscale, int cs_limit, int mode) {
    const int nblk = N / 32, kb = item / nblk, nb = item % nblk, k0 = 64 * kb, n0 = 32 * nb;
    const float cs = (n0 < cs_limit) ? cscale : 1.0f;
#pragma unroll 8
    for (int i = 0; i < 32; ++i) { const int kk = 2 * i + (lane >> 5); float v = W[(size_t)(k0 + kk) * N + n0 + (lane & 31)]; if (kscale) v *= kscale[k0 + kk]; scr[kk * 33 + (lane & 31)] = v * cs; }
    LDS_WAIT(); asm volatile("" ::: "memory");
    const int c = lane & 7;
#pragma unroll
    for (int j = 0; j < 4; ++j) { const int n = (lane >> 3) + 8 * j; const LAS float* s = scr + (8 * c) * 33 + n;
        v4u o; o.x = pk2(s[0 * 33], s[1 * 33]); o.y = pk2(s[2 * 33], s[3 * 33]); o.z = pk2(s[4 * 33], s[5 * 33]); o.w = pk2(s[6 * 33], s[7 * 33]);
        const int col = n0 + n; const int row = (mode == 0) ? col : (256 * (col >> 7) + (col & 127) + (mode == 2 ? 128 : 0));
        *(GAS v4u*)(WT + (size_t)row * K + k0 + 8 * c) = o; }
    LDS_WAIT(); asm volatile("" ::: "memory");
}
__device__ __forceinline__ int t5_bucket(int dist) {
    if (dist < 16) return dist;
    int large = 16 + (int)(logf((float)dist / 16.0f) / logf(128.0f) * 16.0f);
    return large < 31 ? large : 31;
}
__device__ __forceinline__ void p0_prologue(Frame& F) {
    LAS float* scr = (LAS float*)(F.lds + RING_OFF + F.wave * 16384);
    const int gw = F.vcu * NWAVES + F.wave, NGW = F.G * NWAVES;
    constexpr int I_IN = (DM / 64) * (INC / 32), I_OUT = (DM / 64) * (DM / 32), I_G = (DM / 64) * (FF / 32), I_D = (FF / 64) * (DM / 32);
    constexpr int I_GLU = (SW / 64) * (SW / 32);
    constexpr int PER_L = I_IN + I_OUT + 2 * I_G + I_D + I_GLU;
    for (int it = gw; it < DEPTH * PER_L; it += NGW) {
        const int l = it / PER_L; int r = it % PER_L;
        if (r < I_IN) { p0_transpose_item(F_IN(I_WIN) + (size_t)l * DM * INC, DM, INC, F_WS(bf16, WS_WIN) + (size_t)l * INC * DM, scr, r, F.lane, F_IN(I_GPREMIX) + l * DM, QSCALE, AW, 0); continue; } r -= I_IN;
        if (r < I_OUT) { p0_transpose_item(F_IN(I_WOUT) + (size_t)l * DM * DM, DM, DM, F_WS(bf16, WS_WOUT) + (size_t)l * DM * DM, scr, r, F.lane, nullptr, 1.f, 0, 0); continue; } r -= I_OUT;
        if (r < I_G) { p0_transpose_item(F_IN(I_WGATE) + (size_t)l * DM * FF, DM, FF, F_WS(bf16, WS_WGU) + (size_t)l * FF2 * DM, scr, r, F.lane, F_IN(I_GPREFFN) + l * DM, 1.f, 0, 1); continue; } r -= I_G;
        if (r < I_G) { p0_transpose_item(F_IN(I_WUP) + (size_t)l * DM * FF, DM, FF, F_WS(bf16, WS_WGU) + (size_t)l * FF2 * DM, scr, r, F.lane, F_IN(I_GPREFFN) + l * DM, 1.f, 0, 2); continue; } r -= I_G;
        if (r < I_D) { p0_transpose_item(F_IN(I_WDOWN) + (size_t)l * FF * DM, FF, DM, F_WS(bf16, WS_WDN) + (size_t)l * DM * FF, scr, r, F.lane, nullptr, 1.f, 0, 0); continue; } r -= I_D;
        p0_transpose_item(F_IN(I_WGLU) + (size_t)l * SW * SW, SW, SW, F_WS(bf16, WS_WGLU) + (size_t)l * SW * SW, scr, r, F.lane, nullptr, 1.f, 0, 0);
    }
    for (int i = gw * 64 + F.lane; i < DEPTH * 32 * 64; i += NGW * 64) {
        const int p = i & 63, g = (i >> 6) & 31, l = i >> 11;
        const float lr = F_IN(I_LAMRE)[i], li = F_IN(I_LAMIM)[i], step = expf(F_IN(I_LOGSTEP)[l * 32 + g]);
        const float mag = expf(lr * step), are = mag * cosf(li * step), aim = mag * sinf(li * step);
        const float den = lr * lr + li * li, cre_ = ((are - 1.0f) * lr + aim * li) / den, cim_ = (aim * lr - (are - 1.0f) * li) / den;
        float pr = are, pim = aim; float* ap = F_WS(float, WS_AP) + (size_t)i * 8; ap[0] = are; ap[1] = aim;
        for (int k = 0; k < 5; ++k) { const float nr = pr * pr - pim * pim, ni = 2.0f * pr * pim; pr = nr; pim = ni; }
        ap[2] = pr; ap[3] = pim;
        for (int k = 0; k < 3; ++k) { const float nr = pr * pr - pim * pim, ni = 2.0f * pr * pim; pr = nr; pim = ni; }
        ap[4] = pr; ap[5] = pim; ap[6] = 0.f; ap[7] = 0.f;
        bf16* BB = F_WS(bf16, WS_BBF) + ((size_t)(l * 32 + g) * 8) * 512; bf16* CFp = F_WS(bf16, WS_CF) + ((size_t)(l * 32 + g) * 4) * 512;
        const int mt = p >> 4, rowi = p & 15;
        for (int c = 0; c < 16; ++c) { const float br = F_IN(I_BRE)[(size_t)i * 16 + c], bi = F_IN(I_BIM)[(size_t)i * 16 + c];
            const int ln = rowi + 16 * (c >> 3), j = c & 7;
            BB[(mt * 64 + ln) * 8 + j] = (bf16)f2bf(cre_ * br - cim_ * bi); BB[((4 + mt) * 64 + ln) * 8 + j] = (bf16)f2bf(cre_ * bi + cim_ * br);
            const int lc = c + 16 * ((p >> 3) & 3), jc = p & 7;
            CFp[((p >> 5) * 64 + lc) * 8 + jc] = (bf16)f2bf(F_IN(I_CRE)[(((size_t)l * 32 + g) * 16 + c) * 64 + p]);
            CFp[((2 + (p >> 5)) * 64 + lc) * 8 + jc] = (bf16)f2bf(-F_IN(I_CIM)[(((size_t)l * 32 + g) * 16 + c) * 64 + p]); }
        for (int g4 = 2; g4 < 4; ++g4) for (int j = 0; j < 8; ++j) { BB[(mt * 64 + rowi + 16 * g4) * 8 + j] = 0; BB[((4 + mt) * 64 + rowi + 16 * g4) * 8 + j] = 0; }
    }
    for (int i = gw * 64 + F.lane; i < DEPTH * 4 * 128 * 128; i += NGW * 64) { const int s = i & 127, t = (i >> 7) & 127; F_WS(bf16, WS_WM)[i] = (s <= t) ? (bf16)f2bf(F_IN(I_SGUW)[i]) : (bf16)0; }
    for (int m = gw; m < MTOT; m += NGW) {
        GAS v2u* xo = (GAS v2u*)(F_WS(bf16, WS_XN) + (size_t)m * DM) + F.lane;
        if (m < MREAL) {
            const float* src = (m < MP) ? F_IN(I_XP) + (size_t)m * DM : F_IN(I_XS) + (size_t)(m - MP) * DM;
            const GAS f32x4* xr = (const GAS f32x4*)src + F.lane; GAS f32x4* xw = (GAS f32x4*)(F.out + (size_t)m * DM) + F.lane;
            f32x4 v[8]; float s = 0.f;
#pragma unroll
            for (int j = 0; j < 8; ++j) { v[j] = xr[64 * j]; s += (v[j].x * v[j].x + v[j].y * v[j].y) + (v[j].z * v[j].z + v[j].w * v[j].w); }
            s = wave_sum(s);
#pragma unroll
            for (int j = 0; j < 8; ++j) { xw[64 * j] = v[j]; v2u w; w.x = pk2(v[j].x, v[j].y); w.y = pk2(v[j].z, v[j].w); xo[64 * j] = w; }
            if (F.lane == 0) F_WS(float, WS_RS)[m] = 1.0f / sqrtf(s * (1.0f / DM) + EPS);
        } else {
#pragma unroll
            for (int j = 0; j < 8; ++j) { v2u w; w.x = 0u; w.y = 0u; xo[64 * j] = w; }
            if (F.lane == 0) F_WS(float, WS_RS)[m] = 0.f;
        }
    }
    for (int i = gw * 64 + F.lane; i < 3 * 8 * 129; i += NGW * 64) {
        const int jj = i % 129, h = (i / 129) % 8, pi = i / (129 * 8); const int d = pi == 0 ? 1 : (pi == 1 ? 4 : 16);
        F_WS(float, WS_BIAS)[i] = F_IN(I_RELB)[t5_bucket(jj * d) * 8 + h] * LOG2E;
    }
}

__device__ __forceinline__ void norm_rows(Frame& F, const float* g) {
    const int gw = F.vcu * NWAVES + F.wave, NGW = F.G * NWAVES;
    for (int m = gw; m < MREAL; m += NGW) {
        const GAS f32x4* tr = (const GAS f32x4*)(F_WS(float, WS_T) + (size_t)m * DM) + F.lane; GAS f32x4* xw = (GAS f32x4*)(F.out + (size_t)m * DM) + F.lane;
        const GAS f32x4* gr = (const GAS f32x4*)g + F.lane; GAS v2u* xo = (GAS v2u*)(F_WS(bf16, WS_XN) + (size_t)m * DM) + F.lane;
        f32x4 tv[8]; float s = 0.f;
#pragma unroll
        for (int j = 0; j < 8; ++j) { tv[j] = tr[64 * j]; s += (tv[j].x * tv[j].x + tv[j].y * tv[j].y) + (tv[j].z * tv[j].z + tv[j].w * tv[j].w); }
        const float r = 1.0f / sqrtf(wave_sum(s) * (1.0f / DM) + EPS);
        float s2 = 0.f;
#pragma unroll
        for (int j = 0; j < 8; ++j) { const f32x4 xv = xw[64 * j], gv = gr[64 * j]; tv[j] = xv + tv[j] * r * gv; s2 += (tv[j].x * tv[j].x + tv[j].y * tv[j].y) + (tv[j].z * tv[j].z + tv[j].w * tv[j].w); }
        s2 = wave_sum(s2);
#pragma unroll
        for (int j = 0; j < 8; ++j) { xw[64 * j] = tv[j]; v2u w; w.x = pk2(tv[j].x, tv[j].y); w.y = pk2(tv[j].z, tv[j].w); xo[64 * j] = w; }
        if (F.lane == 0) F_WS(float, WS_RS)[m] = 1.0f / sqrtf(s2 * (1.0f / DM) + EPS);
    }
}


typedef short s16x4 __attribute__((ext_vector_type(4)));
typedef short v4i16_t __attribute__((ext_vector_type(4)));
typedef LAS const char* lds_cptr;
#define MFMA16(a, b, c) __builtin_amdgcn_mfma_f32_16x16x32_bf16((a), (b), (c), 0, 0, 0)
__device__ __forceinline__ unsigned off_b(unsigned row, unsigned ch) { return 256u * row + 16u * (ch ^ (((row & 3u) << 2) | ((row >> 2) & 3u))); }
__device__ __forceinline__ unsigned tr_addr16(unsigned lane, unsigned c, unsigned ks, unsigned t) {
    const unsigned g = lane >> 4, q = (lane & 15u) >> 2, p = lane & 3u;
    return off_b(32u * ks + 8u * g + 4u * t + q, 2u * c + (p >> 1)) + 8u * (p & 1u);
}
__device__ __forceinline__ s16x4 vtr(lds_cptr p) { return __builtin_bit_cast(s16x4, __builtin_amdgcn_ds_read_tr16_b64_v4i16((LAS v4i16_t*)p)); }
__device__ __forceinline__ unsigned cvtpk(float lo, float hi) { unsigned r; asm volatile("v_cvt_pk_bf16_f32 %0, %1, %2" : "=v"(r) : "v"(lo), "v"(hi)); return r; }

constexpr int LDS_X_OFF = 132096;
constexpr int ATT_UNITS = 1536;

__device__ __forceinline__ void attn_unit(LAS unsigned char* lds, unsigned char* ws, int unit, int tid) {
    const int lane = tid & 63, w = __builtin_amdgcn_readfirstlane(tid >> 6);
    const int pi = unit >> 9, r2 = unit & 511, n = r2 >> 8, h = (r2 >> 5) & 7, rb = r2 & 31;
    const int dsh = 2 * pi, d = 1 << dsh, nbs = 5 - dsh;
    const int r = rb >> nbs, b = rb & ((1 << nbs) - 1);
    const bf16* Kg = (const bf16*)(ws + WS_K); const bf16* Vg = (const bf16*)(ws + WS_V); const bf16* Qg = (const bf16*)(ws + WS_Q);
    LAS unsigned char* Kimg = lds; LAS unsigned char* Vimg = lds + 65536; LAS float* btab = (LAS float*)(lds + LDS_X_OFF);
    {
        const int ch = tid & 15, jr = tid >> 4;
        v4u kv[8], vv[8];
#pragma unroll
        for (int p = 0; p < 8; ++p) { const int j = p * 32 + jr; const int tk = r + d * (128 * (b - 1) + j);
            if (tk >= 0) { const size_t off = ((size_t)(n * SEQ + tk)) * AW + h * 128 + ch * 8; kv[p] = *(const v4u*)(Kg + off); vv[p] = *(const v4u*)(Vg + off); }
            else { kv[p] = (v4u){0u, 0u, 0u, 0u}; vv[p] = (v4u){0u, 0u, 0u, 0u}; } }
#pragma unroll
        for (int p = 0; p < 8; ++p) { const int j = p * 32 + jr; const unsigned o = off_b(j, ch); *(LAS v4u*)(Kimg + o) = kv[p]; *(LAS v4u*)(Vimg + o) = vv[p]; }
        if (tid < 129) btab[tid] = ((const float*)(ws + WS_BIAS))[(pi * 8 + h) * 129 + tid];
    }
    __syncthreads();
    const int q = lane & 15, g4 = lane >> 4, qi = 16 * w + q;
    const int rowq = n * SEQ + r + d * (128 * b + qi);
    bf16x8 qf[4];
#pragma unroll
    for (int s = 0; s < 4; ++s) qf[s] = *(const bf16x8*)(Qg + (size_t)rowq * AW + h * 128 + 32 * s + 8 * g4);
    const int ks0 = w >> 1;
    f32x4 sacc[5][2];
    {
        const int rr = lane & 15;
#pragma unroll
        for (int kb = 0; kb < 5; ++kb)
#pragma unroll
            for (int t = 0; t < 2; ++t) {
                const int j = 32 * (ks0 + kb) + 8 * (rr >> 2) + 4 * t + (rr & 3);
                f32x4 acc = (f32x4){0.f, 0.f, 0.f, 0.f};
#pragma unroll
                for (int s = 0; s < 4; ++s) { const bf16x8 kf = *(const LAS bf16x8*)(Kimg + off_b(j, 4 * s + g4)); acc = MFMA16(kf, qf[s], acc); }
                sacc[kb][t] = acc;
            }
    }
    float mx = -3.0e38f;
#pragma unroll
    for (int kb = 0; kb < 5; ++kb)
#pragma unroll
        for (int t = 0; t < 2; ++t)
#pragma unroll
            for (int i = 0; i < 4; ++i) {
                const int j = 32 * (ks0 + kb) + 8 * g4 + 4 * t + i; const int delta = 128 + qi - j;
                const bool valid = (delta >= 0) && (delta <= 128) && (b > 0 || j >= 128);
                const int dc = delta < 0 ? 0 : (delta > 128 ? 128 : delta);
                const float sv = valid ? sacc[kb][t][i] + btab[dc] : -1.0e30f;
                sacc[kb][t][i] = sv; mx = fmaxf(mx, sv);
            }
    mx = fmaxf(mx, __shfl_xor(mx, 16)); mx = fmaxf(mx, __shfl_xor(mx, 32));
    float ls = 0.f;
    bf16x8 pf[5];
#pragma unroll
    for (int kb = 0; kb < 5; ++kb) {
        float p[8];
#pragma unroll
        for (int t = 0; t < 2; ++t)
#pragma unroll
            for (int i = 0; i < 4; ++i) { p[4 * t + i] = __builtin_amdgcn_exp2f(sacc[kb][t][i] - mx); ls += p[4 * t + i]; }
        v4u pk; pk.x = cvtpk(p[0], p[1]); pk.y = cvtpk(p[2], p[3]); pk.z = cvtpk(p[4], p[5]); pk.w = cvtpk(p[6], p[7]);
        pf[kb] = __builtin_bit_cast(bf16x8, pk);
    }
    ls += __shfl_xor(ls, 16); ls += __shfl_xor(ls, 32);
    const float inv = 1.0f / ls;
    bf16* Og = (bf16*)(ws + WS_OBUF) + ((size_t)pi * MP + rowq) * AW + h * 128;
#pragma unroll
    for (int c = 0; c < 8; ++c) {
        f32x4 oacc = (f32x4){0.f, 0.f, 0.f, 0.f};
#pragma unroll
        for (int kb = 0; kb < 5; ++kb) {
            const s16x4 lo = vtr((lds_cptr)(Vimg + tr_addr16(lane, c, ks0 + kb, 0))), hi = vtr((lds_cptr)(Vimg + tr_addr16(lane, c, ks0 + kb, 1)));
            const bf16x8 vf = __builtin_shufflevector(lo, hi, 0, 1, 2, 3, 4, 5, 6, 7);
            oacc = MFMA16(vf, pf[kb], oacc);
        }
        v2u ow; ow.x = cvtpk(oacc[0] * inv, oacc[1] * inv); ow.y = cvtpk(oacc[2] * inv, oacc[3] * inv);
        *(v2u*)(Og + 16 * c + 4 * g4) = ow;
    }
    if (g4 == 0) ((float*)(ws + WS_LSE))[((size_t)pi * MP + rowq) * 8 + h] = mx + __builtin_amdgcn_logf(ls);
    __syncthreads();
}

__device__ __forceinline__ void attn_sample_task(unsigned char* ws, const float* const* inp, float* out, int l, int task, int lane) {
    const int rs_ = task >> 3, h = task & 7, n = rs_ >> 3, t = rs_ & 7, row = MP + rs_;
    const unsigned qw = ((const unsigned*)((const bf16*)(ws + WS_Q) + (size_t)row * AW + h * 128))[lane];
    const float q0 = bf_lo(qw), q1 = bf_hi(qw);
    float m = -3.0e38f, ls = 0.f, o0 = 0.f, o1 = 0.f;
#pragma nounroll
    for (int pi = 0; pi < 3; ++pi) {
        const int d = 1 << (2 * pi);
        const float* bt = (const float*)(ws + WS_BIAS) + (pi * 8 + h) * 129;
#pragma nounroll
        for (int jj = 0; jj <= 128; ++jj) {
            const int idx = 2048 + t - jj * d; const float *kp, *vp;
            if (idx < 2048) { const size_t off = ((((size_t)l * 8 + n) * 2048 + idx) * 8 + h) * 128; kp = inp[I_CK] + off; vp = inp[I_CV] + off; }
            else { const size_t off = (((size_t)l * 8 + n) * 8 + (idx - 2048)) * 1024 + h * 128; kp = out + O_NKS + off; vp = out + O_NVS + off; }
            const f32x2v kk = ((const f32x2v*)kp)[lane], vv = ((const f32x2v*)vp)[lane];
            const float s = wave_sum(q0 * kk.x + q1 * kk.y) + bt[jj];
            const float mn = fmaxf(m, s), al = exp2f(m - mn), p = exp2f(s - mn);
            ls = ls * al + p; o0 = o0 * al + p * vv.x; o1 = o1 * al + p * vv.y; m = mn;
        }
    }
    const float inv = 1.0f / ls; f32x2v ov; ov.x = o0 * inv; ov.y = o1 * inv;
    ((f32x2v*)((float*)(ws + WS_SATT) + (size_t)rs_ * AW + h * 128))[lane] = ov;
}

__device__ __forceinline__ void attn_combine_row(unsigned char* ws, const float* const* inp, int l, int row, int lane) {
    float o[16];
    if (row < MP) {
        const int h = lane >> 3; const float* L = (const float*)(ws + WS_LSE);
        const float l0 = L[((size_t)0 * MP + row) * 8 + h], l1 = L[((size_t)1 * MP + row) * 8 + h], l2 = L[((size_t)2 * MP + row) * 8 + h];
        const float mm = fmaxf(l0, fmaxf(l1, l2)); float w0 = exp2f(l0 - mm), w1 = exp2f(l1 - mm), w2 = exp2f(l2 - mm);
        const float is = 1.0f / (w0 + w1 + w2); w0 *= is; w1 *= is; w2 *= is;
        const bf16* O = (const bf16*)(ws + WS_OBUF);
#pragma unroll
        for (int half = 0; half < 2; ++half) {
            const v4u a = *(const v4u*)(O + ((size_t)0 * MP + row) * AW + 16 * lane + 8 * half), b = *(const v4u*)(O + ((size_t)1 * MP + row) * AW + 16 * lane + 8 * half),
                      c = *(const v4u*)(O + ((size_t)2 * MP + row) * AW + 16 * lane + 8 * half);
            o[8 * half + 0] = w0 * bf_lo(a.x) + w1 * bf_lo(b.x) + w2 * bf_lo(c.x); o[8 * half + 1] = w0 * bf_hi(a.x) + w1 * bf_hi(b.x) + w2 * bf_hi(c.x);
            o[8 * half + 2] = w0 * bf_lo(a.y) + w1 * bf_lo(b.y) + w2 * bf_lo(c.y); o[8 * half + 3] = w0 * bf_hi(a.y) + w1 * bf_hi(b.y) + w2 * bf_hi(c.y);
            o[8 * half + 4] = w0 * bf_lo(a.z) + w1 * bf_lo(b.z) + w2 * bf_lo(c.z); o[8 * half + 5] = w0 * bf_hi(a.z) + w1 * bf_hi(b.z) + w2 * bf_hi(c.z);
            o[8 * half + 6] = w0 * bf_lo(a.w) + w1 * bf_lo(b.w) + w2 * bf_lo(c.w); o[8 * half + 7] = w0 * bf_hi(a.w) + w1 * bf_hi(b.w) + w2 * bf_hi(c.w);
        }
    } else {
        const f32x4* S = (const f32x4*)((const float*)(ws + WS_SATT) + (size_t)(row - MP) * AW + 16 * lane);
#pragma unroll
        for (int k = 0; k < 4; ++k) { const f32x4 v = S[k]; o[4 * k] = v.x; o[4 * k + 1] = v.y; o[4 * k + 2] = v.z; o[4 * k + 3] = v.w; }
    }
    float ss = 0.f;
#pragma unroll
    for (int k = 0; k < 16; ++k) ss += o[k] * o[k];
    const float r = 1.0f / sqrtf(wave_sum(ss) * (1.0f / AW) + EPS);
    const f32x4* g = (const f32x4*)(inp[I_GMIXOUT] + l * DM + 16 * lane);
    v4u w0, w1; const f32x4 g0 = g[0], g1 = g[1], g2 = g[2], g3 = g[3];
    w0.x = pk2(o[0] * r * g0.x, o[1] * r * g0.y); w0.y = pk2(o[2] * r * g0.z, o[3] * r * g0.w); w0.z = pk2(o[4] * r * g1.x, o[5] * r * g1.y); w0.w = pk2(o[6] * r * g1.z, o[7] * r * g1.w);
    w1.x = pk2(o[8] * r * g2.x, o[9] * r * g2.y); w1.y = pk2(o[10] * r * g2.z, o[11] * r * g2.w); w1.z = pk2(o[12] * r * g3.x, o[13] * r * g3.y); w1.w = pk2(o[14] * r * g3.z, o[15] * r * g3.w);
    v4u* dst = (v4u*)((bf16*)(ws + WS_MIX) + (size_t)row * DM + 16 * lane); dst[0] = w0; dst[1] = w1;
}

constexpr int XW_STRIDE = 528, XW_BYTES = 16 * XW_STRIDE;
__device__ __forceinline__ void ssm_pass1_unit(LAS unsigned char* xw, unsigned char* ws, int l, int wu, int lane) {
    const int g = wu & 31, sc = (wu >> 5) & 15, n = wu >> 9, q = lane & 15, g4 = lane >> 4;
    const bf16* BB = (const bf16*)(ws + WS_BBF) + ((size_t)(l * 32 + g) * 8) * 512;
    bf16x8 bb[8];
#pragma unroll
    for (int mt = 0; mt < 8; ++mt) bb[mt] = *(const bf16x8*)(BB + (mt * 64 + lane) * 8);
    const float* ap = (const float*)(ws + WS_AP) + ((size_t)(l * 32 + g) * 64 + lane) * 8;
    const float are = ap[0], aim = ap[1];
    float hr = 0.f, hi_ = 0.f;
    const bf16* U = (const bf16*)(ws + WS_U); float* SL = (float*)(ws + WS_SLOC);
#pragma nounroll
    for (int tt = 0; tt < 16; ++tt) {
        const int row0 = n * SEQ + sc * 256 + tt * 16;
        bf16x8 uf = (bf16x8){0, 0, 0, 0, 0, 0, 0, 0};
        if (g4 < 2) uf = *(const bf16x8*)(U + (size_t)(row0 + q) * SW + g * 16 + 8 * g4);
#pragma unroll
        for (int mt = 0; mt < 8; ++mt) { const f32x4 dd = MFMA16(bb[mt], uf, ((f32x4){0.f, 0.f, 0.f, 0.f})); *(LAS f32x4*)(xw + q * XW_STRIDE + (16 * mt + 4 * g4) * 4) = dd; }
        asm volatile("s_waitcnt lgkmcnt(0)" ::: "memory");
#pragma unroll
        for (int t = 0; t < 16; ++t) { const float xr = *(const LAS float*)(xw + t * XW_STRIDE + lane * 4), xi = *(const LAS float*)(xw + t * XW_STRIDE + 256 + lane * 4);
            const float nr = are * hr - aim * hi_ + xr, ni = are * hi_ + aim * hr + xi; hr = nr; hi_ = ni; }
        asm volatile("s_waitcnt lgkmcnt(0)" ::: "memory");
        if (tt & 1) { f32x2v e; e.x = hr; e.y = hi_; ((f32x2v*)SL)[((((size_t)n * 16 + sc) * 8 + (tt >> 1)) * 32 + g) * 64 + lane] = e; }
    }
}
constexpr int YB_OFF = 8 * XW_BYTES, YB_STRIDE = 1040, RED_OFF = YB_OFF + 32 * YB_STRIDE;
constexpr int SSM2_UNITS = 264;
__device__ __forceinline__ void ssm_pass2_unit(LAS unsigned char* lds, unsigned char* ws, const float* const* inp, float* out, int l, int unit, int tid) {
    const int lane = tid & 63, w = __builtin_amdgcn_readfirstlane(tid >> 6), q = lane & 15, g4 = lane >> 4;
    const bool samp = unit >= 256;
    const int n = samp ? unit - 256 : unit >> 7, c32 = unit & 127;
    const int row0 = samp ? MP + n * 8 : n * SEQ + c32 * 32, ntile = samp ? 1 : 2;
    LAS unsigned char* xw = lds + w * XW_BYTES; LAS unsigned char* ybuf = lds + YB_OFF; LAS float* red = (LAS float*)(lds + RED_OFF);
    const bf16* U = (const bf16*)(ws + WS_U); const f32x2v* SL = (const f32x2v*)(ws + WS_SLOC);
#pragma nounroll
    for (int gi = 0; gi < 4; ++gi) {
        const int g = 4 * w + gi;
        const bf16* BB = (const bf16*)(ws + WS_BBF) + ((size_t)(l * 32 + g) * 8) * 512; const bf16* CFp = (const bf16*)(ws + WS_CF) + ((size_t)(l * 32 + g) * 4) * 512;
        const float* ap = (const float*)(ws + WS_AP) + ((size_t)(l * 32 + g) * 64 + lane) * 8;
        const float are = ap[0], aim = ap[1];
        float hr = 0.f, hi_ = 0.f;
        if (!samp) {
            const int sc = c32 >> 3, c2 = c32 & 7; const float a32r = ap[2], a32i = ap[3], a256r = ap[4], a256i = ap[5];
            f32x2v es[15];
#pragma unroll
            for (int s2 = 0; s2 < 15; ++s2) { es[s2] = (f32x2v){0.f, 0.f}; if (s2 < sc) es[s2] = SL[((((size_t)n * 16 + s2) * 8 + 7) * 32 + g) * 64 + lane]; }
#pragma unroll
            for (int s2 = 0; s2 < 15; ++s2) { if (s2 < sc) { const float nr = a256r * hr - a256i * hi_ + es[s2].x, ni = a256r * hi_ + a256i * hr + es[s2].y; hr = nr; hi_ = ni; } }
#pragma nounroll
            for (int k = 0; k < c2; ++k) { const float nr = a32r * hr - a32i * hi_, ni = a32r * hi_ + a32i * hr; hr = nr; hi_ = ni; }
            if (c2 > 0) { const f32x2v e = SL[((((size_t)n * 16 + sc) * 8 + (c2 - 1)) * 32 + g) * 64 + lane]; hr += e.x; hi_ += e.y; }
        } else { hr = inp[I_SRE][(((size_t)l * 8 + n) * 32 + g) * 64 + lane]; hi_ = inp[I_SIM][(((size_t)l * 8 + n) * 32 + g) * 64 + lane]; }
        const f32x4 dsk = *(const f32x4*)(inp[I_SSMD] + l * SW + 16 * g + 4 * g4);
#pragma nounroll
        for (int tt = 0; tt < ntile; ++tt) {
            const int rowt = row0 + tt * 16;
            bf16x8 uf = (bf16x8){0, 0, 0, 0, 0, 0, 0, 0};
            if (g4 < 2) uf = *(const bf16x8*)(U + (size_t)(rowt + q) * SW + g * 16 + 8 * g4);
#pragma unroll
            for (int mt = 0; mt < 8; ++mt) { const bf16x8 bbf = *(const bf16x8*)(BB + (mt * 64 + lane) * 8);
                const f32x4 dd = MFMA16(bbf, uf, ((f32x4){0.f, 0.f, 0.f, 0.f})); *(LAS f32x4*)(xw + q * XW_STRIDE + (16 * mt + 4 * g4) * 4) = dd; }
            asm volatile("s_waitcnt lgkmcnt(0)" ::: "memory");
#pragma unroll
            for (int t = 0; t < 16; ++t) { const float xr = *(const LAS float*)(xw + t * XW_STRIDE + lane * 4), xi = *(const LAS float*)(xw + t * XW_STRIDE + 256 + lane * 4);
                const float nr = are * hr - aim * hi_ + xr, ni = are * hi_ + aim * hr + xi; hr = nr; hi_ = ni;
                asm volatile("" ::: "memory");
                *(LAS bf16*)(xw + t * XW_STRIDE + lane * 2) = (bf16)f2bf(hr); *(LAS bf16*)(xw + t * XW_STRIDE + 128 + lane * 2) = (bf16)f2bf(hi_);
                if (samp && t == 7) { out[O_SRS + (((size_t)l * 8 + n) * 32 + g) * 64 + lane] = hr; out[O_SIS + (((size_t)l * 8 + n) * 32 + g) * 64 + lane] = hi_; } }
            asm volatile("s_waitcnt lgkmcnt(0)" ::: "memory");
            f32x4 yacc = (f32x4){0.f, 0.f, 0.f, 0.f};
#pragma unroll
            for (int ks = 0; ks < 4; ++ks) { const bf16x8 cf = *(const bf16x8*)(CFp + (ks * 64 + lane) * 8); const bf16x8 hf = *(const LAS bf16x8*)(xw + q * XW_STRIDE + (32 * ks + 8 * g4) * 2); yacc = MFMA16(cf, hf, yacc); }
            const v2u uw = *(const v2u*)(U + (size_t)(rowt + q) * SW + 16 * g + 4 * g4);
            const float y0 = yacc[0] + dsk.x * bf_lo(uw.x), y1 = yacc[1] + dsk.y * bf_hi(uw.x), y2 = yacc[2] + dsk.z * bf_lo(uw.y), y3 = yacc[3] + dsk.w * bf_hi(uw.y);
            v2u yw; yw.x = cvtpk(y0, y1); yw.y = cvtpk(y2, y3);
            *(LAS v2u*)(ybuf + (tt * 16 + q) * YB_STRIDE + (16 * g + 4 * g4) * 2) = yw;
            asm volatile("s_waitcnt lgkmcnt(0)" ::: "memory");
        }
        if (!samp && c32 == 127) { out[O_SRP + (((size_t)l * 2 + n) * 32 + g) * 64 + lane] = hr; out[O_SIP + (((size_t)l * 2 + n) * 32 + g) * 64 + lane] = hi_; }
    }
    __syncthreads();
    f32x4 acc[2][4];
#pragma unroll
    for (int mt = 0; mt < 2; ++mt)
#pragma unroll
        for (int nt = 0; nt < 4; ++nt) acc[mt][nt] = (f32x4){0.f, 0.f, 0.f, 0.f};
    const bf16* Wg = (const bf16*)(ws + WS_WGLU) + (size_t)l * 512 * 512;
#pragma unroll 2
    for (int ks = 0; ks < 16; ++ks) {
        bf16x8 af[2];
#pragma unroll
        for (int mt = 0; mt < 2; ++mt) af[mt] = *(const LAS bf16x8*)(ybuf + (16 * mt + q) * YB_STRIDE + (32 * ks + 8 * g4) * 2);
#pragma unroll
        for (int nt = 0; nt < 4; ++nt) { const bf16x8 bfr = *(const bf16x8*)(Wg + (size_t)(64 * w + 16 * nt + q) * 512 + 32 * ks + 8 * g4);
#pragma unroll
            for (int mt = 0; mt < 2; ++mt) acc[mt][nt] = MFMA16(bfr, af[mt], acc[mt][nt]); }
    }
#pragma unroll
    for (int mt = 0; mt < 2; ++mt) { const int t = 16 * mt + q; float ss = 0.f;
#pragma unroll
        for (int nt = 0; nt < 4; ++nt) { const int n0 = 64 * w + 16 * nt + 4 * g4; const f32x4 bg = *(const f32x4*)(inp[I_BGLU] + l * SW + n0);
            const v2u yw = *(const LAS v2u*)(ybuf + t * YB_STRIDE + n0 * 2);
            f32x4 o; o.x = bf_lo(yw.x) * pg8::fast_sigmoid(acc[mt][nt].x + bg.x); o.y = bf_hi(yw.x) * pg8::fast_sigmoid(acc[mt][nt].y + bg.y);
            o.z = bf_lo(yw.y) * pg8::fast_sigmoid(acc[mt][nt].z + bg.z); o.w = bf_hi(yw.y) * pg8::fast_sigmoid(acc[mt][nt].w + bg.w);
            acc[mt][nt] = o; ss += (o.x * o.x + o.y * o.y) + (o.z * o.z + o.w * o.w); }
        ss += __shfl_xor(ss, 16); ss += __shfl_xor(ss, 32);
        if (g4 == 0) red[t * 8 + w] = ss; }
    __syncthreads();
#pragma unroll
    for (int mt = 0; mt < 2; ++mt) { const int t = 16 * mt + q; const LAS f32x4* rp = (const LAS f32x4*)(red + t * 8); const f32x4 r0 = rp[0], r1 = rp[1];
        const float r = 1.0f / sqrtf(((r0.x + r0.y) + (r0.z + r0.w) + (r1.x + r1.y) + (r1.z + r1.w)) * (1.0f / SW) + EPS);
        const bool valid = !samp || t < 8;
        if (valid) {
#pragma unroll
            for (int nt = 0; nt < 4; ++nt) { const int n0 = 64 * w + 16 * nt + 4 * g4; const f32x4 gg = *(const f32x4*)(inp[I_GMIXOUT] + l * DM + 1024 + n0);
                v2u ow; ow.x = cvtpk(acc[mt][nt].x * r * gg.x, acc[mt][nt].y * r * gg.y); ow.y = cvtpk(acc[mt][nt].z * r * gg.z, acc[mt][nt].w * r * gg.w);
                *(v2u*)((bf16*)(ws + WS_MIX) + (size_t)(row0 + t) * DM + 1024 + n0) = ow; } } }
    __syncthreads();
}

constexpr int SGU_UNITS = 72, SGU_RED_OFF = LDS_X_OFF + 1024;
__device__ __forceinline__ void sgu_unit(LAS unsigned char* lds, unsigned char* ws, const float* const* inp, float* out, int l, int unit, int tid) {
    const int lane = tid & 63, w = __builtin_amdgcn_readfirstlane(tid >> 6), q = lane & 15, g4 = lane >> 4;
    const bool samp = unit >= 64;
    const int row0 = samp ? MP + 8 * (unit - 64) : (unit >> 5) * SEQ + (unit & 31) * 128, nrows = samp ? 8 : 128;
    LAS float* red = (LAS float*)(lds + SGU_RED_OFF);
    {
        const bf16* GVg = (const bf16*)(ws + WS_GV); const f32x4* sgp = (const f32x4*)(inp[I_SGUG] + l * GW + 8 * lane); const f32x4 sg0 = sgp[0], sg1 = sgp[1];
#pragma nounroll
        for (int k = 0; k < 16; ++k) { const int s = w + 8 * k; v4u pk = (v4u){0u, 0u, 0u, 0u};
            if (s < nrows) { const v4u raw = *(const v4u*)(GVg + (size_t)(row0 + s) * GW + 8 * lane);
                float x[8] = {bf_lo(raw.x), bf_hi(raw.x), bf_lo(raw.y), bf_hi(raw.y), bf_lo(raw.z), bf_hi(raw.z), bf_lo(raw.w), bf_hi(raw.w)};
                float sm = 0.f;
#pragma unroll
                for (int j = 0; j < 8; ++j) sm += x[j];
                const float mean = wave_sum(sm) * (1.0f / GW); float qq = 0.f;
#pragma unroll
                for (int j = 0; j < 8; ++j) { x[j] -= mean; qq += x[j] * x[j]; }
                const float rstd = 1.0f / sqrtf(wave_sum(qq) * (1.0f / GW) + EPS);
                x[0] *= rstd * sg0.x; x[1] *= rstd * sg0.y; x[2] *= rstd * sg0.z; x[3] *= rstd * sg0.w; x[4] *= rstd * sg1.x; x[5] *= rstd * sg1.y; x[6] *= rstd * sg1.z; x[7] *= rstd * sg1.w;
                if (samp) { f32x4* od = (f32x4*)(out + O_SGV + ((size_t)l * 64 + (row0 + s - MP)) * GW + 8 * lane); od[0] = (f32x4){x[0], x[1], x[2], x[3]}; od[1] = (f32x4){x[4], x[5], x[6], x[7]}; }
                pk.x = pk2(x[0], x[1]); pk.y = pk2(x[2], x[3]); pk.z = pk2(x[4], x[5]); pk.w = pk2(x[6], x[7]); }
            *(LAS v4u*)(lds + (lane >> 4) * 32768 + off_b(s, lane & 15)) = pk; }
    }
    __syncthreads();
    const int hh = w >> 1, th = w & 1;
    LAS unsigned char* img = lds + hh * 32768;
    const bf16* Wm = (const bf16*)(ws + WS_WM) + ((size_t)(l * 4 + hh) * 128) * 128;
    const bf16* GUg = (const bf16*)(ws + WS_GU);
#pragma nounroll
    for (int mp = 0; mp < 2; ++mp) {
        f32x4 acc[2][8];
#pragma unroll
        for (int m2 = 0; m2 < 2; ++m2)
#pragma unroll
            for (int c = 0; c < 8; ++c) acc[m2][c] = (f32x4){0.f, 0.f, 0.f, 0.f};
#pragma nounroll
        for (int ks = 0; ks <= 2 * th + mp; ++ks) {
            bf16x8 gf[8];
#pragma unroll
            for (int c = 0; c < 8; ++c) { const s16x4 lo = vtr((lds_cptr)(img + tr_addr16(lane, c, ks, 0))), hi = vtr((lds_cptr)(img + tr_addr16(lane, c, ks, 1))); gf[c] = __builtin_shufflevector(lo, hi, 0, 1, 2, 3, 4, 5, 6, 7); }
#pragma unroll
            for (int m2 = 0; m2 < 2; ++m2) { const bf16x8 wf = *(const bf16x8*)(Wm + (size_t)(64 * th + 32 * mp + 16 * m2 + q) * 128 + 32 * ks + 8 * g4);
#pragma unroll
                for (int c = 0; c < 8; ++c) acc[m2][c] = MFMA16(gf[c], wf, acc[m2][c]); }
        }
#pragma unroll
        for (int m2 = 0; m2 < 2; ++m2) { const int tl = 64 * th + 32 * mp + 16 * m2 + q; const bool valid = tl < nrows; const float bias = inp[I_SGUB][((size_t)l * 4 + hh) * 128 + tl]; float ss = 0.f;
#pragma unroll
            for (int c = 0; c < 8; ++c) { v2u gw2 = (v2u){0u, 0u}; if (valid) gw2 = *(const v2u*)(GUg + (size_t)(row0 + tl) * GW + hh * 128 + 16 * c + 4 * g4);
                v2u ow; ow.x = cvtpk(bf_lo(gw2.x) * (acc[m2][c].x + bias), bf_hi(gw2.x) * (acc[m2][c].y + bias)); ow.y = cvtpk(bf_lo(gw2.y) * (acc[m2][c].z + bias), bf_hi(gw2.y) * (acc[m2][c].w + bias));
                const float o0 = bf_lo(ow.x), o1 = bf_hi(ow.x), o2 = bf_lo(ow.y), o3 = bf_hi(ow.y); ss += (o0 * o0 + o1 * o1) + (o2 * o2 + o3 * o3);
                if (valid) *(v2u*)((bf16*)(ws + WS_MIX) + (size_t)(row0 + tl) * DM + 1536 + hh * 128 + 16 * c + 4 * g4) = ow; }
            ss += __shfl_xor(ss, 16); ss += __shfl_xor(ss, 32);
            if (g4 == 0) red[tl * 4 + hh] = ss; }
    }
    __syncthreads();
#pragma nounroll
    for (int mt = 0; mt < 4; ++mt) { const int tl = 64 * th + 16 * mt + q; const f32x4 rr = *(const LAS f32x4*)(red + tl * 4);
        const float r = 1.0f / sqrtf(((rr.x + rr.y) + (rr.z + rr.w)) * (1.0f / GW) + EPS);
        if (tl < nrows) {
#pragma unroll
            for (int c = 0; c < 8; ++c) { const int ch = hh * 128 + 16 * c + 4 * g4; const f32x4 gg = *(const f32x4*)(inp[I_GMIXOUT] + l * DM + 1536 + ch);
                v2u* mp_ = (v2u*)((bf16*)(ws + WS_MIX) + (size_t)(row0 + tl) * DM + 1536 + ch); const v2u ow = *mp_;
                v2u nw; nw.x = cvtpk(bf_lo(ow.x) * r * gg.x, bf_hi(ow.x) * r * gg.y); nw.y = cvtpk(bf_lo(ow.y) * r * gg.z, bf_hi(ow.y) * r * gg.w); *mp_ = nw; } } }
    __syncthreads();
}

template <int K>
__device__ __forceinline__ void sample_gemm_n2048(LAS unsigned char* lds, const bf16* A  , const bf16* Wt  , float* T, int c, int tid) {
    const int lane = tid & 63, w = __builtin_amdgcn_readfirstlane(tid >> 6), q = lane & 15, g4 = lane >> 4;
    constexpr int KW = K / 8, NKS = KW / 32;
    const bf16* wp = Wt + (size_t)(8 * c + (q & 7)) * K + w * KW + 8 * g4;
    const bf16* ap = A + (size_t)q * K + w * KW + 8 * g4;
    f32x4 acc[4];
#pragma unroll
    for (int mt = 0; mt < 4; ++mt) acc[mt] = (f32x4){0.f, 0.f, 0.f, 0.f};
#pragma unroll 2
    for (int ks = 0; ks < NKS; ++ks) {
        const bf16x8 wf = *(const bf16x8*)(wp + 32 * ks);
#pragma unroll
        for (int mt = 0; mt < 4; ++mt) { const bf16x8 af = *(const bf16x8*)(ap + (size_t)(16 * mt) * K + 32 * ks); acc[mt] = MFMA16(wf, af, acc[mt]); }
    }
    LAS f32x4* part = (LAS f32x4*)lds;
#pragma unroll
    for (int mt = 0; mt < 4; ++mt) part[(w * 4 + mt) * 64 + lane] = acc[mt];
    __syncthreads();
    if (w < 4 && g4 < 2) { f32x4 s = part[(0 * 4 + w) * 64 + lane];
#pragma unroll
        for (int ww = 1; ww < 8; ++ww) s += part[(ww * 4 + w) * 64 + lane];
        *(f32x4*)(T + (size_t)(MP + 16 * w + q) * DM + 8 * c + 4 * g4) = s; }
    __syncthreads();
}

constexpr int SATT_LDS_PER_WAVE = 4096;
__device__ __forceinline__ const float* samp_row_ptr(const float* cache, const float* fresh, int l, int n, int t, int h, int kk) {
    const int pi = kk >= 258 ? 2 : (kk >= 129 ? 1 : 0), jj = kk - 129 * pi, idx = 2048 + t - (jj << (2 * pi));
    return (idx < 2048) ? cache + ((((size_t)l * 8 + n) * 2048 + idx) * 8 + h) * 128 : fresh + (((size_t)l * 8 + n) * 8 + (idx - 2048)) * 1024 + h * 128;
}
__device__ __forceinline__ void attn_sample_task2(LAS unsigned char* ldsw, unsigned char* ws, const float* const* inp, float* out, int l, int task, int lane) {
    const int rs_ = task >> 3, h = task & 7, n = rs_ >> 3, t = rs_ & 7, row = MP + rs_;
    const int kg = lane >> 4, e0 = 8 * (lane & 15);
    LAS float* sc = (LAS float*)ldsw;
    float qv[8];
    { const v4u qw = *(const v4u*)((const bf16*)(ws + WS_Q) + (size_t)row * AW + h * 128 + e0);
      qv[0] = bf_lo(qw.x); qv[1] = bf_hi(qw.x); qv[2] = bf_lo(qw.y); qv[3] = bf_hi(qw.y); qv[4] = bf_lo(qw.z); qv[5] = bf_hi(qw.z); qv[6] = bf_lo(qw.w); qv[7] = bf_hi(qw.w); }
    const float* ck = inp[I_CK]; const float* cv = inp[I_CV]; const float* fk = out + O_NKS; const float* fv = out + O_NVS;
    const float* bt = (const float*)(ws + WS_BIAS);
#pragma unroll 4
    for (int it = 0; it < 97; ++it) {
        const int kk = 4 * it + kg, kc = kk < 387 ? kk : 386;
        const f32x4* kp = (const f32x4*)(samp_row_ptr(ck, fk, l, n, t, h, kc) + e0);
        const f32x4 k0 = kp[0], k1 = kp[1];
        float dsum = (qv[0] * k0.x + qv[1] * k0.y) + (qv[2] * k0.z + qv[3] * k0.w) + (qv[4] * k1.x + qv[5] * k1.y) + (qv[6] * k1.z + qv[7] * k1.w);
        dsum += __shfl_xor(dsum, 1); dsum += __shfl_xor(dsum, 2); dsum += __shfl_xor(dsum, 4); dsum += __shfl_xor(dsum, 8);
        const int pi = kc >= 258 ? 2 : (kc >= 129 ? 1 : 0), jj = kc - 129 * pi;
        if ((lane & 15) == 0 && kk < 387) sc[kk] = dsum + bt[(pi * 8 + h) * 129 + jj];
    }
    asm volatile("s_waitcnt lgkmcnt(0)" ::: "memory");
    float sv[7]; float m = -3.0e38f;
#pragma unroll
    for (int c = 0; c < 7; ++c) { const int kk = lane + 64 * c; sv[c] = kk < 387 ? sc[kk] : -3.0e38f; m = fmaxf(m, sv[c]); }
#pragma unroll
    for (int o = 1; o < 64; o <<= 1) m = fmaxf(m, __shfl_xor(m, o));
    float ls = 0.f;
#pragma unroll
    for (int c = 0; c < 7; ++c) { const int kk = lane + 64 * c; const float p = kk < 387 ? __builtin_amdgcn_exp2f(sv[c] - m) : 0.f; ls += p; if (kk < 387) sc[kk] = p; }
    ls = wave_sum(ls);
    asm volatile("s_waitcnt lgkmcnt(0)" ::: "memory");
    float o[8];
#pragma unroll
    for (int j = 0; j < 8; ++j) o[j] = 0.f;
#pragma unroll 4
    for (int it = 0; it < 97; ++it) {
        const int kk = 4 * it + kg, kc = kk < 387 ? kk : 386;
        const f32x4* vp = (const f32x4*)(samp_row_ptr(cv, fv, l, n, t, h, kc) + e0);
        const f32x4 v0 = vp[0], v1 = vp[1]; const float p = kk < 387 ? sc[kc] : 0.f;
        o[0] += p * v0.x; o[1] += p * v0.y; o[2] += p * v0.z; o[3] += p * v0.w; o[4] += p * v1.x; o[5] += p * v1.y; o[6] += p * v1.z; o[7] += p * v1.w;
    }
    const float inv = 1.0f / ls;
#pragma unroll
    for (int j = 0; j < 8; ++j) { o[j] += __shfl_xor(o[j], 16); o[j] += __shfl_xor(o[j], 32); o[j] *= inv; }
    if (lane < 16) { f32x4* od = (f32x4*)((float*)(ws + WS_SATT) + (size_t)rs_ * AW + h * 128 + e0); od[0] = (f32x4){o[0], o[1], o[2], o[3]}; od[1] = (f32x4){o[4], o[5], o[6], o[7]}; }
}

__device__ __forceinline__ void attn_row_naive(Frame& F, int l, int row) {
    const int lane = F.lane; const bool samp = row >= MP;
    const int n = samp ? ((row - MP) >> 3) : (row >> 12), t = samp ? ((row - MP) & 7) : (row & 4095);
    float ssq = 0.f; float* tmp = F_WS(float, WS_T) + (size_t)row * DM;
#pragma nounroll
    for (int h = 0; h < 8; ++h) {
        const unsigned qw = ((const unsigned*)(F_WS(bf16, WS_Q) + (size_t)row * AW + h * 128))[lane];
        const float q0 = bf_lo(qw), q1 = bf_hi(qw);
        float m = -3.0e38f, ls = 0.f, o0 = 0.f, o1 = 0.f;
#pragma nounroll
        for (int pi = 0; pi < 3; ++pi) {
            const int d = pi == 0 ? 1 : (pi == 1 ? 4 : 16);
            const float* bt = F_WS(float, WS_BIAS) + (pi * 8 + h) * 129;
#pragma nounroll
            for (int jj = 0; jj <= 128; ++jj) {
                float k0, k1, v0, v1;
                if (!samp) { const int tk = t - jj * d; if (tk < 0) break;
                    const size_t off = ((size_t)(n * SEQ + tk)) * AW + h * 128;
                    const unsigned kw = ((const unsigned*)(F_WS(bf16, WS_K) + off))[lane], vw = ((const unsigned*)(F_WS(bf16, WS_V) + off))[lane];
                    k0 = bf_lo(kw); k1 = bf_hi(kw); v0 = bf_lo(vw); v1 = bf_hi(vw);
                } else { const int idx = 2048 + t - jj * d; const float *kp, *vp;
                    if (idx < 2048) { const size_t off = ((((size_t)l * 8 + n) * 2048 + idx) * 8 + h) * 128; kp = F_IN(I_CK) + off; vp = F_IN(I_CV) + off; }
                    else { const size_t off = (((size_t)l * 8 + n) * 8 + (idx - 2048)) * 1024 + h * 128; kp = F.out + O_NKS + off; vp = F.out + O_NVS + off; }
                    const f32x2v kk = ((const f32x2v*)kp)[lane], vv = ((const f32x2v*)vp)[lane]; k0 = kk.x; k1 = kk.y; v0 = vv.x; v1 = vv.y; }
                const float s = wave_sum(q0 * k0 + q1 * k1) + bt[jj];
                const float mn = fmaxf(m, s), al = exp2f(m - mn), p = exp2f(s - mn);
                ls = ls * al + p; o0 = o0 * al + p * v0; o1 = o1 * al + p * v1; m = mn;
            }
        }
        const float inv = 1.0f / ls; o0 *= inv; o1 *= inv; ssq += o0 * o0 + o1 * o1;
        f32x2v ov; ov.x = o0; ov.y = o1; ((f32x2v*)(tmp + h * 128))[lane] = ov;
    }
    const float r = 1.0f / sqrtf(wave_sum(ssq) * (1.0f / AW) + EPS);
    const float* g = F_IN(I_GMIXOUT) + l * DM;
#pragma nounroll
    for (int h = 0; h < 8; ++h) { const int col = h * 128 + 2 * lane; const f32x2v ov = ((const f32x2v*)(tmp + h * 128))[lane];
        ((unsigned*)(F_WS(bf16, WS_MIX) + (size_t)row * DM + col))[0] = pk2(ov.x * r * g[col], ov.y * r * g[col + 1]); }
}

__device__ __forceinline__ void ssm_seq_naive(Frame& F, int l, int seq, int g) {
    const int p = F.lane; const bool samp = seq >= 2; const int n = samp ? seq - 2 : seq;
    const int L = samp ? 8 : SEQ, row0 = samp ? MP + n * 8 : n * SEQ;
    const size_t gp = ((size_t)l * 32 + g) * 64 + p;
    const float lr = F_IN(I_LAMRE)[gp], li = F_IN(I_LAMIM)[gp], step = expf(F_IN(I_LOGSTEP)[l * 32 + g]);
    const float mag = expf(lr * step), are = mag * cosf(li * step), aim = mag * sinf(li * step);
    const float den = lr * lr + li * li, cre_ = ((are - 1.0f) * lr + aim * li) / den, cim_ = (aim * lr - (are - 1.0f) * li) / den;
    float bbr[16], bbi[16], ccr[16], cci[16];
#pragma unroll
    for (int c = 0; c < 16; ++c) { const float br = F_IN(I_BRE)[gp * 16 + c], bi = F_IN(I_BIM)[gp * 16 + c];
        bbr[c] = cre_ * br - cim_ * bi; bbi[c] = cre_ * bi + cim_ * br;
        ccr[c] = F_IN(I_CRE)[(((size_t)l * 32 + g) * 16 + c) * 64 + p]; cci[c] = F_IN(I_CIM)[(((size_t)l * 32 + g) * 16 + c) * 64 + p]; }
    float hr = 0.f, hi = 0.f;
    if (samp) { hr = F_IN(I_SRE)[(((size_t)l * 8 + n) * 32 + g) * 64 + p]; hi = F_IN(I_SIM)[(((size_t)l * 8 + n) * 32 + g) * 64 + p]; }
    const float dsk = (p < 16) ? F_IN(I_SSMD)[l * SW + g * 16 + p] : 0.f;
#pragma nounroll
    for (int t = 0; t < L; ++t) {
        const int row = row0 + t;
        const v4u ua = *(const v4u*)(F_WS(bf16, WS_U) + (size_t)row * SW + g * 16), ub = *(const v4u*)(F_WS(bf16, WS_U) + (size_t)row * SW + g * 16 + 8);
        float u[16];
        u[0] = bf_lo(ua.x); u[1] = bf_hi(ua.x); u[2] = bf_lo(ua.y); u[3] = bf_hi(ua.y); u[4] = bf_lo(ua.z); u[5] = bf_hi(ua.z); u[6] = bf_lo(ua.w); u[7] = bf_hi(ua.w);
        u[8] = bf_lo(ub.x); u[9] = bf_hi(ub.x); u[10] = bf_lo(ub.y); u[11] = bf_hi(ub.y); u[12] = bf_lo(ub.z); u[13] = bf_hi(ub.z); u[14] = bf_lo(ub.w); u[15] = bf_hi(ub.w);
        float xr = 0.f, xi = 0.f;
#pragma unroll
        for (int c = 0; c < 16; ++c) { xr += bbr[c] * u[c]; xi += bbi[c] * u[c]; }
        const float nhr = are * hr - aim * hi + xr, nhi = are * hi + aim * hr + xi; hr = nhr; hi = nhi;
        float ymine = 0.f;
#pragma unroll
        for (int c = 0; c < 16; ++c) { const float yc = wave_sum(ccr[c] * hr - cci[c] * hi) + 0.f; if (p == c) ymine = yc + dsk * u[c]; }
        if (p < 16) F_WS(float, WS_Y)[(size_t)row * SW + g * 16 + p] = ymine;
    }
    if (!samp) { F.out[O_SRP + (((size_t)l * 2 + n) * 32 + g) * 64 + p] = hr; F.out[O_SIP + (((size_t)l * 2 + n) * 32 + g) * 64 + p] = hi; }
    else { F.out[O_SRS + (((size_t)l * 8 + n) * 32 + g) * 64 + p] = hr; F.out[O_SIS + (((size_t)l * 8 + n) * 32 + g) * 64 + p] = hi; }
}

__device__ __forceinline__ void glu_row_naive(Frame& F, int l, int row) {
    const int lane = F.lane; const float* yrow = F_WS(float, WS_Y) + (size_t)row * SW; const float* W = F_IN(I_WGLU) + (size_t)l * SW * SW;
    float acc[8];
#pragma unroll
    for (int i = 0; i < 8; ++i) acc[i] = F_IN(I_BGLU)[l * SW + lane + 64 * i];
#pragma nounroll
    for (int k = 0; k < SW; ++k) { const float yk = yrow[k];
#pragma unroll
        for (int i = 0; i < 8; ++i) acc[i] += yk * W[(size_t)k * SW + lane + 64 * i]; }
    float o[8]; float ss = 0.f;
#pragma unroll
    for (int i = 0; i < 8; ++i) { o[i] = yrow[lane + 64 * i] * (1.0f / (1.0f + expf(-acc[i]))); ss += o[i] * o[i]; }
    const float r = 1.0f / sqrtf(wave_sum(ss) * (1.0f / SW) + EPS);
    const float* g = F_IN(I_GMIXOUT) + l * DM + 1024;
#pragma unroll
    for (int i = 0; i < 8; ++i) F_WS(bf16, WS_MIX)[(size_t)row * DM + 1024 + lane + 64 * i] = (bf16)f2bf(o[i] * r * g[lane + 64 * i]);
}

__device__ __forceinline__ void sgu_row_naive(Frame& F, int l, int row) {
    const int lane = F.lane; const bool samp = row >= MP;
    const int t = samp ? ((row - MP) & 7) : (row & 4095), tl = samp ? t : (t & 127), rowc = row - tl;
    float acc[8];
#pragma unroll
    for (int i = 0; i < 8; ++i) acc[i] = 0.f;
    const float* sg = F_IN(I_SGUG) + l * GW;
#pragma nounroll
    for (int sl = 0; sl <= tl; ++sl) {
        const int srow = rowc + sl; float xv[8]; float s = 0.f;
#pragma unroll
        for (int i = 0; i < 8; ++i) { xv[i] = bf2f(F_WS(bf16, WS_GV)[(size_t)srow * GW + lane + 64 * i]); s += xv[i]; }
        const float mean = wave_sum(s) * (1.0f / GW); float q = 0.f;
#pragma unroll
        for (int i = 0; i < 8; ++i) { xv[i] -= mean; q += xv[i] * xv[i]; }
        const float rstd = 1.0f / sqrtf(wave_sum(q) * (1.0f / GW) + EPS);
#pragma unroll
        for (int i = 0; i < 8; ++i) { const float gvv = xv[i] * rstd * sg[lane + 64 * i];
            const float w = F_IN(I_SGUW)[(((size_t)l * 4 + (i >> 1)) * 128 + tl) * 128 + sl];
            acc[i] += w * gvv;
            if (samp && sl == tl) F.out[O_SGV + ((size_t)l * 64 + (row - MP)) * GW + lane + 64 * i] = gvv; }
    }
    float o[8]; float ss = 0.f;
#pragma unroll
    for (int i = 0; i < 8; ++i) { const float mixed = acc[i] + F_IN(I_SGUB)[((size_t)l * 4 + (i >> 1)) * 128 + tl];
        o[i] = bf2f(F_WS(bf16, WS_GU)[(size_t)row * GW + lane + 64 * i]) * mixed; ss += o[i] * o[i]; }
    const float r = 1.0f / sqrtf(wave_sum(ss) * (1.0f / GW) + EPS);
    const float* g = F_IN(I_GMIXOUT) + l * DM + 1536;
#pragma unroll
    for (int i = 0; i < 8; ++i) F_WS(bf16, WS_MIX)[(size_t)row * DM + 1536 + lane + 64 * i] = (bf16)f2bf(o[i] * r * g[lane + 64 * i]);
}

struct ArgsN { const float* in[30]; float* out; unsigned char* ws; int l, pad; };
__global__ void __launch_bounds__(512) k_p2_naive(ArgsN a) {
    const int l = a.l, lane = threadIdx.x & 63, gw = blockIdx.x * 8 + (threadIdx.x >> 6), NGW = gridDim.x * 8; const float* const* inp = a.in; float* out = a.out; unsigned char* ws = a.ws;
    Frame F; F.lds = nullptr; F.MISC = nullptr; F.ctl = nullptr; F.tid = 0; F.lane = lane; F.wave = 0; F.vcu = 0; F.G = 0; F.inp = inp; F.out = out; F.ws = ws;
#if !FAST_SSM
    for (int k = gw; k < 320 * 6; k += NGW) if (k % 6 == 0) { const int task = k / 6; ssm_seq_naive(F, l, task / 32, task % 32); }
#endif
#if !FAST_ATTN
    for (int row = gw; row < MREAL; row += NGW) attn_row_naive(F, l, row);
#endif
#if !FAST_SGU
    for (int row = gw; row < MREAL; row += NGW) sgu_row_naive(F, l, row);
#endif
}
__global__ void __launch_bounds__(512, 2) k_p2_fast(ArgsN a) {
    extern __shared__ __attribute__((aligned(16))) unsigned char ldsf[];
    const int tid = threadIdx.x, lane = tid & 63, gw = blockIdx.x * 8 + (tid >> 6), NGW = gridDim.x * 8; (void)lane; (void)gw; (void)NGW;
#if FAST_ATTN
    for (int u = blockIdx.x; u < ATT_UNITS; u += gridDim.x) attn_unit((LAS unsigned char*)ldsf, a.ws, u, tid);
    for (int task = gw; task < 512; task += NGW) attn_sample_task(a.ws, a.in, a.out, a.l, task, lane);
#endif
#if FAST_SGU
    __syncthreads();
    for (int u = blockIdx.x; u < SGU_UNITS; u += gridDim.x) sgu_unit((LAS unsigned char*)ldsf, a.ws, a.in, a.out, a.l, u, tid);
#endif
#if FAST_SSM
    __syncthreads();
    for (int wu = gw; wu < 1024; wu += NGW) ssm_pass1_unit((LAS unsigned char*)ldsf + (tid >> 6) * XW_BYTES, a.ws, a.l, wu, lane);
#endif
}
__global__ void __launch_bounds__(512, 2) k_p3_fast(ArgsN a) {
    extern __shared__ __attribute__((aligned(16))) unsigned char ldsf[];
    const int tid = threadIdx.x, lane = tid & 63, gw = blockIdx.x * 8 + (tid >> 6), NGW = gridDim.x * 8; (void)lane; (void)gw; (void)NGW;
#if FAST_ATTN
    for (int row = gw; row < MREAL; row += NGW) attn_combine_row(a.ws, a.in, a.l, row, lane);
#endif
#if FAST_SSM
    __syncthreads();
    for (int u = blockIdx.x; u < SSM2_UNITS; u += gridDim.x) ssm_pass2_unit((LAS unsigned char*)ldsf, a.ws, a.in, a.out, a.l, u, tid);
#endif
}
__global__ void __launch_bounds__(512) k_p3_naive(ArgsN a) {
    const int l = a.l, lane = threadIdx.x & 63, gw = blockIdx.x * 8 + (threadIdx.x >> 6), NGW = gridDim.x * 8; const float* const* inp = a.in; float* out = a.out; unsigned char* ws = a.ws;
    Frame F; F.lds = nullptr; F.MISC = nullptr; F.ctl = nullptr; F.tid = 0; F.lane = lane; F.wave = 0; F.vcu = 0; F.G = 0; F.inp = inp; F.out = out; F.ws = ws;
#if !FAST_SSM
    for (int row = gw; row < MREAL; row += NGW) glu_row_naive(F, l, row);
#endif
}

struct Args { const float* in[30]; float* out; unsigned char* ws; int ph_lo, ph_hi, li, pad; };
__global__ void __launch_bounds__(NWAVES * 64, 2) fwd(Args args) {
    extern __shared__ __attribute__((aligned(16))) unsigned char lds[];
    Frame F;
    F.lds = (LAS unsigned char*)lds;
    F.MISC = (volatile LAS unsigned*)(F.lds + MISC_OFF);
    F.tid = threadIdx.x; F.lane = F.tid & 63; F.wave = __builtin_amdgcn_readfirstlane(F.tid >> 6);
    F.G = gridDim.x; { const int bx = blockIdx.x; F.vcu = (F.G % 8 == 0) ? (bx % 8) * (F.G / 8) + bx / 8 : bx; }
    unsigned char* ws = args.ws;
    F.ctl = (gu32*)(ws + WS_CTL);
    F.inp = args.in; F.out = args.out; F.ws = ws;
    for (int u = F.tid; u < (LDS_BYTES - LDSCTL_OFF) / 4; u += NWAVES * 64) ((LAS unsigned*)(F.lds + LDSCTL_OFF))[u] = 0u;
    __syncthreads();
    XcdBarrier bar; bar.bar = (unsigned*)(F.ctl + CW_BAR); bar.x = 0; bar.st = nullptr;
    if (!MK_PER_PHASE) bar = xcd_barrier_post((unsigned*)(F.ctl + CW_BAR), F.MISC + 8);
#define GRID_BAR() do { if (!MK_PER_PHASE) xcd_barrier(bar); } while (0)
    const int lo = args.ph_lo, hi = args.ph_hi;
#define IN(k) (lo <= (k) && (k) < hi)
#define BOTH(k) (IN(k) && IN((k) + 1))
    const int gw = F.vcu * NWAVES + F.wave, NGW = F.G * NWAVES;

    if (IN(0)) { p0_prologue(F); if (BOTH(0)) GRID_BAR(); }

    for (int l = 0; l < DEPTH; ++l) {
        const int pb = 1 + 8 * l;
        if (IN(pb + 0)) {
            pg8::Gemm g{F_WS(bf16, WS_XN), F_WS(bf16, WS_WIN) + (size_t)l * INC * DM, MTOT, INC, DM}; pg8::StaticOrder S; S.init(MTOT, INC, F.G, (int)blockIdx.x);
            pg8::EpiIn E{F.ws, F.out, l};
            pg8::gemm_phase<pg8::EpiIn, pg8::StaticOrder, true, true>(F.lds + RING_OFF, g, S, E);
            if (BOTH(pb + 0)) GRID_BAR();
        }
        if (IN(pb + 1)) {
#if MK_FUSED_MIXERS
            { int tl_ = threadIdx.x; asm volatile("" : "+v"(tl_));
              const int ln_ = tl_ & 63;
              for (int u = (int)blockIdx.x; u < ATT_UNITS; u += F.G) attn_unit(F.lds, F.ws, u, tl_);
              __syncthreads();
              if (gw >= 512 && gw < 1024) attn_sample_task2(F.lds + (tl_ >> 6) * SATT_LDS_PER_WAVE, F.ws, F.inp, F.out, l, gw - 512, ln_);
              __syncthreads();
              for (int u = F.G - 1 - (int)blockIdx.x; u < SGU_UNITS; u += F.G) sgu_unit(F.lds, F.ws, F.inp, F.out, l, u, tl_);
              __syncthreads();
              for (int wu = NGW - 1 - gw; wu < 1024; wu += NGW) ssm_pass1_unit(F.lds + (tl_ >> 6) * XW_BYTES, F.ws, l, wu, ln_); }
#endif
            if (BOTH(pb + 1)) GRID_BAR();
        }
        if (IN(pb + 2)) {
#if MK_FUSED_MIXERS
            { int tl_ = threadIdx.x; asm volatile("" : "+v"(tl_));
              const int ln_ = tl_ & 63;
              for (int row = gw; row < MREAL; row += NGW) attn_combine_row(F.ws, F.inp, l, row, ln_);
              __syncthreads();
              for (int u = (int)blockIdx.x; u < SSM2_UNITS; u += F.G) ssm_pass2_unit(F.lds, F.ws, F.inp, F.out, l, u, tl_); }
#endif
            if (BOTH(pb + 2)) GRID_BAR();
        }
        if (IN(pb + 3)) {
            { int tl_ = threadIdx.x; asm volatile("" : "+v"(tl_));
              for (int c = (int)blockIdx.x; c < 256; c += F.G) sample_gemm_n2048<DM>(F.lds, F_WS(bf16, WS_MIX) + (size_t)MP * DM, F_WS(bf16, WS_WOUT) + (size_t)l * DM * DM, F_WS(float, WS_T), c, tl_); }
            pg8::Gemm g{F_WS(bf16, WS_MIX), F_WS(bf16, WS_WOUT) + (size_t)l * DM * DM, MP, DM, DM}; pg8::StaticOrder S; S.init(MP, DM, F.G, (int)blockIdx.x);
            pg8::EpiF32 E{F_WS(float, WS_T), DM};
            pg8::gemm_phase<pg8::EpiF32, pg8::StaticOrder, true, true>(F.lds + RING_OFF, g, S, E);
            if (BOTH(pb + 3)) GRID_BAR();
        }
        if (IN(pb + 4)) { norm_rows(F, F_IN(I_GPOSTMIX) + l * DM); if (BOTH(pb + 4)) GRID_BAR(); }
        if (IN(pb + 5)) {
            pg8::Gemm g{F_WS(bf16, WS_XN), F_WS(bf16, WS_WGU) + (size_t)l * FF2 * DM, MTOT, FF2, DM}; pg8::StaticOrder S; S.init(MTOT, FF2, F.G, (int)blockIdx.x);
            pg8::EpiGU E{F.ws};
            pg8::gemm_phase<pg8::EpiGU, pg8::StaticOrder, true, true>(F.lds + RING_OFF, g, S, E);
            if (BOTH(pb + 5)) GRID_BAR();
        }
        if (IN(pb + 6)) {
            { int tl_ = threadIdx.x; asm volatile("" : "+v"(tl_));
              for (int c = (int)blockIdx.x; c < 256; c += F.G) sample_gemm_n2048<FF>(F.lds, F_WS(bf16, WS_H) + (size_t)MP * FF, F_WS(bf16, WS_WDN) + (size_t)l * DM * FF, F_WS(float, WS_T), c, tl_); }
            pg8::Gemm g{F_WS(bf16, WS_H), F_WS(bf16, WS_WDN) + (size_t)l * DM * FF, MP, DM, FF}; pg8::StaticOrder S; S.init(MP, DM, F.G, (int)blockIdx.x);
            pg8::EpiF32 E{F_WS(float, WS_T), DM};
            pg8::gemm_phase<pg8::EpiF32, pg8::StaticOrder, true, true>(F.lds + RING_OFF, g, S, E);
            if (BOTH(pb + 6)) GRID_BAR();
        }
        if (IN(pb + 7)) { norm_rows(F, F_IN(I_GPOSTFFN) + l * DM); if (BOTH(pb + 7)) GRID_BAR(); }
    }
#undef IN
#undef BOTH
}

extern "C" void kernel_launch(void* const* d_in, const int* in_sizes, int n_in, void* d_out, int out_size, void* d_ws, size_t ws_size, hipStream_t stream) {
    static int grid = 0;
    if (grid == 0) {
        if (n_in != 30 || out_size < (int)O_END || ws_size < WS_END) { fprintf(stderr, "kernel_launch: unexpected problem shape (n_in %d out %d ws %zu)\n", n_in, out_size, ws_size); grid = -1; return; }
        int dev = 0, cus = 0;
        if (hipGetDevice(&dev) != hipSuccess || hipDeviceGetAttribute(&cus, hipDeviceAttributeMultiprocessorCount, dev) != hipSuccess) { grid = -1; return; }
#if MK_PER_PHASE
        (void)hipFuncSetAttribute((const void*)k_p2_fast, hipFuncAttributeMaxDynamicSharedMemorySize, LDS_BYTES); (void)hipFuncSetAttribute((const void*)k_p3_fast, hipFuncAttributeMaxDynamicSharedMemorySize, LDS_BYTES);
#endif
        if (hipFuncSetAttribute((const void*)fwd, hipFuncAttributeMaxDynamicSharedMemorySize, LDS_BYTES) != hipSuccess) { fprintf(stderr, "kernel_launch: hipFuncSetAttribute failed\n"); grid = -1; return; }
        int per_cu = 0;
        if (hipOccupancyMaxActiveBlocksPerMultiprocessor(&per_cu, (const void*)fwd, NWAVES * 64, LDS_BYTES) != hipSuccess || per_cu < 1) { fprintf(stderr, "kernel_launch: occupancy query says %d\n", per_cu); }
        (void)hipGetLastError();
        grid = cus;
    }
    if (grid < 0) return;
    if (hipMemsetAsync((char*)d_ws + WS_CTL, 0, CTL_ZERO_BYTES, stream) != hipSuccess) return;
    Args a{};
    for (int i = 0; i < 30; ++i) a.in[i] = (const float*)d_in[i];
    a.out = (float*)d_out; a.ws = (unsigned char*)d_ws; a.li = 0; a.pad = 0;
#if MK_PER_PHASE
    ArgsN an{}; for (int i = 0; i < 30; ++i) an.in[i] = (const float*)d_in[i]; an.out = (float*)d_out; an.ws = (unsigned char*)d_ws;
    for (int p = 0; p < N_PHASES; ++p) {
        const int k = (p == 0) ? -1 : (p - 1) % 8, l = (p - 1) / 8;
        if (k == 1) { an.l = l; hipLaunchKernelGGL(k_p2_naive, dim3(256), dim3(512), 0, stream, an); hipLaunchKernelGGL(k_p2_fast, dim3(256), dim3(512), LDS_BYTES, stream, an); }
        else if (k == 2) { an.l = l; hipLaunchKernelGGL(k_p3_naive, dim3(256), dim3(512), 0, stream, an); hipLaunchKernelGGL(k_p3_fast, dim3(256), dim3(512), LDS_BYTES, stream, an); }
        else { a.ph_lo = p; a.ph_hi = p + 1; hipLaunchKernelGGL(fwd, dim3(grid), dim3(NWAVES * 64), LDS_BYTES, stream, a); }
    }
#else
    a.ph_lo = 0; a.ph_hi = N_PHASES;
    hipLaunchKernelGGL(fwd, dim3(grid), dim3(NWAVES * 64), LDS_BYTES, stream, a);
#endif
}
```

```cpp
#include <hip/hip_runtime.h>
#include <cstdio>
#include <cstdint>
#define MK_PER_PHASE 0
#define FAST_ATTN 1
#define FAST_SSM 1
#define FAST_SGU 1
constexpr int NWAVES = 8;
#ifndef MK_PER_PHASE
#define MK_PER_PHASE 0
#endif
constexpr int DM = 2048, MP = 8192, MS = 64, MREAL = 8256, MTOT = 8448, SEQ = 4096;
constexpr int AW = 1024, SW = 512, GW = 512, INC = 4608, FF = 5632, FF2 = 11264, DEPTH = 4;
constexpr int N_PHASES = 1 + 8 * DEPTH;
constexpr float EPS = 1e-6f;
constexpr float LOG2E = 1.4426950408889634f;
constexpr float QSCALE = 0.08838834764831845f * 1.4426950408889634f;

constexpr size_t O_YP = 0, O_YS = 16777216, O_NKP = 16908288, O_NVP = 33685504, O_SRP = 50462720, O_SIP = 50479104, O_NKS = 50495488,
                 O_NVS = 50757632, O_SRS = 51019776, O_SIS = 51085312, O_SGV = 51150848, O_END = 51281920;
constexpr size_t MiB = 1u << 20;
constexpr size_t WS_CTL = 0, CTL_ZERO_BYTES = 1 * MiB;
constexpr size_t WS_WIN = 1 * MiB, SZ_WIN = (size_t)INC * DM * 2;
constexpr size_t WS_WOUT = WS_WIN + DEPTH * SZ_WIN, SZ_WOUT = (size_t)DM * DM * 2;
constexpr size_t WS_WGU = WS_WOUT + DEPTH * SZ_WOUT, SZ_WGU = (size_t)FF2 * DM * 2;
constexpr size_t WS_WDN = WS_WGU + DEPTH * SZ_WGU, SZ_WDN = (size_t)DM * FF * 2;
constexpr size_t WS_XN = WS_WDN + DEPTH * SZ_WDN;
constexpr size_t WS_Q = WS_XN + (size_t)MTOT * DM * 2;
constexpr size_t WS_K = WS_Q + (size_t)MTOT * AW * 2;
constexpr size_t WS_V = WS_K + (size_t)MTOT * AW * 2;
constexpr size_t WS_U = WS_V + (size_t)MTOT * AW * 2;
constexpr size_t WS_GU = WS_U + (size_t)MTOT * SW * 2;
constexpr size_t WS_GV = WS_GU + (size_t)MTOT * GW * 2;
constexpr size_t WS_MIX = WS_GV + (size_t)MTOT * GW * 2;
constexpr size_t WS_T = WS_MIX + (size_t)MTOT * DM * 2;
constexpr size_t WS_H = WS_T + (size_t)MTOT * DM * 4;
constexpr size_t WS_Y = WS_H + (size_t)MTOT * FF * 2;
constexpr size_t WS_RS = WS_Y + (size_t)MTOT * SW * 4;
constexpr size_t WS_BIAS = WS_RS + 65536;
constexpr size_t WS_WGLU = WS_BIAS + 65536;
constexpr size_t WS_WM = WS_WGLU + (size_t)DEPTH * 512 * 512 * 2;
constexpr size_t WS_AP = WS_WM + (size_t)DEPTH * 4 * 128 * 128 * 2;
constexpr size_t WS_BBF = WS_AP + (size_t)DEPTH * 32 * 64 * 8 * 4;
constexpr size_t WS_CF = WS_BBF + (size_t)DEPTH * 32 * 8 * 64 * 8 * 2;
constexpr size_t WS_SLOC = WS_CF + (size_t)DEPTH * 32 * 4 * 64 * 8 * 2;
constexpr size_t WS_END = WS_SLOC + (size_t)2 * 16 * 8 * 32 * 64 * 2 * 4;
constexpr size_t WS_OBUF = WS_H;
constexpr size_t WS_LSE = WS_T;
constexpr size_t WS_SATT = WS_T + 1 * MiB;
static_assert((size_t)3 * 8192 * 1024 * 2 <= (size_t)MTOT * FF * 2 && (size_t)3 * 8192 * 8 * 4 <= MiB, "overlays");
static_assert(WS_XN % 256 == 0 && WS_Q % 256 == 0 && WS_U % 256 == 0 && WS_MIX % 256 == 0 && WS_T % 256 == 0 && WS_H % 256 == 0 && WS_Y % 256 == 0 && WS_RS % 256 == 0, "ws alignment");
constexpr int CW_BAR = 4096;
constexpr int RING_OFF = 0, RING_BYTES = 131072;
constexpr int LDSCTL_OFF = RING_BYTES, MISC_OFF = LDSCTL_OFF + 320;
constexpr int LDS_BYTES = 147456;

namespace pg8 {
#define PG8_LAS __attribute__((address_space(3)))
typedef unsigned short bf16_t;
typedef short bf16x8 __attribute__((ext_vector_type(8)));
typedef float f32x4 __attribute__((ext_vector_type(4)));
typedef unsigned u32x4 __attribute__((ext_vector_type(4)));
constexpr int BM = 256, BK = 64, HALF = 128, HTB = HALF * BK * 2  , STAGE_BYTES = 8 * HTB, NXCD = 8, WGM = 8;

__host__ __device__ __forceinline__ int lds_byte(int r, int c) { const int st = (r >> 4) * 2 + (c >> 5), rr = r & 15, cc = c & 31, ob = rr * 64 + cc * 2; return st * 1024 + (ob ^ (((ob >> 9) & 1) << 5)); }
__host__ __device__ __forceinline__ void stage_rc(int b, int& R, int& C) { const int st = b / 1024, sb = b % 1024, swz = sb ^ (((sb >> 9) & 1) << 5); R = (st >> 1) * 16 + swz / 64; C = (st & 1) * 32 + (swz % 64) / 2; }
__host__ __device__ __forceinline__ int perm32(int rho) { const int n = rho >> 4, i = rho & 15; return 8 * (i >> 2) + 4 * n + (i & 3); }

struct Unit { int pm, pn; };
struct Gemm { const bf16_t* A; const bf16_t* Bt; int M, N, K; };

struct StaticOrder {
    int nM, nN, nwg, G, c;
    __host__ __device__ void init(int M, int N, int G_, int c_) { nM = M / BM; nN = N / BM; nwg = nM * nN; G = G_; c = c_; }
    __host__ __device__ bool next(int i, Unit& u) const {
        const long L = (long)i * G + c; if (L >= nwg) return false;
        int wgid = (int)L; { const int q = nwg / NXCD, r = nwg % NXCD, xcd = wgid % NXCD, off = wgid / NXCD; wgid = (xcd < r ? xcd * (q + 1) : r * (q + 1) + (xcd - r) * q) + off; }
        const int nig = WGM * nN, gid = wgid / nig, fm = gid * WGM, gsz = (nM - fm) < WGM ? (nM - fm) : WGM;
        u.pm = fm + ((wgid % nig) % gsz); u.pn = (wgid % nig) / gsz; return true;
    }
    __device__ __forceinline__ void a_ready(const Unit&) const {}
    __device__ __forceinline__ void done(const Unit&) const {}
};
__device__ __forceinline__ unsigned cvt_pk_bf16(float lo, float hi) { unsigned r; asm volatile("v_cvt_pk_bf16_f32 %0, %1, %2" : "=v"(r) : "v"(lo), "v"(hi)); return r; }
template <class Epi, class Sched, bool ALIGN_EPI = false, bool SP2 = false>
__device__ __forceinline__ void gemm_phase(PG8_LAS unsigned char* lds, const Gemm g, const Sched& S, const Epi& E) {
    int tid_raw = threadIdx.x; asm volatile("" : "+v"(tid_raw));
    const int tid = tid_raw, wid = __builtin_amdgcn_readfirstlane(tid >> 6), lane = tid & 63, wr = wid >> 2, wc = wid & 3, fr = lane & 15, fq = lane >> 4;
    const int K = g.K, nt = K / BK;
    unsigned voffA[2], voffB[2];
#pragma unroll
    for (int i = 0; i < 2; ++i) { int R, C; stage_rc(tid * 16 + i * 8192, R, C); const int Rb = Epi::PERM ? ((R & ~31) + perm32(R & 31)) : R;
        voffA[i] = (unsigned)(R * K + C) * 2u; voffB[i] = (unsigned)(Rb * K + C) * 2u; }
    const size_t kstep = (size_t)(BK * 2);
    const size_t hstep = (size_t)HALF * K * 2;
    const size_t tstep = 2 * hstep;
    const unsigned ldsw = (unsigned)wid * 1024u;
    const int aoff = lds_byte(wr * 64 + fr, fq * 8), boff = lds_byte(wc * 32 + fr, fq * 8);
#define PG8_SA(b, h) (((b) * 2 + (h)) * HTB)
#define PG8_SB(b, h) ((4 + (b) * 2 + (h)) * HTB)
#define PG8_STAGE(bufoff, gbase, voff) do { _Pragma("unroll") for (int _i = 0; _i < 2; ++_i) \
        __builtin_amdgcn_global_load_lds((const unsigned*)((const char*)(gbase) + (voff)[_i]), (PG8_LAS unsigned*)(lds + (bufoff) + ldsw + _i * 8192), 16, 0, 0); } while (0)
#define PG8_LDA(dst, b, h) do { _Pragma("unroll") for (int m = 0; m < 4; ++m) _Pragma("unroll") for (int k = 0; k < 2; ++k) dst[m][k] = *(const PG8_LAS bf16x8*)(lds + PG8_SA(b, h) + aoff + m * 2048 + k * 1024); } while (0)
#define PG8_LDB(dst, b, h) do { _Pragma("unroll") for (int n = 0; n < 2; ++n) _Pragma("unroll") for (int k = 0; k < 2; ++k) dst[n][k] = *(const PG8_LAS bf16x8*)(lds + PG8_SB(b, h) + boff + n * 2048 + k * 1024); } while (0)
#define PG8_MMA(ai, bj, At, Bt) do { __builtin_amdgcn_s_setprio(1); _Pragma("unroll") for (int m = 0; m < 4; ++m) _Pragma("unroll") for (int n = 0; n < 2; ++n) _Pragma("unroll") for (int k = 0; k < 2; ++k) \
        acc[ai][bj][m][n] = __builtin_amdgcn_mfma_f32_16x16x32_bf16(Bt[n][k], At[m][k], acc[ai][bj][m][n], 0, 0, 0); __builtin_amdgcn_s_setprio(0); } while (0)
#define PG8_WAIT_V(n) asm volatile("s_waitcnt vmcnt(" #n ")" ::: "memory")
#define PG8_WAIT_L(n) asm volatile("s_waitcnt lgkmcnt(" #n ")" ::: "memory")
#define PG8_BAR __builtin_amdgcn_s_barrier()
#define PG8_SCHED __builtin_amdgcn_sched_barrier(0)
    Unit cur, nxt; int ui = 0;
    if (!S.next(0, cur)) return;
    f32x4 acc[2][2][4][2];
#pragma unroll
    for (int a = 0; a < 2; ++a)
#pragma unroll
        for (int b = 0; b < 2; ++b)
#pragma unroll
            for (int m = 0; m < 4; ++m)
#pragma unroll
                for (int n = 0; n < 2; ++n) acc[a][b][m][n] = (f32x4){0.f, 0.f, 0.f, 0.f};
    bf16x8 At[4][2], B0[2][2], B1[2][2];
    const char* cA = (const char*)g.A + (size_t)cur.pm * tstep; const char* cB = (const char*)g.Bt + (size_t)cur.pn * tstep;
    S.a_ready(cur);
    if constexpr (SP2) {
        PG8_STAGE(PG8_SB(0, 0), cB, voffB); PG8_STAGE(PG8_SB(0, 1), cB + hstep, voffB); PG8_STAGE(PG8_SA(0, 0), cA, voffA); PG8_STAGE(PG8_SA(0, 1), cA + hstep, voffA);
        if (wr == 1) PG8_BAR;
        PG8_WAIT_V(2); PG8_BAR;
        PG8_STAGE(PG8_SB(1, 0), cB + kstep, voffB); PG8_STAGE(PG8_SA(1, 0), cA + kstep, voffA); PG8_STAGE(PG8_SB(1, 1), cB + hstep + kstep, voffB);
        PG8_WAIT_V(6); PG8_BAR;
    } else {
        PG8_STAGE(PG8_SB(0, 0), cB, voffB); PG8_STAGE(PG8_SA(0, 0), cA, voffA); PG8_STAGE(PG8_SB(0, 1), cB + hstep, voffB); PG8_STAGE(PG8_SA(0, 1), cA + hstep, voffA);
        if (wr == 1) PG8_BAR;
        PG8_WAIT_V(4); PG8_BAR;
        PG8_STAGE(PG8_SB(1, 0), cB + kstep, voffB); PG8_STAGE(PG8_SA(1, 0), cA + kstep, voffA); PG8_STAGE(PG8_SB(1, 1), cB + hstep + kstep, voffB);
        PG8_WAIT_V(6); PG8_BAR;
    }
    for (;;) {
        const bool has_next = S.next(ui + 1, nxt);
        const char* nA = has_next ? (const char*)g.A + (size_t)nxt.pm * tstep : cA; const char* nB = has_next ? (const char*)g.Bt + (size_t)nxt.pn * tstep : cB;
        for (int t = 0; t < nt; t += 2) {
            const bool last = (t == nt - 2);
            const char* a1 = cA + (size_t)(t + 1) * kstep;
            const char* a2 = last ? nA : cA + (size_t)(t + 2) * kstep; const char* b2 = last ? nB : cB + (size_t)(t + 2) * kstep;
            const char* a3 = a2 + kstep; const char* b3 = b2 + kstep;
            if (last && has_next) S.a_ready(nxt);
            if constexpr (SP2) {
            PG8_LDB(B0, 0, 0); PG8_LDB(B1, 0, 1); PG8_SCHED; PG8_LDA(At, 0, 0); PG8_STAGE(PG8_SA(1, 1), a1 + hstep, voffA);
            PG8_WAIT_V(8); PG8_WAIT_L(0); PG8_BAR; PG8_MMA(0, 0, At, B0); PG8_MMA(0, 1, At, B1); PG8_BAR; PG8_SCHED;
            PG8_LDA(At, 0, 1); PG8_STAGE(PG8_SB(0, 0), b2, voffB); PG8_STAGE(PG8_SB(0, 1), b2 + hstep, voffB); PG8_STAGE(PG8_SA(0, 0), a2, voffA);
            PG8_WAIT_V(8); PG8_WAIT_L(0); PG8_BAR; PG8_MMA(1, 0, At, B0); PG8_MMA(1, 1, At, B1); PG8_BAR; PG8_SCHED;
            PG8_LDB(B0, 1, 0); PG8_LDB(B1, 1, 1); PG8_SCHED; PG8_LDA(At, 1, 0); PG8_STAGE(PG8_SA(0, 1), a2 + hstep, voffA);
            PG8_WAIT_V(8); PG8_WAIT_L(0); PG8_BAR; PG8_MMA(0, 0, At, B0); PG8_MMA(0, 1, At, B1); PG8_BAR; PG8_SCHED;
            PG8_LDA(At, 1, 1); PG8_STAGE(PG8_SB(1, 0), b3, voffB); PG8_STAGE(PG8_SB(1, 1), b3 + hstep, voffB); PG8_STAGE(PG8_SA(1, 0), a3, voffA);
            PG8_WAIT_V(8); PG8_WAIT_L(0); PG8_BAR; PG8_MMA(1, 0, At, B0); PG8_MMA(1, 1, At, B1); PG8_BAR; PG8_SCHED;
            } else {
            PG8_LDB(B0, 0, 0); PG8_SCHED; PG8_LDA(At, 0, 0); PG8_STAGE(PG8_SA(1, 1), a1 + hstep, voffA);
            PG8_WAIT_L(8); PG8_BAR; PG8_WAIT_L(0); PG8_MMA(0, 0, At, B0); PG8_BAR; PG8_SCHED;
            PG8_LDB(B1, 0, 1); PG8_STAGE(PG8_SB(0, 0), b2, voffB);
            PG8_BAR; PG8_WAIT_L(0); PG8_MMA(0, 1, At, B1); PG8_BAR;
            PG8_LDA(At, 0, 1); PG8_STAGE(PG8_SA(0, 0), a2, voffA);
            PG8_BAR; PG8_WAIT_L(0); PG8_MMA(1, 0, At, B0); PG8_BAR; PG8_SCHED;
            PG8_STAGE(PG8_SB(0, 1), b2 + hstep, voffB);
            PG8_WAIT_V(6); PG8_BAR; PG8_MMA(1, 1, At, B1); PG8_BAR;
            PG8_LDB(B0, 1, 0); PG8_SCHED; PG8_LDA(At, 1, 0); PG8_STAGE(PG8_SA(0, 1), a2 + hstep, voffA);
            PG8_WAIT_L(8); PG8_BAR; PG8_WAIT_L(0); PG8_MMA(0, 0, At, B0); PG8_BAR; PG8_SCHED;
            PG8_LDB(B1, 1, 1); PG8_STAGE(PG8_SB(1, 0), b3, voffB);
            PG8_BAR; PG8_WAIT_L(0); PG8_MMA(0, 1, At, B1); PG8_BAR;
            PG8_LDA(At, 1, 1); PG8_STAGE(PG8_SA(1, 0), a3, voffA);
            PG8_BAR; PG8_WAIT_L(0); PG8_MMA(1, 0, At, B0); PG8_BAR; PG8_SCHED;
            PG8_STAGE(PG8_SB(1, 1), b3 + hstep, voffB);
            PG8_WAIT_V(6); PG8_BAR; PG8_MMA(1, 1, At, B1); PG8_BAR;
            }
        }
        if constexpr (ALIGN_EPI) { if (wr == 0) PG8_BAR; }
        if constexpr (!Epi::AFTER_DRAIN) { E(acc, cur, wr, wc, fr, fq); S.done(cur); }
        if (!has_next) break;
#pragma unroll
        for (int a = 0; a < 2; ++a)
#pragma unroll
            for (int b = 0; b < 2; ++b)
#pragma unroll
                for (int m = 0; m < 4; ++m)
#pragma unroll
                    for (int n = 0; n < 2; ++n) acc[a][b][m][n] = (f32x4){0.f, 0.f, 0.f, 0.f};
        cur = nxt; cA = nA; cB = nB; ++ui;
        if constexpr (ALIGN_EPI) { if (wr == 1) PG8_BAR; }
    }
    PG8_WAIT_V(0);
    if constexpr (!ALIGN_EPI) { if (wr == 0) PG8_BAR; }
    PG8_BAR;
    if constexpr (Epi::AFTER_DRAIN) { E.fused(acc, cur, wr, wc, fr, fq, lds, wid, lane); S.done(cur); }
#undef PG8_SA
#undef PG8_SB
#undef PG8_STAGE
#undef PG8_LDA
#undef PG8_LDB
#undef PG8_MMA
#undef PG8_WAIT_V
#undef PG8_WAIT_L
#undef PG8_BAR
#undef PG8_SCHED
}
}

namespace pg8 {
__device__ __forceinline__ float fast_sigmoid(float w) { return __builtin_amdgcn_rcpf(1.0f + __builtin_amdgcn_exp2f(-1.4426950408889634f * w)); }
__device__ __forceinline__ float gelu_tanh(float x) { return x * fast_sigmoid(1.5957691216057308f * (x + 0.044715f * x * x * x)); }

struct EpiF32 {
    static constexpr bool PERM = false, AFTER_DRAIN = false;
    float* C; int ldc;
    __device__ __forceinline__ void operator()(const f32x4 (&acc)[2][2][4][2], const Unit& u, int wr, int wc, int fr, int fq) const {
        const int row0 = u.pm * BM + wr * 64 + fr, col0 = u.pn * BM + wc * 32 + 4 * fq;
#pragma unroll
        for (int ai = 0; ai < 2; ++ai)
#pragma unroll
            for (int m = 0; m < 4; ++m) { float* rowp = C + (size_t)(row0 + ai * HALF + m * 16) * ldc + col0;
#pragma unroll
                for (int bj = 0; bj < 2; ++bj)
#pragma unroll
                    for (int n = 0; n < 2; ++n) *(f32x4*)(rowp + bj * HALF + n * 16) = acc[ai][bj][m][n]; }
    }
};

struct EpiIn {
    static constexpr bool PERM = true, AFTER_DRAIN = false;
    unsigned char* ws; float* out; int layer;
    __device__ __forceinline__ void operator()(const f32x4 (&acc)[2][2][4][2], const Unit& u, int wr, int wc, int fr, int fq) const {
        const int row0 = u.pm * BM + wr * 64 + fr;
        const int pn = u.pn;
#pragma unroll
        for (int ai = 0; ai < 2; ++ai)
#pragma unroll
            for (int m = 0; m < 4; ++m) {
                const int row = row0 + ai * HALF + m * 16;
                const float r = ((const float*)(ws + WS_RS))[row];
#pragma unroll
                for (int bj = 0; bj < 2; ++bj) {
                    f32x4 v0 = acc[ai][bj][m][0] * r, v1 = acc[ai][bj][m][1] * r;
                    const int col = pn * BM + bj * HALF + wc * 32 + 8 * fq;
                    bf16_t* dst;
                    if (pn < 4) dst = (bf16_t*)(ws + WS_Q) + (size_t)row * 1024 + col;
                    else if (pn < 8) dst = (bf16_t*)(ws + WS_K) + (size_t)row * 1024 + (col - 1024);
                    else if (pn < 12) dst = (bf16_t*)(ws + WS_V) + (size_t)row * 1024 + (col - 2048);
                    else if (pn < 14) dst = (bf16_t*)(ws + WS_U) + (size_t)row * 512 + (col - 3072);
                    else if (pn < 16) dst = (bf16_t*)(ws + WS_GU) + (size_t)row * 512 + (col - 3584);
                    else dst = (bf16_t*)(ws + WS_GV) + (size_t)row * 512 + (col - 4096);
                    if (pn >= 4 && pn < 12) {
                        const int c2 = (pn < 8) ? col - 1024 : col - 2048;
                        float* o = nullptr;
                        if (row < 8192) { const int b = row >> 12, t = row & 4095;
                            if (t >= 2048) o = out + ((pn < 8) ? O_NKP : O_NVP) + ((size_t)((layer * 2 + b) * 2048 + (t - 2048))) * 1024 + c2; }
                        else if (row < 8256) o = out + ((pn < 8) ? O_NKS : O_NVS) + ((size_t)(layer * 64 + (row - 8192))) * 1024 + c2;
                        if (o) { *(f32x4*)o = v0; *(f32x4*)(o + 4) = v1; }
                    }
                    if (pn >= 14) {
#pragma unroll
                        for (int j = 0; j < 4; ++j) { v0[j] = gelu_tanh(v0[j]); v1[j] = gelu_tanh(v1[j]); }
                    }
                    u32x4 w; w.x = cvt_pk_bf16(v0[0], v0[1]); w.y = cvt_pk_bf16(v0[2], v0[3]); w.z = cvt_pk_bf16(v1[0], v1[1]); w.w = cvt_pk_bf16(v1[2], v1[3]);
                    *(u32x4*)dst = w;
                }
            }
    }
};

struct EpiGU {
    static constexpr bool PERM = true, AFTER_DRAIN = false;
    unsigned char* ws;
    __device__ __forceinline__ void operator()(const f32x4 (&acc)[2][2][4][2], const Unit& u, int wr, int wc, int fr, int fq) const {
        const int row0 = u.pm * BM + wr * 64 + fr, j0 = u.pn * HALF + wc * 32 + 8 * fq;
#pragma unroll
        for (int ai = 0; ai < 2; ++ai)
#pragma unroll
            for (int m = 0; m < 4; ++m) {
                const int row = row0 + ai * HALF + m * 16;
                const float r = ((const float*)(ws + WS_RS))[row];
                float o[8];
#pragma unroll
                for (int n = 0; n < 2; ++n)
#pragma unroll
                    for (int j = 0; j < 4; ++j) { const float g = acc[ai][0][m][n][j] * r, up = acc[ai][1][m][n][j] * r; o[4 * n + j] = g * fast_sigmoid(g) * up; }
                u32x4 w; w.x = cvt_pk_bf16(o[0], o[1]); w.y = cvt_pk_bf16(o[2], o[3]); w.z = cvt_pk_bf16(o[4], o[5]); w.w = cvt_pk_bf16(o[6], o[7]);
                *(u32x4*)((bf16_t*)(ws + WS_H) + (size_t)row * 5632 + j0) = w;
            }
    }
};
}

#define GAS __attribute__((address_space(1)))
#define LAS __attribute__((address_space(3)))
typedef unsigned short bf16;
typedef unsigned v4u __attribute__((ext_vector_type(4)));
typedef unsigned v2u __attribute__((ext_vector_type(2)));
typedef float f32x4 __attribute__((ext_vector_type(4)));
typedef float f32x2v __attribute__((ext_vector_type(2)));
typedef short bf16x8 __attribute__((ext_vector_type(8)));
typedef GAS unsigned gu32;
#define RLX_AGENT __ATOMIC_RELAXED, __HIP_MEMORY_SCOPE_AGENT
#define LDS_WAIT() asm volatile("s_waitcnt lgkmcnt(0)" ::: "memory")
#define VM_WAIT() asm volatile("s_waitcnt vmcnt(0)" ::: "memory")
__device__ __forceinline__ unsigned f2bf(float f) { unsigned u = __builtin_bit_cast(unsigned, f); return (u + 0x7fffu + ((u >> 16) & 1u)) >> 16; }
__device__ __forceinline__ unsigned pk2(float lo, float hi) { return f2bf(lo) | (f2bf(hi) << 16); }
__device__ __forceinline__ float bf_lo(unsigned w) { return __builtin_bit_cast(float, w << 16); }
__device__ __forceinline__ float bf_hi(unsigned w) { return __builtin_bit_cast(float, w & 0xffff0000u); }
__device__ __forceinline__ float bf2f(bf16 b) { return __builtin_bit_cast(float, ((unsigned)b) << 16); }

#define XB_TMO      128
#define XB_XCNT(j)  (256  + 64 * (j))
#define XB_XSUB(j)  (1280 + 64 * (j))
#define XB_XGEN(j)  (2304 + 64 * (j))
#define XB_TOP      3328
#define XB_TOPGEN   3392
#define XCD_BAR_WORDS 3456
#define XB_SPIN_CAP (1u << 18)

__device__ __forceinline__ unsigned xb_ld(unsigned* p)              { return __hip_atomic_load(p, __ATOMIC_RELAXED, __HIP_MEMORY_SCOPE_AGENT); }
__device__ __forceinline__ unsigned xb_add(unsigned* p, unsigned v) { return __hip_atomic_fetch_add(p, v, __ATOMIC_RELAXED, __HIP_MEMORY_SCOPE_AGENT); }
__device__ __forceinline__ unsigned xb_xcc_id() { return (unsigned)__builtin_amdgcn_s_getreg((3 << 11) | 20) & 0xFu; }
#define XB_SPIN(cond, bar) do { unsigned _sp = 0; while (cond) { __builtin_amdgcn_s_sleep(1); \
    if ((++_sp & 255u) == 0u) { if (xb_ld(&(bar)[XB_TMO])) break; if (_sp > XB_SPIN_CAP) { atomicAdd(&(bar)[XB_TMO], 1u); break; } } } } while (0)

struct XcdBarrier {
    unsigned* bar; unsigned x;
    volatile LAS unsigned* st;
};

__device__ __forceinline__ XcdBarrier xcd_barrier_post(unsigned* bar, volatile LAS unsigned* st) {
    XcdBarrier b; b.bar = bar; b.x = xb_xcc_id(); b.st = st;
    if (threadIdx.x == 0) (void)xb_add(&bar[XB_XCNT(b.x)], 1u);
    return b;
}
__device__ __forceinline__ void xcd_barrier_complete(unsigned* bar, unsigned x, unsigned& nloc, unsigned& nx) {
    const unsigned G = gridDim.x * gridDim.y * gridDim.z;
    unsigned sum, cnt, mine, sp = 0u;
    for (;;) {
        sum = 0u; cnt = 0u; mine = 0u;
#pragma unroll
        for (unsigned j = 0; j < 16; ++j) { const unsigned c = xb_ld(&bar[XB_XCNT(j)]); sum += c; cnt += (c > 0u) ? 1u : 0u; mine = (j == x) ? c : mine; }
        if (sum == G) break;
        __builtin_amdgcn_s_sleep(1);
        if ((++sp & 255u) == 0u) { if (xb_ld(&bar[XB_TMO])) break; if (sp > XB_SPIN_CAP) { atomicAdd(&bar[XB_TMO], 1u); break; } }
    }
    nloc = mine > 0u ? mine : 1u; nx = cnt > 0u ? cnt : 1u;
}

__device__ __forceinline__ void xcd_barrier(const XcdBarrier& b) {
    asm volatile("s_waitcnt vmcnt(0)" ::: "memory");
    __syncthreads();
    if (threadIdx.x == 0) {
        unsigned* bar = b.bar;
        __builtin_amdgcn_s_waitcnt(0);
        unsigned nloc = b.st[0], nx = b.st[1];
        if (nloc == 0u) { xcd_barrier_complete(bar, b.x, nloc, nx); b.st[0] = nloc; b.st[1] = nx; }
        const unsigned old = xb_add(&bar[XB_XSUB(b.x)], 1u);
        const unsigned gen = old / nloc;
        if (old + 1u == (gen + 1u) * nloc) {
            __builtin_amdgcn_fence(__ATOMIC_RELEASE, "agent");
            asm volatile("s_waitcnt vmcnt(0)" ::: "memory");
            const unsigned og = xb_add(&bar[XB_TOP], 1u);
            const unsigned tg = og / nx;
            if (og + 1u == (tg + 1u) * nx) xb_add(&bar[XB_TOPGEN], 1u);
            else XB_SPIN(xb_ld(&bar[XB_TOPGEN]) == tg, bar);
            __builtin_amdgcn_fence(__ATOMIC_ACQUIRE, "agent");
            xb_add(&bar[XB_XGEN(b.x)], 1u);
            asm volatile("s_waitcnt vmcnt(0)" ::: "memory");
        } else {
            XB_SPIN(xb_ld(&bar[XB_XGEN(b.x)]) == gen, bar);
            __builtin_amdgcn_fence(__ATOMIC_ACQUIRE, "agent");
            asm volatile("s_waitcnt vmcnt(0)" ::: "memory");
        }
    }
    __syncthreads();
}


#ifndef PROBE_P0
#define PROBE_P0 1
#endif
#ifndef PROBE_P2
#define PROBE_P2 1
#endif
#ifndef PROBE_P3
#define PROBE_P3 1
#endif
#ifndef MK_FUSED_MIXERS
#define MK_FUSED_MIXERS 1
#endif
#ifndef FAST_ATTN
#define FAST_ATTN 0
#endif
#ifndef FAST_SSM
#define FAST_SSM 0
#endif
#ifndef FAST_SGU
#define FAST_SGU 0
#endif
struct Frame {
    LAS unsigned char* lds;
    volatile LAS unsigned* MISC;
    gu32* ctl;
    int tid, lane, wave;
    int vcu, G;
    const float* const* inp;
    float* out;
    unsigned char* ws;
};
#define F_IN(k) (F.inp[(k)])
#define F_WS(type, off) ((type*)(F.ws + (off)))
enum { I_XP = 0, I_XS, I_CK, I_CV, I_SRE, I_SIM, I_RELB, I_WIN, I_WOUT, I_GPREMIX, I_GPOSTMIX, I_GMIXOUT, I_LAMRE, I_LAMIM, I_LOGSTEP, I_BRE, I_BIM, I_CRE, I_CIM,
       I_SSMD, I_WGLU, I_BGLU, I_SGUG, I_SGUW, I_SGUB, I_GPREFFN, I_GPOSTFFN, I_WGATE, I_WUP, I_WDOWN };

__device__ __forceinline__ float wave_sum(float v) {
#pragma unroll
    for (int o = 1; o < 64; o <<= 1) v += __shfl_xor(v, o);
    return v;
}

__device__ __forceinline__ void p0_transpose_item(const float* W, int K, int N, bf16* WT, LAS float* scr, int item, int lane, const float* kscale, float cscale, int cs_limit, int mode) {
    const int nblk = N / 32, kb = item / nblk, nb = item % nblk, k0 = 64 * kb, n0 = 32 * nb;
    const float cs = (n0 < cs_limit) ? cscale : 1.0f;
#pragma unroll 8
    for (int i = 0; i < 32; ++i) { const int kk = 2 * i + (lane >> 5); float v = W[(size_t)(k0 + kk) * N + n0 + (lane & 31)]; if (kscale) v *= kscale[k0 + kk]; scr[kk * 33 + (lane & 31)] = v * cs; }
    LDS_WAIT(); asm volatile("" ::: "memory");
    const int c = lane & 7;
#pragma unroll
    for (int j = 0; j < 4; ++j) { const int n = (lane >> 3) + 8 * j; const LAS float* s = scr + (8 * c) * 33 + n;
        v4u o; o.x = pk2(s[0 * 33], s[1 * 33]); o.y = pk2(s[2 * 33], s[3 * 33]); o.z = pk2(s[4 * 33], s[5 * 33]); o.w = pk2(s[6 * 33], s[7 * 33]);
        const int col = n0 + n; const int row = (mode == 0) ? col : (256 * (col >> 7) + (col & 127) + (mode == 2 ? 128 : 0));
        *(GAS v4u*)(WT + (size_t)row * K + k0 + 8 * c) = o; }
    LDS_WAIT(); asm volatile("" ::: "memory");
}
__device__ __forceinline__ int t5_bucket(int dist) {
    if (dist < 16) return dist;
    int large = 16 + (int)(logf((float)dist / 16.0f) / logf(128.0f) * 16.0f);
    return large < 31 ? large : 31;
}
__device__ __forceinline__ void p0_prologue(Frame& F) {
    LAS float* scr = (LAS float*)(F.lds + RING_OFF + F.wave * 16384);
    const int gw = F.vcu * NWAVES + F.wave, NGW = F.G * NWAVES;
    constexpr int I_IN = (DM / 64) * (INC / 32), I_OUT = (DM / 64) * (DM / 32), I_G = (DM / 64) * (FF / 32), I_D = (FF / 64) * (DM / 32);
    constexpr int I_GLU = (SW / 64) * (SW / 32);
    constexpr int PER_L = I_IN + I_OUT + 2 * I_G + I_D + I_GLU;
    for (int it = gw; it < DEPTH * PER_L; it += NGW) {
        const int l = it / PER_L; int r = it % PER_L;
        if (r < I_IN) { p0_transpose_item(F_IN(I_WIN) + (size_t)l * DM * INC, DM, INC, F_WS(bf16, WS_WIN) + (size_t)l * INC * DM, scr, r, F.lane, F_IN(I_GPREMIX) + l * DM, QSCALE, AW, 0); continue; } r -= I_IN;
        if (r < I_OUT) { p0_transpose_item(F_IN(I_WOUT) + (size_t)l * DM * DM, DM, DM, F_WS(bf16, WS_WOUT) + (size_t)l * DM * DM, scr, r, F.lane, nullptr, 1.f, 0, 0); continue; } r -= I_OUT;
        if (r < I_G) { p0_transpose_item(F_IN(I_WGATE) + (size_t)l * DM * FF, DM, FF, F_WS(bf16, WS_WGU) + (size_t)l * FF2 * DM, scr, r, F.lane, F_IN(I_GPREFFN) + l * DM, 1.f, 0, 1); continue; } r -= I_G;
        if (r < I_G) { p0_transpose_item(F_IN(I_WUP) + (size_t)l * DM * FF, DM, FF, F_WS(bf16, WS_WGU) + (size_t)l * FF2 * DM, scr, r, F.lane, F_IN(I_GPREFFN) + l * DM, 1.f, 0, 2); continue; } r -= I_G;
        if (r < I_D) { p0_transpose_item(F_IN(I_WDOWN) + (size_t)l * FF * DM, FF, DM, F_WS(bf16, WS_WDN) + (size_t)l * DM * FF, scr, r, F.lane, nullptr, 1.f, 0, 0); continue; } r -= I_D;
        p0_transpose_item(F_IN(I_WGLU) + (size_t)l * SW * SW, SW, SW, F_WS(bf16, WS_WGLU) + (size_t)l * SW * SW, scr, r, F.lane, nullptr, 1.f, 0, 0);
    }
    for (int i = gw * 64 + F.lane; i < DEPTH * 32 * 64; i += NGW * 64) {
        const int p = i & 63, g = (i >> 6) & 31, l = i >> 11;
        const float lr = F_IN(I_LAMRE)[i], li = F_IN(I_LAMIM)[i], step = expf(F_IN(I_LOGSTEP)[l * 32 + g]);
        const float mag = expf(lr * step), are = mag * cosf(li * step), aim = mag * sinf(li * step);
        const float den = lr * lr + li * li, cre_ = ((are - 1.0f) * lr + aim * li) / den, cim_ = (aim * lr - (are - 1.0f) * li) / den;
        float pr = are, pim = aim; float* ap = F_WS(float, WS_AP) + (size_t)i * 8; ap[0] = are; ap[1] = aim;
        for (int k = 0; k < 5; ++k) { const float nr = pr * pr - pim * pim, ni = 2.0f * pr * pim; pr = nr; pim = ni; }
        ap[2] = pr; ap[3] = pim;
        for (int k = 0; k < 3; ++k) { const float nr = pr * pr - pim * pim, ni = 2.0f * pr * pim; pr = nr; pim = ni; }
        ap[4] = pr; ap[5] = pim; ap[6] = 0.f; ap[7] = 0.f;
        bf16* BB = F_WS(bf16, WS_BBF) + ((size_t)(l * 32 + g) * 8) * 512; bf16* CFp = F_WS(bf16, WS_CF) + ((size_t)(l * 32 + g) * 4) * 512;
        const int mt = p >> 4, rowi = p & 15;
        for (int c = 0; c < 16; ++c) { const float br = F_IN(I_BRE)[(size_t)i * 16 + c], bi = F_IN(I_BIM)[(size_t)i * 16 + c];
            const int ln = rowi + 16 * (c >> 3), j = c & 7;
            BB[(mt * 64 + ln) * 8 + j] = (bf16)f2bf(cre_ * br - cim_ * bi); BB[((4 + mt) * 64 + ln) * 8 + j] = (bf16)f2bf(cre_ * bi + cim_ * br);
            const int lc = c + 16 * ((p >> 3) & 3), jc = p & 7;
            CFp[((p >> 5) * 64 + lc) * 8 + jc] = (bf16)f2bf(F_IN(I_CRE)[(((size_t)l * 32 + g) * 16 + c) * 64 + p]);
            CFp[((2 + (p >> 5)) * 64 + lc) * 8 + jc] = (bf16)f2bf(-F_IN(I_CIM)[(((size_t)l * 32 + g) * 16 + c) * 64 + p]); }
        for (int g4 = 2; g4 < 4; ++g4) for (int j = 0; j < 8; ++j) { BB[(mt * 64 + rowi + 16 * g4) * 8 + j] = 0; BB[((4 + mt) * 64 + rowi + 16 * g4) * 8 + j] = 0; }
    }
    for (int i = gw * 64 + F.lane; i < DEPTH * 4 * 128 * 128; i += NGW * 64) { const int s = i & 127, t = (i >> 7) & 127; F_WS(bf16, WS_WM)[i] = (s <= t) ? (bf16)f2bf(F_IN(I_SGUW)[i]) : (bf16)0; }
    for (int m = gw; m < MTOT; m += NGW) {
        GAS v2u* xo = (GAS v2u*)(F_WS(bf16, WS_XN) + (size_t)m * DM) + F.lane;
        if (m < MREAL) {
            const float* src = (m < MP) ? F_IN(I_XP) + (size_t)m * DM : F_IN(I_XS) + (size_t)(m - MP) * DM;
            const GAS f32x4* xr = (const GAS f32x4*)src + F.lane; GAS f32x4* xw = (GAS f32x4*)(F.out + (size_t)m * DM) + F.lane;
            f32x4 v[8]; float s = 0.f;
#pragma unroll
            for (int j = 0; j < 8; ++j) { v[j] = xr[64 * j]; s += (v[j].x * v[j].x + v[j].y * v[j].y) + (v[j].z * v[j].z + v[j].w * v[j].w); }
            s = wave_sum(s);
#pragma unroll
            for (int j = 0; j < 8; ++j) { xw[64 * j] = v[j]; v2u w; w.x = pk2(v[j].x, v[j].y); w.y = pk2(v[j].z, v[j].w); xo[64 * j] = w; }
            if (F.lane == 0) F_WS(float, WS_RS)[m] = 1.0f / sqrtf(s * (1.0f / DM) + EPS);
        } else {
#pragma unroll
            for (int j = 0; j < 8; ++j) { v2u w; w.x = 0u; w.y = 0u; xo[64 * j] = w; }
            if (F.lane == 0) F_WS(float, WS_RS)[m] = 0.f;
        }
    }
    for (int i = gw * 64 + F.lane; i < 3 * 8 * 129; i += NGW * 64) {
        const int jj = i % 129, h = (i / 129) % 8, pi = i / (129 * 8); const int d = pi == 0 ? 1 : (pi == 1 ? 4 : 16);
        F_WS(float, WS_BIAS)[i] = F_IN(I_RELB)[t5_bucket(jj * d) * 8 + h] * LOG2E;
    }
}

__device__ __forceinline__ void norm_rows(Frame& F, const float* g) {
    const int gw = F.vcu * NWAVES + F.wave, NGW = F.G * NWAVES;
    for (int m = gw; m < MREAL; m += NGW) {
        const GAS f32x4* tr = (const GAS f32x4*)(F_WS(float, WS_T) + (size_t)m * DM) + F.lane; GAS f32x4* xw = (GAS f32x4*)(F.out + (size_t)m * DM) + F.lane;
        const GAS f32x4* gr = (const GAS f32x4*)g + F.lane; GAS v2u* xo = (GAS v2u*)(F_WS(bf16, WS_XN) + (size_t)m * DM) + F.lane;
        f32x4 tv[8]; float s = 0.f;
#pragma unroll
        for (int j = 0; j < 8; ++j) { tv[j] = tr[64 * j]; s += (tv[j].x * tv[j].x + tv[j].y * tv[j].y) + (tv[j].z * tv[j].z + tv[j].w * tv[j].w); }
        const float r = 1.0f / sqrtf(wave_sum(s) * (1.0f / DM) + EPS);
        float s2 = 0.f;
#pragma unroll
        for (int j = 0; j < 8; ++j) { const f32x4 xv = xw[64 * j], gv = gr[64 * j]; tv[j] = xv + tv[j] * r * gv; s2 += (tv[j].x * tv[j].x + tv[j].y * tv[j].y) + (tv[j].z * tv[j].z + tv[j].w * tv[j].w); }
        s2 = wave_sum(s2);
#pragma unroll
        for (int j = 0; j < 8; ++j) { xw[64 * j] = tv[j]; v2u w; w.x = pk2(tv[j].x, tv[j].y); w.y = pk2(tv[j].z, tv[j].w); xo[64 * j] = w; }
        if (F.lane == 0) F_WS(float, WS_RS)[m] = 1.0f / sqrtf(s2 * (1.0f / DM) + EPS);
    }
}


typedef short s16x4 __attribute__((ext_vector_type(4)));
typedef short v4i16_t __attribute__((ext_vector_type(4)));
typedef LAS const char* lds_cptr;
#define MFMA16(a, b, c) __builtin_amdgcn_mfma_f32_16x16x32_bf16((a), (b), (c), 0, 0, 0)
__device__ __forceinline__ unsigned off_b(unsigned row, unsigned ch) { return 256u * row + 16u * (ch ^ (((row & 3u) << 2) | ((row >> 2) & 3u))); }
__device__ __forceinline__ unsigned tr_addr16(unsigned lane, unsigned c, unsigned ks, unsigned t) {
    const unsigned g = lane >> 4, q = (lane & 15u) >> 2, p = lane & 3u;
    return off_b(32u * ks + 8u * g + 4u * t + q, 2u * c + (p >> 1)) + 8u * (p & 1u);
}
__device__ __forceinline__ s16x4 vtr(lds_cptr p) { return __builtin_bit_cast(s16x4, __builtin_amdgcn_ds_read_tr16_b64_v4i16((LAS v4i16_t*)p)); }
__device__ __forceinline__ unsigned cvtpk(float lo, float hi) { unsigned r; asm volatile("v_cvt_pk_bf16_f32 %0, %1, %2" : "=v"(r) : "v"(lo), "v"(hi)); return r; }

constexpr int LDS_X_OFF = 132096;
constexpr int ATT_UNITS = 1536;

__device__ __forceinline__ void attn_unit(LAS unsigned char* lds, unsigned char* ws, int unit, int tid) {
    const int lane = tid & 63, w = __builtin_amdgcn_readfirstlane(tid >> 6);
    const int pi = unit >> 9, r2 = unit & 511, n = r2 >> 8, h = (r2 >> 5) & 7, rb = r2 & 31;
    const int dsh = 2 * pi, d = 1 << dsh, nbs = 5 - dsh;
    const int r = rb >> nbs, b = rb & ((1 << nbs) - 1);
    const bf16* Kg = (const bf16*)(ws + WS_K); const bf16* Vg = (const bf16*)(ws + WS_V); const bf16* Qg = (const bf16*)(ws + WS_Q);
    LAS unsigned char* Kimg = lds; LAS unsigned char* Vimg = lds + 65536; LAS float* btab = (LAS float*)(lds + LDS_X_OFF);
    {
        const int ch = tid & 15, jr = tid >> 4;
        v4u kv[8], vv[8];
#pragma unroll
        for (int p = 0; p < 8; ++p) { const int j = p * 32 + jr; const int tk = r + d * (128 * (b - 1) + j);
            if (tk >= 0) { const size_t off = ((size_t)(n * SEQ + tk)) * AW + h * 128 + ch * 8; kv[p] = *(const v4u*)(Kg + off); vv[p] = *(const v4u*)(Vg + off); }
            else { kv[p] = (v4u){0u, 0u, 0u, 0u}; vv[p] = (v4u){0u, 0u, 0u, 0u}; } }
#pragma unroll
        for (int p = 0; p < 8; ++p) { const int j = p * 32 + jr; const unsigned o = off_b(j, ch); *(LAS v4u*)(Kimg + o) = kv[p]; *(LAS v4u*)(Vimg + o) = vv[p]; }
        if (tid < 129) btab[tid] = ((const float*)(ws + WS_BIAS))[(pi * 8 + h) * 129 + tid];
    }
    __syncthreads();
    const int q = lane & 15, g4 = lane >> 4, qi = 16 * w + q;
    const int rowq = n * SEQ + r + d * (128 * b + qi);
    bf16x8 qf[4];
#pragma unroll
    for (int s = 0; s < 4; ++s) qf[s] = *(const bf16x8*)(Qg + (size_t)rowq * AW + h * 128 + 32 * s + 8 * g4);
    const int ks0 = w >> 1;
    f32x4 sacc[5][2];
    {
        const int rr = lane & 15;
#pragma unroll
        for (int kb = 0; kb < 5; ++kb)
#pragma unroll
            for (int t = 0; t < 2; ++t) {
                const int j = 32 * (ks0 + kb) + 8 * (rr >> 2) + 4 * t + (rr & 3);
                f32x4 acc = (f32x4){0.f, 0.f, 0.f, 0.f};
#pragma unroll
                for (int s = 0; s < 4; ++s) { const bf16x8 kf = *(const LAS bf16x8*)(Kimg + off_b(j, 4 * s + g4)); acc = MFMA16(kf, qf[s], acc); }
                sacc[kb][t] = acc;
            }
    }
    float mx = -3.0e38f;
#pragma unroll
    for (int kb = 0; kb < 5; ++kb)
#pragma unroll
        for (int t = 0; t < 2; ++t)
#pragma unroll
            for (int i = 0; i < 4; ++i) {
                const int j = 32 * (ks0 + kb) + 8 * g4 + 4 * t + i; const int delta = 128 + qi - j;
                const bool valid = (delta >= 0) && (delta <= 128) && (b > 0 || j >= 128);
                const int dc = delta < 0 ? 0 : (delta > 128 ? 128 : delta);
                const float sv = valid ? sacc[kb][t][i] + btab[dc] : -1.0e30f;
                sacc[kb][t][i] = sv; mx = fmaxf(mx, sv);
            }
    mx = fmaxf(mx, __shfl_xor(mx, 16)); mx = fmaxf(mx, __shfl_xor(mx, 32));
    float ls = 0.f;
    bf16x8 pf[5];
#pragma unroll
    for (int kb = 0; kb < 5; ++kb) {
        float p[8];
#pragma unroll
        for (int t = 0; t < 2; ++t)
#pragma unroll
            for (int i = 0; i < 4; ++i) { p[4 * t + i] = __builtin_amdgcn_exp2f(sacc[kb][t][i] - mx); ls += p[4 * t + i]; }
        v4u pk; pk.x = cvtpk(p[0], p[1]); pk.y = cvtpk(p[2], p[3]); pk.z = cvtpk(p[4], p[5]); pk.w = cvtpk(p[6], p[7]);
        pf[kb] = __builtin_bit_cast(bf16x8, pk);
    }
    ls += __shfl_xor(ls, 16); ls += __shfl_xor(ls, 32);
    const float inv = 1.0f / ls;
    bf16* Og = (bf16*)(ws + WS_OBUF) + ((size_t)pi * MP + rowq) * AW + h * 128;
#pragma unroll
    for (int c = 0; c < 8; ++c) {
        f32x4 oacc = (f32x4){0.f, 0.f, 0.f, 0.f};
#pragma unroll
        for (int kb = 0; kb < 5; ++kb) {
            const s16x4 lo = vtr((lds_cptr)(Vimg + tr_addr16(lane, c, ks0 + kb, 0))), hi = vtr((lds_cptr)(Vimg + tr_addr16(lane, c, ks0 + kb, 1)));
            const bf16x8 vf = __builtin_shufflevector(lo, hi, 0, 1, 2, 3, 4, 5, 6, 7);
            oacc = MFMA16(vf, pf[kb], oacc);
        }
        v2u ow; ow.x = cvtpk(oacc[0] * inv, oacc[1] * inv); ow.y = cvtpk(oacc[2] * inv, oacc[3] * inv);
        *(v2u*)(Og + 16 * c + 4 * g4) = ow;
    }
    if (g4 == 0) ((float*)(ws + WS_LSE))[((size_t)pi * MP + rowq) * 8 + h] = mx + __builtin_amdgcn_logf(ls);
    __syncthreads();
}

__device__ __forceinline__ void attn_sample_task(unsigned char* ws, const float* const* inp, float* out, int l, int task, int lane) {
    const int rs_ = task >> 3, h = task & 7, n = rs_ >> 3, t = rs_ & 7, row = MP + rs_;
    const unsigned qw = ((const unsigned*)((const bf16*)(ws + WS_Q) + (size_t)row * AW + h * 128))[lane];
    const float q0 = bf_lo(qw), q1 = bf_hi(qw);
    float m = -3.0e38f, ls = 0.f, o0 = 0.f, o1 = 0.f;
#pragma nounroll
    for (int pi = 0; pi < 3; ++pi) {
        const int d = 1 << (2 * pi);
        const float* bt = (const float*)(ws + WS_BIAS) + (pi * 8 + h) * 129;
#pragma nounroll
        for (int jj = 0; jj <= 128; ++jj) {
            const int idx = 2048 + t - jj * d; const float *kp, *vp;
            if (idx < 2048) { const size_t off = ((((size_t)l * 8 + n) * 2048 + idx) * 8 + h) * 128; kp = inp[I_CK] + off; vp = inp[I_CV] + off; }
            else { const size_t off = (((size_t)l * 8 + n) * 8 + (idx - 2048)) * 1024 + h * 128; kp = out + O_NKS + off; vp = out + O_NVS + off; }
            const f32x2v kk = ((const f32x2v*)kp)[lane], vv = ((const f32x2v*)vp)[lane];
            const float s = wave_sum(q0 * kk.x + q1 * kk.y) + bt[jj];
            const float mn = fmaxf(m, s), al = exp2f(m - mn), p = exp2f(s - mn);
            ls = ls * al + p; o0 = o0 * al + p * vv.x; o1 = o1 * al + p * vv.y; m = mn;
        }
    }
    const float inv = 1.0f / ls; f32x2v ov; ov.x = o0 * inv; ov.y = o1 * inv;
    ((f32x2v*)((float*)(ws + WS_SATT) + (size_t)rs_ * AW + h * 128))[lane] = ov;
}

__device__ __forceinline__ void attn_combine_row(unsigned char* ws, const float* const* inp, int l, int row, int lane) {
    float o[16];
    if (row < MP) {
        const int h = lane >> 3; const float* L = (const float*)(ws + WS_LSE);
        const float l0 = L[((size_t)0 * MP + row) * 8 + h], l1 = L[((size_t)1 * MP + row) * 8 + h], l2 = L[((size_t)2 * MP + row) * 8 + h];
        const float mm = fmaxf(l0, fmaxf(l1, l2)); float w0 = exp2f(l0 - mm), w1 = exp2f(l1 - mm), w2 = exp2f(l2 - mm);
        const float is = 1.0f / (w0 + w1 + w2); w0 *= is; w1 *= is; w2 *= is;
        const bf16* O = (const bf16*)(ws + WS_OBUF);
#pragma unroll
        for (int half = 0; half < 2; ++half) {
            const v4u a = *(const v4u*)(O + ((size_t)0 * MP + row) * AW + 16 * lane + 8 * half), b = *(const v4u*)(O + ((size_t)1 * MP + row) * AW + 16 * lane + 8 * half),
                      c = *(const v4u*)(O + ((size_t)2 * MP + row) * AW + 16 * lane + 8 * half);
            o[8 * half + 0] = w0 * bf_lo(a.x) + w1 * bf_lo(b.x) + w2 * bf_lo(c.x); o[8 * half + 1] = w0 * bf_hi(a.x) + w1 * bf_hi(b.x) + w2 * bf_hi(c.x);
            o[8 * half + 2] = w0 * bf_lo(a.y) + w1 * bf_lo(b.y) + w2 * bf_lo(c.y); o[8 * half + 3] = w0 * bf_hi(a.y) + w1 * bf_hi(b.y) + w2 * bf_hi(c.y);
            o[8 * half + 4] = w0 * bf_lo(a.z) + w1 * bf_lo(b.z) + w2 * bf_lo(c.z); o[8 * half + 5] = w0 * bf_hi(a.z) + w1 * bf_hi(b.z) + w2 * bf_hi(c.z);
            o[8 * half + 6] = w0 * bf_lo(a.w) + w1 * bf_lo(b.w) + w2 * bf_lo(c.w); o[8 * half + 7] = w0 * bf_hi(a.w) + w1 * bf_hi(b.w) + w2 * bf_hi(c.w);
        }
    } else {
        const f32x4* S = (const f32x4*)((const float*)(ws + WS_SATT) + (size_t)(row - MP) * AW + 16 * lane);
#pragma unroll
        for (int k = 0; k < 4; ++k) { const f32x4 v = S[k]; o[4 * k] = v.x; o[4 * k + 1] = v.y; o[4 * k + 2] = v.z; o[4 * k + 3] = v.w; }
    }
    float ss = 0.f;
#pragma unroll
    for (int k = 0; k < 16; ++k) ss += o[k] * o[k];
    const float r = 1.0f / sqrtf(wave_sum(ss) * (1.0f / AW) + EPS);
    const f32x4* g = (const f32x4*)(inp[I_GMIXOUT] + l * DM + 16 * lane);
    v4u w0, w1; const f32x4 g0 = g[0], g1 = g[1], g2 = g[2], g3 = g[3];
    w0.x = pk2(o[0] * r * g0.x, o[1] * r * g0.y); w0.y = pk2(o[2] * r * g0.z, o[3] * r * g0.w); w0.z = pk2(o[4] * r * g1.x, o[5] * r * g1.y); w0.w = pk2(o[6] * r * g1.z, o[7] * r * g1.w);
    w1.x = pk2(o[8] * r * g2.x, o[9] * r * g2.y); w1.y = pk2(o[10] * r * g2.z, o[11] * r * g2.w); w1.z = pk2(o[12] * r * g3.x, o[13] * r * g3.y); w1.w = pk2(o[14] * r * g3.z, o[15] * r * g3.w);
    v4u* dst = (v4u*)((bf16*)(ws + WS_MIX) + (size_t)row * DM + 16 * lane); dst[0] = w0; dst[1] = w1;
}

constexpr int XW_STRIDE = 528, XW_BYTES = 16 * XW_STRIDE;
__device__ __forceinline__ void ssm_pass1_unit(LAS unsigned char* xw, unsigned char* ws, int l, int wu, int lane) {
    const int g = wu & 31, sc = (wu >> 5) & 15, n = wu >> 9, q = lane & 15, g4 = lane >> 4;
    const bf16* BB = (const bf16*)(ws + WS_BBF) + ((size_t)(l * 32 + g) * 8) * 512;
    bf16x8 bb[8];
#pragma unroll
    for (int mt = 0; mt < 8; ++mt) bb[mt] = *(const bf16x8*)(BB + (mt * 64 + lane) * 8);
    const float* ap = (const float*)(ws + WS_AP) + ((size_t)(l * 32 + g) * 64 + lane) * 8;
    const float are = ap[0], aim = ap[1];
    float hr = 0.f, hi_ = 0.f;
    const bf16* U = (const bf16*)(ws + WS_U); float* SL = (float*)(ws + WS_SLOC);
    const bf16* up = U + (size_t)(n * SEQ + sc * 256 + q) * SW + g * 16 + 8 * (g4 & 1);
    bf16x8 ufn = *(const bf16x8*)up;
#pragma nounroll
    for (int tt = 0; tt < 16; ++tt) {
        bf16x8 uf = ufn; if (g4 >= 2) uf = (bf16x8){0, 0, 0, 0, 0, 0, 0, 0};
        if (tt < 15) ufn = *(const bf16x8*)(up + (size_t)(tt + 1) * 16 * SW);
#pragma unroll
        for (int mt = 0; mt < 8; ++mt) { const f32x4 dd = MFMA16(bb[mt], uf, ((f32x4){0.f, 0.f, 0.f, 0.f})); *(LAS f32x4*)(xw + q * XW_STRIDE + (16 * mt + 4 * g4) * 4) = dd; }
        asm volatile("s_waitcnt lgkmcnt(0)" ::: "memory");
#pragma unroll
        for (int t = 0; t < 16; ++t) { const float xr = *(const LAS float*)(xw + t * XW_STRIDE + lane * 4), xi = *(const LAS float*)(xw + t * XW_STRIDE + 256 + lane * 4);
            const float nr = are * hr - aim * hi_ + xr, ni = are * hi_ + aim * hr + xi; hr = nr; hi_ = ni; }
        asm volatile("s_waitcnt lgkmcnt(0)" ::: "memory");
        if (tt & 1) { f32x2v e; e.x = hr; e.y = hi_; ((f32x2v*)SL)[((((size_t)n * 16 + sc) * 8 + (tt >> 1)) * 32 + g) * 64 + lane] = e; }
    }
}
constexpr int YB_OFF = 8 * XW_BYTES, YB_STRIDE = 1040, RED_OFF = YB_OFF + 32 * YB_STRIDE;
constexpr int SSM2_UNITS = 264;
__device__ __forceinline__ void ssm_pass2_unit(LAS unsigned char* lds, unsigned char* ws, const float* const* inp, float* out, int l, int unit, int tid) {
    const int lane = tid & 63, w = __builtin_amdgcn_readfirstlane(tid >> 6), q = lane & 15, g4 = lane >> 4;
    const bool samp = unit >= 256;
    const int n = samp ? unit - 256 : unit >> 7, c32 = unit & 127;
    const int row0 = samp ? MP + n * 8 : n * SEQ + c32 * 32, ntile = samp ? 1 : 2;
    LAS unsigned char* xw = lds + w * XW_BYTES; LAS unsigned char* ybuf = lds + YB_OFF; LAS float* red = (LAS float*)(lds + RED_OFF);
    const bf16* U = (const bf16*)(ws + WS_U); const f32x2v* SL = (const f32x2v*)(ws + WS_SLOC);
#pragma nounroll
    for (int gi = 0; gi < 4; ++gi) {
        const int g = 4 * w + gi;
        const bf16* BB = (const bf16*)(ws + WS_BBF) + ((size_t)(l * 32 + g) * 8) * 512; const bf16* CFp = (const bf16*)(ws + WS_CF) + ((size_t)(l * 32 + g) * 4) * 512;
        const float* ap = (const float*)(ws + WS_AP) + ((size_t)(l * 32 + g) * 64 + lane) * 8;
        const float are = ap[0], aim = ap[1];
        float hr = 0.f, hi_ = 0.f;
        if (!samp) {
            const int sc = c32 >> 3, c2 = c32 & 7; const float a32r = ap[2], a32i = ap[3], a256r = ap[4], a256i = ap[5];
            f32x2v es[15];
#pragma unroll
            for (int s2 = 0; s2 < 15; ++s2) { es[s2] = (f32x2v){0.f, 0.f}; if (s2 < sc) es[s2] = SL[((((size_t)n * 16 + s2) * 8 + 7) * 32 + g) * 64 + lane]; }
#pragma unroll
            for (int s2 = 0; s2 < 15; ++s2) { if (s2 < sc) { const float nr = a256r * hr - a256i * hi_ + es[s2].x, ni = a256r * hi_ + a256i * hr + es[s2].y; hr = nr; hi_ = ni; } }
#pragma nounroll
            for (int k = 0; k < c2; ++k) { const float nr = a32r * hr - a32i * hi_, ni = a32r * hi_ + a32i * hr; hr = nr; hi_ = ni; }
            if (c2 > 0) { const f32x2v e = SL[((((size_t)n * 16 + sc) * 8 + (c2 - 1)) * 32 + g) * 64 + lane]; hr += e.x; hi_ += e.y; }
        } else { hr = inp[I_SRE][(((size_t)l * 8 + n) * 32 + g) * 64 + lane]; hi_ = inp[I_SIM][(((size_t)l * 8 + n) * 32 + g) * 64 + lane]; }
        const f32x4 dsk = *(const f32x4*)(inp[I_SSMD] + l * SW + 16 * g + 4 * g4);
#pragma nounroll
        for (int tt = 0; tt < ntile; ++tt) {
            const int rowt = row0 + tt * 16;
            bf16x8 uf = (bf16x8){0, 0, 0, 0, 0, 0, 0, 0};
            if (g4 < 2) uf = *(const bf16x8*)(U + (size_t)(rowt + q) * SW + g * 16 + 8 * g4);
#pragma unroll
            for (int mt = 0; mt < 8; ++mt) { const bf16x8 bbf = *(const bf16x8*)(BB + (mt * 64 + lane) * 8);
                const f32x4 dd = MFMA16(bbf, uf, ((f32x4){0.f, 0.f, 0.f, 0.f})); *(LAS f32x4*)(xw + q * XW_STRIDE + (16 * mt + 4 * g4) * 4) = dd; }
            asm volatile("s_waitcnt lgkmcnt(0)" ::: "memory");
#pragma unroll
            for (int t = 0; t < 16; ++t) { const float xr = *(const LAS float*)(xw + t * XW_STRIDE + lane * 4), xi = *(const LAS float*)(xw + t * XW_STRIDE + 256 + lane * 4);
                const float nr = are * hr - aim * hi_ + xr, ni = are * hi_ + aim * hr + xi; hr = nr; hi_ = ni;
                asm volatile("" ::: "memory");
                *(LAS bf16*)(xw + t * XW_STRIDE + lane * 2) = (bf16)f2bf(hr); *(LAS bf16*)(xw + t * XW_STRIDE + 128 + lane * 2) = (bf16)f2bf(hi_);
                if (samp && t == 7) { out[O_SRS + (((size_t)l * 8 + n) * 32 + g) * 64 + lane] = hr; out[O_SIS + (((size_t)l * 8 + n) * 32 + g) * 64 + lane] = hi_; } }
            asm volatile("s_waitcnt lgkmcnt(0)" ::: "memory");
            f32x4 yacc = (f32x4){0.f, 0.f, 0.f, 0.f};
#pragma unroll
            for (int ks = 0; ks < 4; ++ks) { const bf16x8 cf = *(const bf16x8*)(CFp + (ks * 64 + lane) * 8); const bf16x8 hf = *(const LAS bf16x8*)(xw + q * XW_STRIDE + (32 * ks + 8 * g4) * 2); yacc = MFMA16(cf, hf, yacc); }
            const v2u uw = *(const v2u*)(U + (size_t)(rowt + q) * SW + 16 * g + 4 * g4);
            const float y0 = yacc[0] + dsk.x * bf_lo(uw.x), y1 = yacc[1] + dsk.y * bf_hi(uw.x), y2 = yacc[2] + dsk.z * bf_lo(uw.y), y3 = yacc[3] + dsk.w * bf_hi(uw.y);
            v2u yw; yw.x = cvtpk(y0, y1); yw.y = cvtpk(y2, y3);
            *(LAS v2u*)(ybuf + (tt * 16 + q) * YB_STRIDE + (16 * g + 4 * g4) * 2) = yw;
            asm volatile("s_waitcnt lgkmcnt(0)" ::: "memory");
        }
        if (!samp && c32 == 127) { out[O_SRP + (((size_t)l * 2 + n) * 32 + g) * 64 + lane] = hr; out[O_SIP + (((size_t)l * 2 + n) * 32 + g) * 64 + lane] = hi_; }
    }
    __syncthreads();
    f32x4 acc[2][4];
#pragma unroll
    for (int mt = 0; mt < 2; ++mt)
#pragma unroll
        for (int nt = 0; nt < 4; ++nt) acc[mt][nt] = (f32x4){0.f, 0.f, 0.f, 0.f};
    const bf16* Wg = (const bf16*)(ws + WS_WGLU) + (size_t)l * 512 * 512;
#pragma unroll 2
    for (int ks = 0; ks < 16; ++ks) {
        bf16x8 af[2];
#pragma unroll
        for (int mt = 0; mt < 2; ++mt) af[mt] = *(const LAS bf16x8*)(ybuf + (16 * mt + q) * YB_STRIDE + (32 * ks + 8 * g4) * 2);
#pragma unroll
        for (int nt = 0; nt < 4; ++nt) { const bf16x8 bfr = *(const bf16x8*)(Wg + (size_t)(64 * w + 16 * nt + q) * 512 + 32 * ks + 8 * g4);
#pragma unroll
            for (int mt = 0; mt < 2; ++mt) acc[mt][nt] = MFMA16(bfr, af[mt], acc[mt][nt]); }
    }
#pragma unroll
    for (int mt = 0; mt < 2; ++mt) { const int t = 16 * mt + q; float ss = 0.f;
#pragma unroll
        for (int nt = 0; nt < 4; ++nt) { const int n0 = 64 * w + 16 * nt + 4 * g4; const f32x4 bg = *(const f32x4*)(inp[I_BGLU] + l * SW + n0);
            const v2u yw = *(const LAS v2u*)(ybuf + t * YB_STRIDE + n0 * 2);
            f32x4 o; o.x = bf_lo(yw.x) * pg8::fast_sigmoid(acc[mt][nt].x + bg.x); o.y = bf_hi(yw.x) * pg8::fast_sigmoid(acc[mt][nt].y + bg.y);
            o.z = bf_lo(yw.y) * pg8::fast_sigmoid(acc[mt][nt].z + bg.z); o.w = bf_hi(yw.y) * pg8::fast_sigmoid(acc[mt][nt].w + bg.w);
            acc[mt][nt] = o; ss += (o.x * o.x + o.y * o.y) + (o.z * o.z + o.w * o.w); }
        ss += __shfl_xor(ss, 16); ss += __shfl_xor(ss, 32);
        if (g4 == 0) red[t * 8 + w] = ss; }
    __syncthreads();
#pragma unroll
    for (int mt = 0; mt < 2; ++mt) { const int t = 16 * mt + q; const LAS f32x4* rp = (const LAS f32x4*)(red + t * 8); const f32x4 r0 = rp[0], r1 = rp[1];
        const float r = 1.0f / sqrtf(((r0.x + r0.y) + (r0.z + r0.w) + (r1.x + r1.y) + (r1.z + r1.w)) * (1.0f / SW) + EPS);
        const bool valid = !samp || t < 8;
        if (valid) {
#pragma unroll
            for (int nt = 0; nt < 4; ++nt) { const int n0 = 64 * w + 16 * nt + 4 * g4; const f32x4 gg = *(const f32x4*)(inp[I_GMIXOUT] + l * DM + 1024 + n0);
                v2u ow; ow.x = cvtpk(acc[mt][nt].x * r * gg.x, acc[mt][nt].y * r * gg.y); ow.y = cvtpk(acc[mt][nt].z * r * gg.z, acc[mt][nt].w * r * gg.w);
                *(v2u*)((bf16*)(ws + WS_MIX) + (size_t)(row0 + t) * DM + 1024 + n0) = ow; } } }
    __syncthreads();
}

constexpr int SGU_UNITS = 72, SGU_RED_OFF = LDS_X_OFF + 1024;
__device__ __forceinline__ void sgu_unit(LAS unsigned char* lds, unsigned char* ws, const float* const* inp, float* out, int l, int unit, int tid) {
    const int lane = tid & 63, w = __builtin_amdgcn_readfirstlane(tid >> 6), q = lane & 15, g4 = lane >> 4;
    const bool samp = unit >= 64;
    const int row0 = samp ? MP + 8 * (unit - 64) : (unit >> 5) * SEQ + (unit & 31) * 128, nrows = samp ? 8 : 128;
    LAS float* red = (LAS float*)(lds + SGU_RED_OFF);
    {
        const bf16* GVg = (const bf16*)(ws + WS_GV); const f32x4* sgp = (const f32x4*)(inp[I_SGUG] + l * GW + 8 * lane); const f32x4 sg0 = sgp[0], sg1 = sgp[1];
#pragma unroll 4
        for (int k = 0; k < 16; ++k) { const int s = w + 8 * k; v4u pk = (v4u){0u, 0u, 0u, 0u};
            if (s < nrows) { const v4u raw = *(const v4u*)(GVg + (size_t)(row0 + s) * GW + 8 * lane);
                float x[8] = {bf_lo(raw.x), bf_hi(raw.x), bf_lo(raw.y), bf_hi(raw.y), bf_lo(raw.z), bf_hi(raw.z), bf_lo(raw.w), bf_hi(raw.w)};
                float sm = 0.f;
#pragma unroll
                for (int j = 0; j < 8; ++j) sm += x[j];
                const float mean = wave_sum(sm) * (1.0f / GW); float qq = 0.f;
#pragma unroll
                for (int j = 0; j < 8; ++j) { x[j] -= mean; qq += x[j] * x[j]; }
                const float rstd = 1.0f / sqrtf(wave_sum(qq) * (1.0f / GW) + EPS);
                x[0] *= rstd * sg0.x; x[1] *= rstd * sg0.y; x[2] *= rstd * sg0.z; x[3] *= rstd * sg0.w; x[4] *= rstd * sg1.x; x[5] *= rstd * sg1.y; x[6] *= rstd * sg1.z; x[7] *= rstd * sg1.w;
                if (samp) { f32x4* od = (f32x4*)(out + O_SGV + ((size_t)l * 64 + (row0 + s - MP)) * GW + 8 * lane); od[0] = (f32x4){x[0], x[1], x[2], x[3]}; od[1] = (f32x4){x[4], x[5], x[6], x[7]}; }
                pk.x = pk2(x[0], x[1]); pk.y = pk2(x[2], x[3]); pk.z = pk2(x[4], x[5]); pk.w = pk2(x[6], x[7]); }
            *(LAS v4u*)(lds + (lane >> 4) * 32768 + off_b(s, lane & 15)) = pk; }
    }
    __syncthreads();
    const int hh = w >> 1, th = w & 1;
    LAS unsigned char* img = lds + hh * 32768;
    const bf16* Wm = (const bf16*)(ws + WS_WM) + ((size_t)(l * 4 + hh) * 128) * 128;
    const bf16* GUg = (const bf16*)(ws + WS_GU);
#pragma nounroll
    for (int mp = 0; mp < 2; ++mp) {
        f32x4 acc[2][8];
#pragma unroll
        for (int m2 = 0; m2 < 2; ++m2)
#pragma unroll
            for (int c = 0; c < 8; ++c) acc[m2][c] = (f32x4){0.f, 0.f, 0.f, 0.f};
#pragma nounroll
        for (int ks = 0; ks <= 2 * th + mp; ++ks) {
            bf16x8 gf[8];
#pragma unroll
            for (int c = 0; c < 8; ++c) { const s16x4 lo = vtr((lds_cptr)(img + tr_addr16(lane, c, ks, 0))), hi = vtr((lds_cptr)(img + tr_addr16(lane, c, ks, 1))); gf[c] = __builtin_shufflevector(lo, hi, 0, 1, 2, 3, 4, 5, 6, 7); }
#pragma unroll
            for (int m2 = 0; m2 < 2; ++m2) { const bf16x8 wf = *(const bf16x8*)(Wm + (size_t)(64 * th + 32 * mp + 16 * m2 + q) * 128 + 32 * ks + 8 * g4);
#pragma unroll
                for (int c = 0; c < 8; ++c) acc[m2][c] = MFMA16(gf[c], wf, acc[m2][c]); }
        }
#pragma unroll
        for (int m2 = 0; m2 < 2; ++m2) { const int tl = 64 * th + 32 * mp + 16 * m2 + q; const bool valid = tl < nrows; const float bias = inp[I_SGUB][((size_t)l * 4 + hh) * 128 + tl]; float ss = 0.f;
#pragma unroll
            for (int c = 0; c < 8; ++c) { v2u gw2 = (v2u){0u, 0u}; if (valid) gw2 = *(const v2u*)(GUg + (size_t)(row0 + tl) * GW + hh * 128 + 16 * c + 4 * g4);
                v2u ow; ow.x = cvtpk(bf_lo(gw2.x) * (acc[m2][c].x + bias), bf_hi(gw2.x) * (acc[m2][c].y + bias)); ow.y = cvtpk(bf_lo(gw2.y) * (acc[m2][c].z + bias), bf_hi(gw2.y) * (acc[m2][c].w + bias));
                const float o0 = bf_lo(ow.x), o1 = bf_hi(ow.x), o2 = bf_lo(ow.y), o3 = bf_hi(ow.y); ss += (o0 * o0 + o1 * o1) + (o2 * o2 + o3 * o3);
                if (valid) *(v2u*)((bf16*)(ws + WS_MIX) + (size_t)(row0 + tl) * DM + 1536 + hh * 128 + 16 * c + 4 * g4) = ow; }
            ss += __shfl_xor(ss, 16); ss += __shfl_xor(ss, 32);
            if (g4 == 0) red[tl * 4 + hh] = ss; }
    }
    __syncthreads();
#pragma nounroll
    for (int mt = 0; mt < 4; ++mt) { const int tl = 64 * th + 16 * mt + q; const f32x4 rr = *(const LAS f32x4*)(red + tl * 4);
        const float r = 1.0f / sqrtf(((rr.x + rr.y) + (rr.z + rr.w)) * (1.0f / GW) + EPS);
        if (tl < nrows) {
#pragma unroll
            for (int c = 0; c < 8; ++c) { const int ch = hh * 128 + 16 * c + 4 * g4; const f32x4 gg = *(const f32x4*)(inp[I_GMIXOUT] + l * DM + 1536 + ch);
                v2u* mp_ = (v2u*)((bf16*)(ws + WS_MIX) + (size_t)(row0 + tl) * DM + 1536 + ch); const v2u ow = *mp_;
                v2u nw; nw.x = cvtpk(bf_lo(ow.x) * r * gg.x, bf_hi(ow.x) * r * gg.y); nw.y = cvtpk(bf_lo(ow.y) * r * gg.z, bf_hi(ow.y) * r * gg.w); *mp_ = nw; } } }
    __syncthreads();
}

template <int K>
__device__ __forceinline__ void sample_gemm_n2048(LAS unsigned char* lds, const bf16* A  , const bf16* Wt  , float* T, int c, int tid) {
    const int lane = tid & 63, w = __builtin_amdgcn_readfirstlane(tid >> 6), q = lane & 15, g4 = lane >> 4;
    constexpr int KW = K / 8, NKS = KW / 32;
    const bf16* wp = Wt + (size_t)(8 * c + (q & 7)) * K + w * KW + 8 * g4;
    const bf16* ap = A + (size_t)q * K + w * KW + 8 * g4;
    f32x4 acc[4];
#pragma unroll
    for (int mt = 0; mt < 4; ++mt) acc[mt] = (f32x4){0.f, 0.f, 0.f, 0.f};
#pragma unroll 2
    for (int ks = 0; ks < NKS; ++ks) {
        const bf16x8 wf = *(const bf16x8*)(wp + 32 * ks);
#pragma unroll
        for (int mt = 0; mt < 4; ++mt) { const bf16x8 af = *(const bf16x8*)(ap + (size_t)(16 * mt) * K + 32 * ks); acc[mt] = MFMA16(wf, af, acc[mt]); }
    }
    LAS f32x4* part = (LAS f32x4*)lds;
#pragma unroll
    for (int mt = 0; mt < 4; ++mt) part[(w * 4 + mt) * 64 + lane] = acc[mt];
    __syncthreads();
    if (w < 4 && g4 < 2) { f32x4 s = part[(0 * 4 + w) * 64 + lane];
#pragma unroll
        for (int ww = 1; ww < 8; ++ww) s += part[(ww * 4 + w) * 64 + lane];
        *(f32x4*)(T + (size_t)(MP + 16 * w + q) * DM + 8 * c + 4 * g4) = s; }
    __syncthreads();
}

constexpr int SATT_LDS_PER_WAVE = 4096;
__device__ __forceinline__ const float* samp_row_ptr(const float* cache, const float* fresh, int l, int n, int t, int h, int kk) {
    const int pi = kk >= 258 ? 2 : (kk >= 129 ? 1 : 0), jj = kk - 129 * pi, idx = 2048 + t - (jj << (2 * pi));
    return (idx < 2048) ? cache + ((((size_t)l * 8 + n) * 2048 + idx) * 8 + h) * 128 : fresh + (((size_t)l * 8 + n) * 8 + (idx - 2048)) * 1024 + h * 128;
}
__device__ __forceinline__ void attn_sample_task2(LAS unsigned char* ldsw, unsigned char* ws, const float* const* inp, float* out, int l, int task, int lane) {
    const int rs_ = task >> 3, h = task & 7, n = rs_ >> 3, t = rs_ & 7, row = MP + rs_;
    const int kg = lane >> 4, e0 = 8 * (lane & 15);
    LAS float* sc = (LAS float*)ldsw;
    float qv[8];
    { const v4u qw = *(const v4u*)((const bf16*)(ws + WS_Q) + (size_t)row * AW + h * 128 + e0);
      qv[0] = bf_lo(qw.x); qv[1] = bf_hi(qw.x); qv[2] = bf_lo(qw.y); qv[3] = bf_hi(qw.y); qv[4] = bf_lo(qw.z); qv[5] = bf_hi(qw.z); qv[6] = bf_lo(qw.w); qv[7] = bf_hi(qw.w); }
    const float* ck = inp[I_CK]; const float* cv = inp[I_CV]; const float* fk = out + O_NKS; const float* fv = out + O_NVS;
    const float* bt = (const float*)(ws + WS_BIAS);
#pragma unroll 4
    for (int it = 0; it < 97; ++it) {
        const int kk = 4 * it + kg, kc = kk < 387 ? kk : 386;
        const f32x4* kp = (const f32x4*)(samp_row_ptr(ck, fk, l, n, t, h, kc) + e0);
        const f32x4 k0 = kp[0], k1 = kp[1];
        float dsum = (qv[0] * k0.x + qv[1] * k0.y) + (qv[2] * k0.z + qv[3] * k0.w) + (qv[4] * k1.x + qv[5] * k1.y) + (qv[6] * k1.z + qv[7] * k1.w);
        dsum += __shfl_xor(dsum, 1); dsum += __shfl_xor(dsum, 2); dsum += __shfl_xor(dsum, 4); dsum += __shfl_xor(dsum, 8);
        const int pi = kc >= 258 ? 2 : (kc >= 129 ? 1 : 0), jj = kc - 129 * pi;
        if ((lane & 15) == 0 && kk < 387) sc[kk] = dsum + bt[(pi * 8 + h) * 129 + jj];
    }
    asm volatile("s_waitcnt lgkmcnt(0)" ::: "memory");
    float sv[7]; float m = -3.0e38f;
#pragma unroll
    for (int c = 0; c < 7; ++c) { const int kk = lane + 64 * c; sv[c] = kk < 387 ? sc[kk] : -3.0e38f; m = fmaxf(m, sv[c]); }
#pragma unroll
    for (int o = 1; o < 64; o <<= 1) m = fmaxf(m, __shfl_xor(m, o));
    float ls = 0.f;
#pragma unroll
    for (int c = 0; c < 7; ++c) { const int kk = lane + 64 * c; const float p = kk < 387 ? __builtin_amdgcn_exp2f(sv[c] - m) : 0.f; ls += p; if (kk < 387) sc[kk] = p; }
    ls = wave_sum(ls);
    asm volatile("s_waitcnt lgkmcnt(0)" ::: "memory");
    float o[8];
#pragma unroll
    for (int j = 0; j < 8; ++j) o[j] = 0.f;
#pragma unroll 4
    for (int it = 0; it < 97; ++it) {
        const int kk = 4 * it + kg, kc = kk < 387 ? kk : 386;
        const f32x4* vp = (const f32x4*)(samp_row_ptr(cv, fv, l, n, t, h, kc) + e0);
        const f32x4 v0 = vp[0], v1 = vp[1]; const float p = kk < 387 ? sc[kc] : 0.f;
        o[0] += p * v0.x; o[1] += p * v0.y; o[2] += p * v0.z; o[3] += p * v0.w; o[4] += p * v1.x; o[5] += p * v1.y; o[6] += p * v1.z; o[7] += p * v1.w;
    }
    const float inv = 1.0f / ls;
#pragma unroll
    for (int j = 0; j < 8; ++j) { o[j] += __shfl_xor(o[j], 16); o[j] += __shfl_xor(o[j], 32); o[j] *= inv; }
    if (lane < 16) { f32x4* od = (f32x4*)((float*)(ws + WS_SATT) + (size_t)rs_ * AW + h * 128 + e0); od[0] = (f32x4){o[0], o[1], o[2], o[3]}; od[1] = (f32x4){o[4], o[5], o[6], o[7]}; }
}

__device__ __forceinline__ void attn_sample_wg(LAS unsigned char* lds, unsigned char* ws, const float* const* inp, float* out, int l, int task, int tid) {
    const int lane = tid & 63, w = __builtin_amdgcn_readfirstlane(tid >> 6);
    const int rs_ = task >> 3, h = task & 7, n = rs_ >> 3, t = rs_ & 7, row = MP + rs_;
    const int e0 = 8 * (lane & 15), grp = w * 4 + (lane >> 4);
    float qv[8];
    { const v4u qw = *(const v4u*)((const bf16*)(ws + WS_Q) + (size_t)row * AW + h * 128 + e0);
      qv[0] = bf_lo(qw.x); qv[1] = bf_hi(qw.x); qv[2] = bf_lo(qw.y); qv[3] = bf_hi(qw.y); qv[4] = bf_lo(qw.z); qv[5] = bf_hi(qw.z); qv[6] = bf_lo(qw.w); qv[7] = bf_hi(qw.w); }
    const float* ck = inp[I_CK]; const float* cv = inp[I_CV]; const float* fk = out + O_NKS; const float* fv = out + O_NVS;
    const float* bt = (const float*)(ws + WS_BIAS);
    float m = -3.0e38f, ls = 0.f, o[8];
#pragma unroll
    for (int j = 0; j < 8; ++j) o[j] = 0.f;
#pragma unroll 4
    for (int it = 0; it < 13; ++it) {
        const int kk = grp + 32 * it; const bool valid = kk < 387; const int kc = valid ? kk : 386;
        const f32x4* kp = (const f32x4*)(samp_row_ptr(ck, fk, l, n, t, h, kc) + e0); const f32x4* vp = (const f32x4*)(samp_row_ptr(cv, fv, l, n, t, h, kc) + e0);
        const f32x4 k0 = kp[0], k1 = kp[1], v0 = vp[0], v1 = vp[1];
        float dsum = (qv[0] * k0.x + qv[1] * k0.y) + (qv[2] * k0.z + qv[3] * k0.w) + (qv[4] * k1.x + qv[5] * k1.y) + (qv[6] * k1.z + qv[7] * k1.w);
        dsum += __shfl_xor(dsum, 1); dsum += __shfl_xor(dsum, 2); dsum += __shfl_xor(dsum, 4); dsum += __shfl_xor(dsum, 8);
        const int pi = kc >= 258 ? 2 : (kc >= 129 ? 1 : 0), jj = kc - 129 * pi;
        const float s = valid ? dsum + bt[(pi * 8 + h) * 129 + jj] : -3.0e38f;
        const float mn = fmaxf(m, s), al = __builtin_amdgcn_exp2f(m - mn), p = valid ? __builtin_amdgcn_exp2f(s - mn) : 0.f;
        ls = ls * al + p; m = mn;
        o[0] = o[0] * al + p * v0.x; o[1] = o[1] * al + p * v0.y; o[2] = o[2] * al + p * v0.z; o[3] = o[3] * al + p * v0.w;
        o[4] = o[4] * al + p * v1.x; o[5] = o[5] * al + p * v1.y; o[6] = o[6] * al + p * v1.z; o[7] = o[7] * al + p * v1.w;
    }
    LAS float* pml = (LAS float*)lds;
    LAS float* po = (LAS float*)(lds + 256);
    if ((lane & 15) == 0) { pml[2 * grp] = m; pml[2 * grp + 1] = ls; }
    { LAS f32x4* pd = (LAS f32x4*)(po + grp * 128 + e0); pd[0] = (f32x4){o[0], o[1], o[2], o[3]}; pd[1] = (f32x4){o[4], o[5], o[6], o[7]}; }
    __syncthreads();
    if (tid < 128) {
        float M = -3.0e38f;
#pragma unroll
        for (int i = 0; i < 32; ++i) M = fmaxf(M, pml[2 * i]);
        float L = 0.f, O = 0.f;
#pragma unroll
        for (int i = 0; i < 32; ++i) { const float sc = __builtin_amdgcn_exp2f(pml[2 * i] - M); L += pml[2 * i + 1] * sc; O += po[i * 128 + tid] * sc; }
        ((float*)(ws + WS_SATT))[(size_t)rs_ * AW + h * 128 + tid] = O / L;
    }
    __syncthreads();
}

__device__ __forceinline__ void attn_row_naive(Frame& F, int l, int row) {
    const int lane = F.lane; const bool samp = row >= MP;
    const int n = samp ? ((row - MP) >> 3) : (row >> 12), t = samp ? ((row - MP) & 7) : (row & 4095);
    float ssq = 0.f; float* tmp = F_WS(float, WS_T) + (size_t)row * DM;
#pragma nounroll
    for (int h = 0; h < 8; ++h) {
        const unsigned qw = ((const unsigned*)(F_WS(bf16, WS_Q) + (size_t)row * AW + h * 128))[lane];
        const float q0 = bf_lo(qw), q1 = bf_hi(qw);
        float m = -3.0e38f, ls = 0.f, o0 = 0.f, o1 = 0.f;
#pragma nounroll
        for (int pi = 0; pi < 3; ++pi) {
            const int d = pi == 0 ? 1 : (pi == 1 ? 4 : 16);
            const float* bt = F_WS(float, WS_BIAS) + (pi * 8 + h) * 129;
#pragma nounroll
            for (int jj = 0; jj <= 128; ++jj) {
                float k0, k1, v0, v1;
                if (!samp) { const int tk = t - jj * d; if (tk < 0) break;
                    const size_t off = ((size_t)(n * SEQ + tk)) * AW + h * 128;
                    const unsigned kw = ((const unsigned*)(F_WS(bf16, WS_K) + off))[lane], vw = ((const unsigned*)(F_WS(bf16, WS_V) + off))[lane];
                    k0 = bf_lo(kw); k1 = bf_hi(kw); v0 = bf_lo(vw); v1 = bf_hi(vw);
                } else { const int idx = 2048 + t - jj * d; const float *kp, *vp;
                    if (idx < 2048) { const size_t off = ((((size_t)l * 8 + n) * 2048 + idx) * 8 + h) * 128; kp = F_IN(I_CK) + off; vp = F_IN(I_CV) + off; }
                    else { const size_t off = (((size_t)l * 8 + n) * 8 + (idx - 2048)) * 1024 + h * 128; kp = F.out + O_NKS + off; vp = F.out + O_NVS + off; }
                    const f32x2v kk = ((const f32x2v*)kp)[lane], vv = ((const f32x2v*)vp)[lane]; k0 = kk.x; k1 = kk.y; v0 = vv.x; v1 = vv.y; }
                const float s = wave_sum(q0 * k0 + q1 * k1) + bt[jj];
                const float mn = fmaxf(m, s), al = exp2f(m - mn), p = exp2f(s - mn);
                ls = ls * al + p; o0 = o0 * al + p * v0; o1 = o1 * al + p * v1; m = mn;
            }
        }
        const float inv = 1.0f / ls; o0 *= inv; o1 *= inv; ssq += o0 * o0 + o1 * o1;
        f32x2v ov; ov.x = o0; ov.y = o1; ((f32x2v*)(tmp + h * 128))[lane] = ov;
    }
    const float r = 1.0f / sqrtf(wave_sum(ssq) * (1.0f / AW) + EPS);
    const float* g = F_IN(I_GMIXOUT) + l * DM;
#pragma nounroll
    for (int h = 0; h < 8; ++h) { const int col = h * 128 + 2 * lane; const f32x2v ov = ((const f32x2v*)(tmp + h * 128))[lane];
        ((unsigned*)(F_WS(bf16, WS_MIX) + (size_t)row * DM + col))[0] = pk2(ov.x * r * g[col], ov.y * r * g[col + 1]); }
}

__device__ __forceinline__ void ssm_seq_naive(Frame& F, int l, int seq, int g) {
    const int p = F.lane; const bool samp = seq >= 2; const int n = samp ? seq - 2 : seq;
    const int L = samp ? 8 : SEQ, row0 = samp ? MP + n * 8 : n * SEQ;
    const size_t gp = ((size_t)l * 32 + g) * 64 + p;
    const float lr = F_IN(I_LAMRE)[gp], li = F_IN(I_LAMIM)[gp], step = expf(F_IN(I_LOGSTEP)[l * 32 + g]);
    const float mag = expf(lr * step), are = mag * cosf(li * step), aim = mag * sinf(li * step);
    const float den = lr * lr + li * li, cre_ = ((are - 1.0f) * lr + aim * li) / den, cim_ = (aim * lr - (are - 1.0f) * li) / den;
    float bbr[16], bbi[16], ccr[16], cci[16];
#pragma unroll
    for (int c = 0; c < 16; ++c) { const float br = F_IN(I_BRE)[gp * 16 + c], bi = F_IN(I_BIM)[gp * 16 + c];
        bbr[c] = cre_ * br - cim_ * bi; bbi[c] = cre_ * bi + cim_ * br;
        ccr[c] = F_IN(I_CRE)[(((size_t)l * 32 + g) * 16 + c) * 64 + p]; cci[c] = F_IN(I_CIM)[(((size_t)l * 32 + g) * 16 + c) * 64 + p]; }
    float hr = 0.f, hi = 0.f;
    if (samp) { hr = F_IN(I_SRE)[(((size_t)l * 8 + n) * 32 + g) * 64 + p]; hi = F_IN(I_SIM)[(((size_t)l * 8 + n) * 32 + g) * 64 + p]; }
    const float dsk = (p < 16) ? F_IN(I_SSMD)[l * SW + g * 16 + p] : 0.f;
#pragma nounroll
    for (int t = 0; t < L; ++t) {
        const int row = row0 + t;
        const v4u ua = *(const v4u*)(F_WS(bf16, WS_U) + (size_t)row * SW + g * 16), ub = *(const v4u*)(F_WS(bf16, WS_U) + (size_t)row * SW + g * 16 + 8);
        float u[16];
        u[0] = bf_lo(ua.x); u[1] = bf_hi(ua.x); u[2] = bf_lo(ua.y); u[3] = bf_hi(ua.y); u[4] = bf_lo(ua.z); u[5] = bf_hi(ua.z); u[6] = bf_lo(ua.w); u[7] = bf_hi(ua.w);
        u[8] = bf_lo(ub.x); u[9] = bf_hi(ub.x); u[10] = bf_lo(ub.y); u[11] = bf_hi(ub.y); u[12] = bf_lo(ub.z); u[13] = bf_hi(ub.z); u[14] = bf_lo(ub.w); u[15] = bf_hi(ub.w);
        float xr = 0.f, xi = 0.f;
#pragma unroll
        for (int c = 0; c < 16; ++c) { xr += bbr[c] * u[c]; xi += bbi[c] * u[c]; }
        const float nhr = are * hr - aim * hi + xr, nhi = are * hi + aim * hr + xi; hr = nhr; hi = nhi;
        float ymine = 0.f;
#pragma unroll
        for (int c = 0; c < 16; ++c) { const float yc = wave_sum(ccr[c] * hr - cci[c] * hi) + 0.f; if (p == c) ymine = yc + dsk * u[c]; }
        if (p < 16) F_WS(float, WS_Y)[(size_t)row * SW + g * 16 + p] = ymine;
    }
    if (!samp) { F.out[O_SRP + (((size_t)l * 2 + n) * 32 + g) * 64 + p] = hr; F.out[O_SIP + (((size_t)l * 2 + n) * 32 + g) * 64 + p] = hi; }
    else { F.out[O_SRS + (((size_t)l * 8 + n) * 32 + g) * 64 + p] = hr; F.out[O_SIS + (((size_t)l * 8 + n) * 32 + g) * 64 + p] = hi; }
}

__device__ __forceinline__ void glu_row_naive(Frame& F, int l, int row) {
    const int lane = F.lane; const float* yrow = F_WS(float, WS_Y) + (size_t)row * SW; const float* W = F_IN(I_WGLU) + (size_t)l * SW * SW;
    float acc[8];
#pragma unroll
    for (int i = 0; i < 8; ++i) acc[i] = F_IN(I_BGLU)[l * SW + lane + 64 * i];
#pragma nounroll
    for (int k = 0; k < SW; ++k) { const float yk = yrow[k];
#pragma unroll
        for (int i = 0; i < 8; ++i) acc[i] += yk * W[(size_t)k * SW + lane + 64 * i]; }
    float o[8]; float ss = 0.f;
#pragma unroll
    for (int i = 0; i < 8; ++i) { o[i] = yrow[lane + 64 * i] * (1.0f / (1.0f + expf(-acc[i]))); ss += o[i] * o[i]; }
    const float r = 1.0f / sqrtf(wave_sum(ss) * (1.0f / SW) + EPS);
    const float* g = F_IN(I_GMIXOUT) + l * DM + 1024;
#pragma unroll
    for (int i = 0; i < 8; ++i) F_WS(bf16, WS_MIX)[(size_t)row * DM + 1024 + lane + 64 * i] = (bf16)f2bf(o[i] * r * g[lane + 64 * i]);
}

__device__ __forceinline__ void sgu_row_naive(Frame& F, int l, int row) {
    const int lane = F.lane; const bool samp = row >= MP;
    const int t = samp ? ((row - MP) & 7) : (row & 4095), tl = samp ? t : (t & 127), rowc = row - tl;
    float acc[8];
#pragma unroll
    for (int i = 0; i < 8; ++i) acc[i] = 0.f;
    const float* sg = F_IN(I_SGUG) + l * GW;
#pragma nounroll
    for (int sl = 0; sl <= tl; ++sl) {
        const int srow = rowc + sl; float xv[8]; float s = 0.f;
#pragma unroll
        for (int i = 0; i < 8; ++i) { xv[i] = bf2f(F_WS(bf16, WS_GV)[(size_t)srow * GW + lane + 64 * i]); s += xv[i]; }
        const float mean = wave_sum(s) * (1.0f / GW); float q = 0.f;
#pragma unroll
        for (int i = 0; i < 8; ++i) { xv[i] -= mean; q += xv[i] * xv[i]; }
        const float rstd = 1.0f / sqrtf(wave_sum(q) * (1.0f / GW) + EPS);
#pragma unroll
        for (int i = 0; i < 8; ++i) { const float gvv = xv[i] * rstd * sg[lane + 64 * i];
            const float w = F_IN(I_SGUW)[(((size_t)l * 4 + (i >> 1)) * 128 + tl) * 128 + sl];
            acc[i] += w * gvv;
            if (samp && sl == tl) F.out[O_SGV + ((size_t)l * 64 + (row - MP)) * GW + lane + 64 * i] = gvv; }
    }
    float o[8]; float ss = 0.f;
#pragma unroll
    for (int i = 0; i < 8; ++i) { const float mixed = acc[i] + F_IN(I_SGUB)[((size_t)l * 4 + (i >> 1)) * 128 + tl];
        o[i] = bf2f(F_WS(bf16, WS_GU)[(size_t)row * GW + lane + 64 * i]) * mixed; ss += o[i] * o[i]; }
    const float r = 1.0f / sqrtf(wave_sum(ss) * (1.0f / GW) + EPS);
    const float* g = F_IN(I_GMIXOUT) + l * DM + 1536;
#pragma unroll
    for (int i = 0; i < 8; ++i) F_WS(bf16, WS_MIX)[(size_t)row * DM + 1536 + lane + 64 * i] = (bf16)f2bf(o[i] * r * g[lane + 64 * i]);
}

struct ArgsN { const float* in[30]; float* out; unsigned char* ws; int l, pad; };
__global__ void __launch_bounds__(512) k_p2_naive(ArgsN a) {
    const int l = a.l, lane = threadIdx.x & 63, gw = blockIdx.x * 8 + (threadIdx.x >> 6), NGW = gridDim.x * 8; const float* const* inp = a.in; float* out = a.out; unsigned char* ws = a.ws;
    Frame F; F.lds = nullptr; F.MISC = nullptr; F.ctl = nullptr; F.tid = 0; F.lane = lane; F.wave = 0; F.vcu = 0; F.G = 0; F.inp = inp; F.out = out; F.ws = ws;
#if !FAST_SSM
    for (int k = gw; k < 320 * 6; k += NGW) if (k % 6 == 0) { const int task = k / 6; ssm_seq_naive(F, l, task / 32, task % 32); }
#endif
#if !FAST_ATTN
    for (int row = gw; row < MREAL; row += NGW) attn_row_naive(F, l, row);
#endif
#if !FAST_SGU
    for (int row = gw; row < MREAL; row += NGW) sgu_row_naive(F, l, row);
#endif
}
__global__ void __launch_bounds__(512, 2) k_p2_fast(ArgsN a) {
    extern __shared__ __attribute__((aligned(16))) unsigned char ldsf[];
    const int tid = threadIdx.x, lane = tid & 63, gw = blockIdx.x * 8 + (tid >> 6), NGW = gridDim.x * 8; (void)lane; (void)gw; (void)NGW;
#if FAST_ATTN
    for (int u = blockIdx.x; u < ATT_UNITS; u += gridDim.x) attn_unit((LAS unsigned char*)ldsf, a.ws, u, tid);
    for (int task = gw; task < 512; task += NGW) attn_sample_task(a.ws, a.in, a.out, a.l, task, lane);
#endif
#if FAST_SGU
    __syncthreads();
    for (int u = blockIdx.x; u < SGU_UNITS; u += gridDim.x) sgu_unit((LAS unsigned char*)ldsf, a.ws, a.in, a.out, a.l, u, tid);
#endif
#if FAST_SSM
    __syncthreads();
    for (int wu = gw; wu < 1024; wu += NGW) ssm_pass1_unit((LAS unsigned char*)ldsf + (tid >> 6) * XW_BYTES, a.ws, a.l, wu, lane);
#endif
}
__global__ void __launch_bounds__(512, 2) k_p3_fast(ArgsN a) {
    extern __shared__ __attribute__((aligned(16))) unsigned char ldsf[];
    const int tid = threadIdx.x, lane = tid & 63, gw = blockIdx.x * 8 + (tid >> 6), NGW = gridDim.x * 8; (void)lane; (void)gw; (void)NGW;
#if FAST_ATTN
    for (int row = gw; row < MREAL; row += NGW) attn_combine_row(a.ws, a.in, a.l, row, lane);
#endif
#if FAST_SSM
    __syncthreads();
    for (int u = blockIdx.x; u < SSM2_UNITS; u += gridDim.x) ssm_pass2_unit((LAS unsigned char*)ldsf, a.ws, a.in, a.out, a.l, u, tid);
#endif
}
__global__ void __launch_bounds__(512) k_p3_naive(ArgsN a) {
    const int l = a.l, lane = threadIdx.x & 63, gw = blockIdx.x * 8 + (threadIdx.x >> 6), NGW = gridDim.x * 8; const float* const* inp = a.in; float* out = a.out; unsigned char* ws = a.ws;
    Frame F; F.lds = nullptr; F.MISC = nullptr; F.ctl = nullptr; F.tid = 0; F.lane = lane; F.wave = 0; F.vcu = 0; F.G = 0; F.inp = inp; F.out = out; F.ws = ws;
#if !FAST_SSM
    for (int row = gw; row < MREAL; row += NGW) glu_row_naive(F, l, row);
#endif
}

struct Args { const float* in[30]; float* out; unsigned char* ws; int ph_lo, ph_hi, li, pad; };
__global__ void __launch_bounds__(NWAVES * 64, 2) fwd(Args args) {
    extern __shared__ __attribute__((aligned(16))) unsigned char lds[];
    Frame F;
    F.lds = (LAS unsigned char*)lds;
    F.MISC = (volatile LAS unsigned*)(F.lds + MISC_OFF);
    F.tid = threadIdx.x; F.lane = F.tid & 63; F.wave = __builtin_amdgcn_readfirstlane(F.tid >> 6);
    F.G = gridDim.x; { const int bx = blockIdx.x; F.vcu = (F.G % 8 == 0) ? (bx % 8) * (F.G / 8) + bx / 8 : bx; }
    unsigned char* ws = args.ws;
    F.ctl = (gu32*)(ws + WS_CTL);
    F.inp = args.in; F.out = args.out; F.ws = ws;
    for (int u = F.tid; u < (LDS_BYTES - LDSCTL_OFF) / 4; u += NWAVES * 64) ((LAS unsigned*)(F.lds + LDSCTL_OFF))[u] = 0u;
    __syncthreads();
    XcdBarrier bar; bar.bar = (unsigned*)(F.ctl + CW_BAR); bar.x = 0; bar.st = nullptr;
    if (!MK_PER_PHASE) bar = xcd_barrier_post((unsigned*)(F.ctl + CW_BAR), F.MISC + 8);
#define GRID_BAR() do { if (!MK_PER_PHASE) xcd_barrier(bar); } while (0)
    const int lo = args.ph_lo, hi = args.ph_hi;
#define IN(k) (lo <= (k) && (k) < hi)
#define BOTH(k) (IN(k) && IN((k) + 1))
    const int gw = F.vcu * NWAVES + F.wave, NGW = F.G * NWAVES;

    if (IN(0)) { p0_prologue(F); if (BOTH(0)) GRID_BAR(); }

    for (int l = 0; l < DEPTH; ++l) {
        const int pb = 1 + 8 * l;
        if (IN(pb + 0)) {
            pg8::Gemm g{F_WS(bf16, WS_XN), F_WS(bf16, WS_WIN) + (size_t)l * INC * DM, MTOT, INC, DM}; pg8::StaticOrder S; S.init(MTOT, INC, F.G, (int)blockIdx.x);
            pg8::EpiIn E{F.ws, F.out, l};
            pg8::gemm_phase<pg8::EpiIn, pg8::StaticOrder, true, true>(F.lds + RING_OFF, g, S, E);
            if (BOTH(pb + 0)) GRID_BAR();
        }
        if (IN(pb + 1)) {
#if MK_FUSED_MIXERS
            { int tl_ = threadIdx.x; asm volatile("" : "+v"(tl_));
              const int ln_ = tl_ & 63;
              for (int u = (int)blockIdx.x; u < ATT_UNITS; u += F.G) attn_unit(F.lds, F.ws, u, tl_);
              for (int u = (int)blockIdx.x; u < 512; u += F.G) attn_sample_wg(F.lds, F.ws, F.inp, F.out, l, u, tl_);
              for (int u = (int)blockIdx.x; u < SGU_UNITS; u += F.G) sgu_unit(F.lds, F.ws, F.inp, F.out, l, u, tl_);
              for (int wu = ((int)blockIdx.x - SGU_UNITS) * NWAVES + (tl_ >> 6); wu >= 0 && wu < 1024; wu += (F.G - SGU_UNITS) * NWAVES) ssm_pass1_unit(F.lds + (tl_ >> 6) * XW_BYTES, F.ws, l, wu, ln_); }
#endif
            if (BOTH(pb + 1)) GRID_BAR();
        }
        if (IN(pb + 2)) {
#if MK_FUSED_MIXERS
            { int tl_ = threadIdx.x; asm volatile("" : "+v"(tl_));
              const int ln_ = tl_ & 63;
              for (int row = gw; row < MREAL; row += NGW) attn_combine_row(F.ws, F.inp, l, row, ln_);
              __syncthreads();
              for (int u = (int)blockIdx.x; u < SSM2_UNITS; u += F.G) ssm_pass2_unit(F.lds, F.ws, F.inp, F.out, l, u, tl_); }
#endif
            if (BOTH(pb + 2)) GRID_BAR();
        }
        if (IN(pb + 3)) {
            { int tl_ = threadIdx.x; asm volatile("" : "+v"(tl_));
              for (int c = (int)blockIdx.x; c < 256; c += F.G) sample_gemm_n2048<DM>(F.lds, F_WS(bf16, WS_MIX) + (size_t)MP * DM, F_WS(bf16, WS_WOUT) + (size_t)l * DM * DM, F_WS(float, WS_T), c, tl_); }
            pg8::Gemm g{F_WS(bf16, WS_MIX), F_WS(bf16, WS_WOUT) + (size_t)l * DM * DM, MP, DM, DM}; pg8::StaticOrder S; S.init(MP, DM, F.G, (int)blockIdx.x);
            pg8::EpiF32 E{F_WS(float, WS_T), DM};
            pg8::gemm_phase<pg8::EpiF32, pg8::StaticOrder, true, true>(F.lds + RING_OFF, g, S, E);
            if (BOTH(pb + 3)) GRID_BAR();
        }
        if (IN(pb + 4)) { { Frame Fn = F; int ln_ = threadIdx.x & 63; asm volatile("" : "+v"(ln_)); Fn.lane = ln_; norm_rows(Fn, F_IN(I_GPOSTMIX) + l * DM); } if (BOTH(pb + 4)) GRID_BAR(); }
        if (IN(pb + 5)) {
            pg8::Gemm g{F_WS(bf16, WS_XN), F_WS(bf16, WS_WGU) + (size_t)l * FF2 * DM, MTOT, FF2, DM}; pg8::StaticOrder S; S.init(MTOT, FF2, F.G, (int)blockIdx.x);
            pg8::EpiGU E{F.ws};
            pg8::gemm_phase<pg8::EpiGU, pg8::StaticOrder, true, true>(F.lds + RING_OFF, g, S, E);
            if (BOTH(pb + 5)) GRID_BAR();
        }
        if (IN(pb + 6)) {
            { int tl_ = threadIdx.x; asm volatile("" : "+v"(tl_));
              for (int c = (int)blockIdx.x; c < 256; c += F.G) sample_gemm_n2048<FF>(F.lds, F_WS(bf16, WS_H) + (size_t)MP * FF, F_WS(bf16, WS_WDN) + (size_t)l * DM * FF, F_WS(float, WS_T), c, tl_); }
            pg8::Gemm g{F_WS(bf16, WS_H), F_WS(bf16, WS_WDN) + (size_t)l * DM * FF, MP, DM, FF}; pg8::StaticOrder S; S.init(MP, DM, F.G, (int)blockIdx.x);
            pg8::EpiF32 E{F_WS(float, WS_T), DM};
            pg8::gemm_phase<pg8::EpiF32, pg8::StaticOrder, true, true>(F.lds + RING_OFF, g, S, E);
            if (BOTH(pb + 6)) GRID_BAR();
        }
        if (IN(pb + 7)) { { Frame Fn = F; int ln_ = threadIdx.x & 63; asm volatile("" : "+v"(ln_)); Fn.lane = ln_; norm_rows(Fn, F_IN(I_GPOSTFFN) + l * DM); } if (BOTH(pb + 7)) GRID_BAR(); }
    }
#undef IN
#undef BOTH
}

extern "C" void kernel_launch(void* const* d_in, const int* in_sizes, int n_in, void* d_out, int out_size, void* d_ws, size_t ws_size, hipStream_t stream) {
    static int grid = 0;
    if (grid == 0) {
        if (n_in != 30 || out_size < (int)O_END || ws_size < WS_END) { fprintf(stderr, "kernel_launch: unexpected problem shape (n_in %d out %d ws %zu)\n", n_in, out_size, ws_size); grid = -1; return; }
        int dev = 0, cus = 0;
        if (hipGetDevice(&dev) != hipSuccess || hipDeviceGetAttribute(&cus, hipDeviceAttributeMultiprocessorCount, dev) != hipSuccess) { grid = -1; return; }
#if MK_PER_PHASE
        (void)hipFuncSetAttribute((const void*)k_p2_fast, hipFuncAttributeMaxDynamicSharedMemorySize, LDS_BYTES); (void)hipFuncSetAttribute((const void*)k_p3_fast, hipFuncAttributeMaxDynamicSharedMemorySize, LDS_BYTES);
#endif
        if (hipFuncSetAttribute((const void*)fwd, hipFuncAttributeMaxDynamicSharedMemorySize, LDS_BYTES) != hipSuccess) { fprintf(stderr, "kernel_launch: hipFuncSetAttribute failed\n"); grid = -1; return; }
        int per_cu = 0;
        if (hipOccupancyMaxActiveBlocksPerMultiprocessor(&per_cu, (const void*)fwd, NWAVES * 64, LDS_BYTES) != hipSuccess || per_cu < 1) { fprintf(stderr, "kernel_launch: occupancy query says %d\n", per_cu); }
        (void)hipGetLastError();
        grid = cus;
    }
    if (grid < 0) return;
    if (hipMemsetAsync((char*)d_ws + WS_CTL, 0, CTL_ZERO_BYTES, stream) != hipSuccess) return;
    Args a{};
    for (int i = 0; i < 30; ++i) a.in[i] = (const float*)d_in[i];
    a.out = (float*)d_out; a.ws = (unsigned char*)d_ws; a.li = 0; a.pad = 0;
#if MK_PER_PHASE
    ArgsN an{}; for (int i = 0; i < 30; ++i) an.in[i] = (const float*)d_in[i]; an.out = (float*)d_out; an.ws = (unsigned char*)d_ws;
    for (int p = 0; p < N_PHASES; ++p) {
        const int k = (p == 0) ? -1 : (p - 1) % 8, l = (p - 1) / 8;
        if (k == 1) { an.l = l; hipLaunchKernelGGL(k_p2_naive, dim3(256), dim3(512), 0, stream, an); hipLaunchKernelGGL(k_p2_fast, dim3(256), dim3(512), LDS_BYTES, stream, an); }
        else if (k == 2) { an.l = l; hipLaunchKernelGGL(k_p3_naive, dim3(256), dim3(512), 0, stream, an); hipLaunchKernelGGL(k_p3_fast, dim3(256), dim3(512), LDS_BYTES, stream, an); }
        else { a.ph_lo = p; a.ph_hi = p + 1; hipLaunchKernelGGL(fwd, dim3(grid), dim3(NWAVES * 64), LDS_BYTES, stream, a); }
    }
#else
#ifdef PROBE_DUP_PHASE
    { int cur = 0;
      auto launch = [&](int lo_, int hi_) { if (lo_ >= hi_) return; (void)hipMemsetAsync((char*)d_ws + WS_CTL, 0, CTL_ZERO_BYTES, stream); a.ph_lo = lo_; a.ph_hi = hi_; hipLaunchKernelGGL(fwd, dim3(grid), dim3(NWAVES * 64), LDS_BYTES, stream, a); };
      if (PROBE_DUP_PHASE == 0) { launch(0, 1); launch(0, 1); cur = 1; }
      else for (int l = 0; l < DEPTH; ++l) { const int p = 8 * l + PROBE_DUP_PHASE; launch(cur, p + 1); launch(p, p + 1); cur = p + 1; }
      launch(cur, N_PHASES); }
#else
    a.ph_lo = 0; a.ph_hi = N_PHASES;
    hipLaunchKernelGGL(fwd, dim3(grid), dim3(NWAVES * 64), LDS_BYTES, stream, a);
#endif
#endif
}
```

```cpp
#include <hip/hip_runtime.h>
#include <cstdio>
#include <cstdint>
#define MK_PER_PHASE 0
#define FAST_ATTN 1
#define FAST_SSM 1
#define FAST_SGU 1
constexpr int NWAVES = 8;
#ifndef MK_PER_PHASE
#define MK_PER_PHASE 0
#endif
constexpr int DM = 2048, MP = 8192, MS = 64, MREAL = 8256, MTOT = 8448, SEQ = 4096;
constexpr int AW = 1024, SW = 512, GW = 512, INC = 4608, FF = 5632, FF2 = 11264, DEPTH = 4;
constexpr int N_PHASES = 1 + 8 * DEPTH;
constexpr float EPS = 1e-6f;
constexpr float LOG2E = 1.4426950408889634f;
constexpr float QSCALE = 0.08838834764831845f * 1.4426950408889634f;

constexpr size_t O_YP = 0, O_YS = 16777216, O_NKP = 16908288, O_NVP = 33685504, O_SRP = 50462720, O_SIP = 50479104, O_NKS = 50495488,
                 O_NVS = 50757632, O_SRS = 51019776, O_SIS = 51085312, O_SGV = 51150848, O_END = 51281920;
constexpr size_t MiB = 1u << 20;
constexpr size_t WS_CTL = 0, CTL_ZERO_BYTES = 1 * MiB;
constexpr size_t WS_WIN = 1 * MiB, SZ_WIN = (size_t)INC * DM * 2;
constexpr size_t WS_WOUT = WS_WIN + DEPTH * SZ_WIN, SZ_WOUT = (size_t)DM * DM * 2;
constexpr size_t WS_WGU = WS_WOUT + DEPTH * SZ_WOUT, SZ_WGU = (size_t)FF2 * DM * 2;
constexpr size_t WS_WDN = WS_WGU + DEPTH * SZ_WGU, SZ_WDN = (size_t)DM * FF * 2;
constexpr size_t WS_XN = WS_WDN + DEPTH * SZ_WDN;
constexpr size_t WS_Q = WS_XN + (size_t)MTOT * DM * 2;
constexpr size_t WS_K = WS_Q + (size_t)MTOT * AW * 2;
constexpr size_t WS_V = WS_K + (size_t)MTOT * AW * 2;
constexpr size_t WS_U = WS_V + (size_t)MTOT * AW * 2;
constexpr size_t WS_GU = WS_U + (size_t)MTOT * SW * 2;
constexpr size_t WS_GV = WS_GU + (size_t)MTOT * GW * 2;
constexpr size_t WS_MIX = WS_GV + (size_t)MTOT * GW * 2;
constexpr size_t WS_T = WS_MIX + (size_t)MTOT * DM * 2;
constexpr size_t WS_H = WS_T + (size_t)MTOT * DM * 4;
constexpr size_t WS_Y = WS_H + (size_t)MTOT * FF * 2;
constexpr size_t WS_RS = WS_Y + (size_t)MTOT * SW * 4;
constexpr size_t WS_BIAS = WS_RS + 65536;
constexpr size_t WS_WGLU = WS_BIAS + 65536;
constexpr size_t WS_WM = WS_WGLU + (size_t)DEPTH * 512 * 512 * 2;
constexpr size_t WS_AP = WS_WM + (size_t)DEPTH * 4 * 128 * 128 * 2;
constexpr size_t WS_BBF = WS_AP + (size_t)DEPTH * 32 * 64 * 8 * 4;
constexpr size_t WS_CF = WS_BBF + (size_t)DEPTH * 32 * 8 * 64 * 8 * 2;
constexpr size_t WS_SLOC = WS_CF + (size_t)DEPTH * 32 * 4 * 64 * 8 * 2;
constexpr size_t WS_END = WS_SLOC + (size_t)2 * 16 * 8 * 32 * 64 * 2 * 4;
constexpr size_t WS_OBUF = WS_H;
constexpr size_t WS_LSE = WS_T;
constexpr size_t WS_SATT = WS_T + 1 * MiB;
static_assert((size_t)3 * 8192 * 1024 * 2 <= (size_t)MTOT * FF * 2 && (size_t)3 * 8192 * 8 * 4 <= MiB, "overlays");
static_assert(WS_XN % 256 == 0 && WS_Q % 256 == 0 && WS_U % 256 == 0 && WS_MIX % 256 == 0 && WS_T % 256 == 0 && WS_H % 256 == 0 && WS_Y % 256 == 0 && WS_RS % 256 == 0, "ws alignment");
constexpr int CW_BAR = 4096;
constexpr int RING_OFF = 0, RING_BYTES = 131072;
constexpr int LDSCTL_OFF = RING_BYTES, MISC_OFF = LDSCTL_OFF + 320;
constexpr int LDS_BYTES = 147456;

namespace pg8 {
#define PG8_LAS __attribute__((address_space(3)))
typedef unsigned short bf16_t;
typedef short bf16x8 __attribute__((ext_vector_type(8)));
typedef float f32x4 __attribute__((ext_vector_type(4)));
typedef unsigned u32x4 __attribute__((ext_vector_type(4)));
constexpr int BM = 256, BK = 64, HALF = 128, HTB = HALF * BK * 2  , STAGE_BYTES = 8 * HTB, NXCD = 8, WGM = 8;

__host__ __device__ __forceinline__ int lds_byte(int r, int c) { const int st = (r >> 4) * 2 + (c >> 5), rr = r & 15, cc = c & 31, ob = rr * 64 + cc * 2; return st * 1024 + (ob ^ (((ob >> 9) & 1) << 5)); }
__host__ __device__ __forceinline__ void stage_rc(int b, int& R, int& C) { const int st = b / 1024, sb = b % 1024, swz = sb ^ (((sb >> 9) & 1) << 5); R = (st >> 1) * 16 + swz / 64; C = (st & 1) * 32 + (swz % 64) / 2; }
__host__ __device__ __forceinline__ int perm32(int rho) { const int n = rho >> 4, i = rho & 15; return 8 * (i >> 2) + 4 * n + (i & 3); }

struct Unit { int pm, pn; };
struct Gemm { const bf16_t* A; const bf16_t* Bt; int M, N, K; };

struct StaticOrder {
    int nM, nN, nwg, G, c;
    __host__ __device__ void init(int M, int N, int G_, int c_) { nM = M / BM; nN = N / BM; nwg = nM * nN; G = G_; c = c_; }
    __host__ __device__ bool next(int i, Unit& u) const {
        const long L = (long)i * G + c; if (L >= nwg) return false;
        int wgid = (int)L; { const int q = nwg / NXCD, r = nwg % NXCD, xcd = wgid % NXCD, off = wgid / NXCD; wgid = (xcd < r ? xcd * (q + 1) : r * (q + 1) + (xcd - r) * q) + off; }
        const int nig = WGM * nN, gid = wgid / nig, fm = gid * WGM, gsz = (nM - fm) < WGM ? (nM - fm) : WGM;
        u.pm = fm + ((wgid % nig) % gsz); u.pn = (wgid % nig) / gsz; return true;
    }
    __device__ __forceinline__ void a_ready(const Unit&) const {}
    __device__ __forceinline__ void done(const Unit&) const {}
};
__device__ __forceinline__ unsigned cvt_pk_bf16(float lo, float hi) { unsigned r; asm volatile("v_cvt_pk_bf16_f32 %0, %1, %2" : "=v"(r) : "v"(lo), "v"(hi)); return r; }
template <class Epi, class Sched, bool ALIGN_EPI = false, bool SP2 = false>
__device__ __forceinline__ void gemm_phase(PG8_LAS unsigned char* lds, const Gemm g, const Sched& S, const Epi& E) {
    int tid_raw = threadIdx.x; asm volatile("" : "+v"(tid_raw));
    const int tid = tid_raw, wid = __builtin_amdgcn_readfirstlane(tid >> 6), lane = tid & 63, wr = wid >> 2, wc = wid & 3, fr = lane & 15, fq = lane >> 4;
    const int K = g.K, nt = K / BK;
    unsigned voffA[2], voffB[2];
#pragma unroll
    for (int i = 0; i < 2; ++i) { int R, C; stage_rc(tid * 16 + i * 8192, R, C); const int Rb = Epi::PERM ? ((R & ~31) + perm32(R & 31)) : R;
        voffA[i] = (unsigned)(R * K + C) * 2u; voffB[i] = (unsigned)(Rb * K + C) * 2u; }
    const size_t kstep = (size_t)(BK * 2);
    const size_t hstep = (size_t)HALF * K * 2;
    const size_t tstep = 2 * hstep;
    const unsigned ldsw = (unsigned)wid * 1024u;
    const int aoff = lds_byte(wr * 64 + fr, fq * 8), boff = lds_byte(wc * 32 + fr, fq * 8);
#define PG8_SA(b, h) (((b) * 2 + (h)) * HTB)
#define PG8_SB(b, h) ((4 + (b) * 2 + (h)) * HTB)
#define PG8_STAGE(bufoff, gbase, voff) do { _Pragma("unroll") for (int _i = 0; _i < 2; ++_i) \
        __builtin_amdgcn_global_load_lds((const unsigned*)((const char*)(gbase) + (voff)[_i]), (PG8_LAS unsigned*)(lds + (bufoff) + ldsw + _i * 8192), 16, 0, 0); } while (0)
#define PG8_LDA(dst, b, h) do { _Pragma("unroll") for (int m = 0; m < 4; ++m) _Pragma("unroll") for (int k = 0; k < 2; ++k) dst[m][k] = *(const PG8_LAS bf16x8*)(lds + PG8_SA(b, h) + aoff + m * 2048 + k * 1024); } while (0)
#define PG8_LDB(dst, b, h) do { _Pragma("unroll") for (int n = 0; n < 2; ++n) _Pragma("unroll") for (int k = 0; k < 2; ++k) dst[n][k] = *(const PG8_LAS bf16x8*)(lds + PG8_SB(b, h) + boff + n * 2048 + k * 1024); } while (0)
#define PG8_MMA(ai, bj, At, Bt) do { __builtin_amdgcn_s_setprio(1); _Pragma("unroll") for (int m = 0; m < 4; ++m) _Pragma("unroll") for (int n = 0; n < 2; ++n) _Pragma("unroll") for (int k = 0; k < 2; ++k) \
        acc[ai][bj][m][n] = __builtin_amdgcn_mfma_f32_16x16x32_bf16(Bt[n][k], At[m][k], acc[ai][bj][m][n], 0, 0, 0); __builtin_amdgcn_s_setprio(0); } while (0)
#define PG8_WAIT_V(n) asm volatile("s_waitcnt vmcnt(" #n ")" ::: "memory")
#define PG8_WAIT_L(n) asm volatile("s_waitcnt lgkmcnt(" #n ")" ::: "memory")
#define PG8_BAR __builtin_amdgcn_s_barrier()
#define PG8_SCHED __builtin_amdgcn_sched_barrier(0)
    Unit cur, nxt; int ui = 0;
    if (!S.next(0, cur)) return;
    f32x4 acc[2][2][4][2];
#pragma unroll
    for (int a = 0; a < 2; ++a)
#pragma unroll
        for (int b = 0; b < 2; ++b)
#pragma unroll
            for (int m = 0; m < 4; ++m)
#pragma unroll
                for (int n = 0; n < 2; ++n) acc[a][b][m][n] = (f32x4){0.f, 0.f, 0.f, 0.f};
    bf16x8 At[4][2], B0[2][2], B1[2][2];
    const char* cA = (const char*)g.A + (size_t)cur.pm * tstep; const char* cB = (const char*)g.Bt + (size_t)cur.pn * tstep;
    S.a_ready(cur);
    if constexpr (SP2) {
        PG8_STAGE(PG8_SB(0, 0), cB, voffB); PG8_STAGE(PG8_SB(0, 1), cB + hstep, voffB); PG8_STAGE(PG8_SA(0, 0), cA, voffA); PG8_STAGE(PG8_SA(0, 1), cA + hstep, voffA);
        if (wr == 1) PG8_BAR;
        PG8_WAIT_V(2); PG8_BAR;
        PG8_STAGE(PG8_SB(1, 0), cB + kstep, voffB); PG8_STAGE(PG8_SA(1, 0), cA + kstep, voffA); PG8_STAGE(PG8_SB(1, 1), cB + hstep + kstep, voffB);
        PG8_WAIT_V(6); PG8_BAR;
    } else {
        PG8_STAGE(PG8_SB(0, 0), cB, voffB); PG8_STAGE(PG8_SA(0, 0), cA, voffA); PG8_STAGE(PG8_SB(0, 1), cB + hstep, voffB); PG8_STAGE(PG8_SA(0, 1), cA + hstep, voffA);
        if (wr == 1) PG8_BAR;
        PG8_WAIT_V(4); PG8_BAR;
        PG8_STAGE(PG8_SB(1, 0), cB + kstep, voffB); PG8_STAGE(PG8_SA(1, 0), cA + kstep, voffA); PG8_STAGE(PG8_SB(1, 1), cB + hstep + kstep, voffB);
        PG8_WAIT_V(6); PG8_BAR;
    }
    for (;;) {
        const bool has_next = S.next(ui + 1, nxt);
        const char* nA = has_next ? (const char*)g.A + (size_t)nxt.pm * tstep : cA; const char* nB = has_next ? (const char*)g.Bt + (size_t)nxt.pn * tstep : cB;
        for (int t = 0; t < nt; t += 2) {
            const bool last = (t == nt - 2);
            const char* a1 = cA + (size_t)(t + 1) * kstep;
            const char* a2 = last ? nA : cA + (size_t)(t + 2) * kstep; const char* b2 = last ? nB : cB + (size_t)(t + 2) * kstep;
            const char* a3 = a2 + kstep; const char* b3 = b2 + kstep;
            if (last && has_next) S.a_ready(nxt);
            if constexpr (SP2) {
            PG8_LDB(B0, 0, 0); PG8_LDB(B1, 0, 1); PG8_SCHED; PG8_LDA(At, 0, 0); PG8_STAGE(PG8_SA(1, 1), a1 + hstep, voffA);
            PG8_WAIT_V(8); PG8_WAIT_L(0); PG8_BAR; PG8_MMA(0, 0, At, B0); PG8_MMA(0, 1, At, B1); PG8_BAR; PG8_SCHED;
            PG8_LDA(At, 0, 1); PG8_STAGE(PG8_SB(0, 0), b2, voffB); PG8_STAGE(PG8_SB(0, 1), b2 + hstep, voffB); PG8_STAGE(PG8_SA(0, 0), a2, voffA);
            PG8_WAIT_V(8); PG8_WAIT_L(0); PG8_BAR; PG8_MMA(1, 0, At, B0); PG8_MMA(1, 1, At, B1); PG8_BAR; PG8_SCHED;
            PG8_LDB(B0, 1, 0); PG8_LDB(B1, 1, 1); PG8_SCHED; PG8_LDA(At, 1, 0); PG8_STAGE(PG8_SA(0, 1), a2 + hstep, voffA);
            PG8_WAIT_V(8); PG8_WAIT_L(0); PG8_BAR; PG8_MMA(0, 0, At, B0); PG8_MMA(0, 1, At, B1); PG8_BAR; PG8_SCHED;
            PG8_LDA(At, 1, 1); PG8_STAGE(PG8_SB(1, 0), b3, voffB); PG8_STAGE(PG8_SB(1, 1), b3 + hstep, voffB); PG8_STAGE(PG8_SA(1, 0), a3, voffA);
            PG8_WAIT_V(8); PG8_WAIT_L(0); PG8_BAR; PG8_MMA(1, 0, At, B0); PG8_MMA(1, 1, At, B1); PG8_BAR; PG8_SCHED;
            } else {
            PG8_LDB(B0, 0, 0); PG8_SCHED; PG8_LDA(At, 0, 0); PG8_STAGE(PG8_SA(1, 1), a1 + hstep, voffA);
            PG8_WAIT_L(8); PG8_BAR; PG8_WAIT_L(0); PG8_MMA(0, 0, At, B0); PG8_BAR; PG8_SCHED;
            PG8_LDB(B1, 0, 1); PG8_STAGE(PG8_SB(0, 0), b2, voffB);
            PG8_BAR; PG8_WAIT_L(0); PG8_MMA(0, 1, At, B1); PG8_BAR;
            PG8_LDA(At, 0, 1); PG8_STAGE(PG8_SA(0, 0), a2, voffA);
            PG8_BAR; PG8_WAIT_L(0); PG8_MMA(1, 0, At, B0); PG8_BAR; PG8_SCHED;
            PG8_STAGE(PG8_SB(0, 1), b2 + hstep, voffB);
            PG8_WAIT_V(6); PG8_BAR; PG8_MMA(1, 1, At, B1); PG8_BAR;
            PG8_LDB(B0, 1, 0); PG8_SCHED; PG8_LDA(At, 1, 0); PG8_STAGE(PG8_SA(0, 1), a2 + hstep, voffA);
            PG8_WAIT_L(8); PG8_BAR; PG8_WAIT_L(0); PG8_MMA(0, 0, At, B0); PG8_BAR; PG8_SCHED;
            PG8_LDB(B1, 1, 1); PG8_STAGE(PG8_SB(1, 0), b3, voffB);
            PG8_BAR; PG8_WAIT_L(0); PG8_MMA(0, 1, At, B1); PG8_BAR;
            PG8_LDA(At, 1, 1); PG8_STAGE(PG8_SA(1, 0), a3, voffA);
            PG8_BAR; PG8_WAIT_L(0); PG8_MMA(1, 0, At, B0); PG8_BAR; PG8_SCHED;
            PG8_STAGE(PG8_SB(1, 1), b3 + hstep, voffB);
            PG8_WAIT_V(6); PG8_BAR; PG8_MMA(1, 1, At, B1); PG8_BAR;
            }
        }
        if constexpr (ALIGN_EPI) { if (wr == 0) PG8_BAR; }
        if constexpr (!Epi::AFTER_DRAIN) { E(acc, cur, wr, wc, fr, fq); S.done(cur); }
        if (!has_next) break;
#pragma unroll
        for (int a = 0; a < 2; ++a)
#pragma unroll
            for (int b = 0; b < 2; ++b)
#pragma unroll
                for (int m = 0; m < 4; ++m)
#pragma unroll
                    for (int n = 0; n < 2; ++n) acc[a][b][m][n] = (f32x4){0.f, 0.f, 0.f, 0.f};
        cur = nxt; cA = nA; cB = nB; ++ui;
        if constexpr (ALIGN_EPI) { if (wr == 1) PG8_BAR; }
    }
    PG8_WAIT_V(0);
    if constexpr (!ALIGN_EPI) { if (wr == 0) PG8_BAR; }
    PG8_BAR;
    if constexpr (Epi::AFTER_DRAIN) { E.fused(acc, cur, wr, wc, fr, fq, lds, wid, lane); S.done(cur); }
#undef PG8_SA
#undef PG8_SB
#undef PG8_STAGE
#undef PG8_LDA
#undef PG8_LDB
#undef PG8_MMA
#undef PG8_WAIT_V
#undef PG8_WAIT_L
#undef PG8_BAR
#undef PG8_SCHED
}
}

namespace pg8 {
__device__ __forceinline__ float fast_sigmoid(float w) { return __builtin_amdgcn_rcpf(1.0f + __builtin_amdgcn_exp2f(-1.4426950408889634f * w)); }
__device__ __forceinline__ float gelu_tanh(float x) { return x * fast_sigmoid(1.5957691216057308f * (x + 0.044715f * x * x * x)); }

struct EpiF32 {
    static constexpr bool PERM = false, AFTER_DRAIN = false;
    float* C; int ldc;
    __device__ __forceinline__ void operator()(const f32x4 (&acc)[2][2][4][2], const Unit& u, int wr, int wc, int fr, int fq) const {
        const int row0 = u.pm * BM + wr * 64 + fr, col0 = u.pn * BM + wc * 32 + 4 * fq;
#pragma unroll
        for (int ai = 0; ai < 2; ++ai)
#pragma unroll
            for (int m = 0; m < 4; ++m) { float* rowp = C + (size_t)(row0 + ai * HALF + m * 16) * ldc + col0;
#pragma unroll
                for (int bj = 0; bj < 2; ++bj)
#pragma unroll
                    for (int n = 0; n < 2; ++n) *(f32x4*)(rowp + bj * HALF + n * 16) = acc[ai][bj][m][n]; }
    }
};

struct EpiIn {
    static constexpr bool PERM = true, AFTER_DRAIN = false;
    unsigned char* ws; float* out; int layer;
    __device__ __forceinline__ void operator()(const f32x4 (&acc)[2][2][4][2], const Unit& u, int wr, int wc, int fr, int fq) const {
        const int row0 = u.pm * BM + wr * 64 + fr;
        const int pn = u.pn;
#pragma unroll
        for (int ai = 0; ai < 2; ++ai)
#pragma unroll
            for (int m = 0; m < 4; ++m) {
                const int row = row0 + ai * HALF + m * 16;
                const float r = ((const float*)(ws + WS_RS))[row];
#pragma unroll
                for (int bj = 0; bj < 2; ++bj) {
                    f32x4 v0 = acc[ai][bj][m][0] * r, v1 = acc[ai][bj][m][1] * r;
                    const int col = pn * BM + bj * HALF + wc * 32 + 8 * fq;
                    bf16_t* dst;
                    if (pn < 4) dst = (bf16_t*)(ws + WS_Q) + (size_t)row * 1024 + col;
                    else if (pn < 8) dst = (bf16_t*)(ws + WS_K) + (size_t)row * 1024 + (col - 1024);
                    else if (pn < 12) dst = (bf16_t*)(ws + WS_V) + (size_t)row * 1024 + (col - 2048);
                    else if (pn < 14) dst = (bf16_t*)(ws + WS_U) + (size_t)row * 512 + (col - 3072);
                    else if (pn < 16) dst = (bf16_t*)(ws + WS_GU) + (size_t)row * 512 + (col - 3584);
                    else dst = (bf16_t*)(ws + WS_GV) + (size_t)row * 512 + (col - 4096);
                    if (pn >= 4 && pn < 12) {
                        const int c2 = (pn < 8) ? col - 1024 : col - 2048;
                        float* o = nullptr;
                        if (row < 8192) { const int b = row >> 12, t = row & 4095;
                            if (t >= 2048) o = out + ((pn < 8) ? O_NKP : O_NVP) + ((size_t)((layer * 2 + b) * 2048 + (t - 2048))) * 1024 + c2; }
                        else if (row < 8256) o = out + ((pn < 8) ? O_NKS : O_NVS) + ((size_t)(layer * 64 + (row - 8192))) * 1024 + c2;
                        if (o) { *(f32x4*)o = v0; *(f32x4*)(o + 4) = v1; }
                    }
                    if (pn >= 14) {
#pragma unroll
                        for (int j = 0; j < 4; ++j) { v0[j] = gelu_tanh(v0[j]); v1[j] = gelu_tanh(v1[j]); }
                    }
                    u32x4 w; w.x = cvt_pk_bf16(v0[0], v0[1]); w.y = cvt_pk_bf16(v0[2], v0[3]); w.z = cvt_pk_bf16(v1[0], v1[1]); w.w = cvt_pk_bf16(v1[2], v1[3]);
                    *(u32x4*)dst = w;
                }
            }
    }
};

struct EpiGU {
    static constexpr bool PERM = true, AFTER_DRAIN = false;
    unsigned char* ws;
    __device__ __forceinline__ void operator()(const f32x4 (&acc)[2][2][4][2], const Unit& u, int wr, int wc, int fr, int fq) const {
        const int row0 = u.pm * BM + wr * 64 + fr, j0 = u.pn * HALF + wc * 32 + 8 * fq;
#pragma unroll
        for (int ai = 0; ai < 2; ++ai)
#pragma unroll
            for (int m = 0; m < 4; ++m) {
                const int row = row0 + ai * HALF + m * 16;
                const float r = ((const float*)(ws + WS_RS))[row];
                float o[8];
#pragma unroll
                for (int n = 0; n < 2; ++n)
#pragma unroll
                    for (int j = 0; j < 4; ++j) { const float g = acc[ai][0][m][n][j] * r, up = acc[ai][1][m][n][j] * r; o[4 * n + j] = g * fast_sigmoid(g) * up; }
                u32x4 w; w.x = cvt_pk_bf16(o[0], o[1]); w.y = cvt_pk_bf16(o[2], o[3]); w.z = cvt_pk_bf16(o[4], o[5]); w.w = cvt_pk_bf16(o[6], o[7]);
                *(u32x4*)((bf16_t*)(ws + WS_H) + (size_t)row * 5632 + j0) = w;
            }
    }
};
}

#define GAS __attribute__((address_space(1)))
#define LAS __attribute__((address_space(3)))
typedef unsigned short bf16;
typedef unsigned v4u __attribute__((ext_vector_type(4)));
typedef unsigned v2u __attribute__((ext_vector_type(2)));
typedef float f32x4 __attribute__((ext_vector_type(4)));
typedef float f32x2v __attribute__((ext_vector_type(2)));
typedef short bf16x8 __attribute__((ext_vector_type(8)));
typedef GAS unsigned gu32;
#define RLX_AGENT __ATOMIC_RELAXED, __HIP_MEMORY_SCOPE_AGENT
#define LDS_WAIT() asm volatile("s_waitcnt lgkmcnt(0)" ::: "memory")
#define VM_WAIT() asm volatile("s_waitcnt vmcnt(0)" ::: "memory")
__device__ __forceinline__ unsigned f2bf(float f) { unsigned u = __builtin_bit_cast(unsigned, f); return (u + 0x7fffu + ((u >> 16) & 1u)) >> 16; }
__device__ __forceinline__ unsigned pk2(float lo, float hi) { return f2bf(lo) | (f2bf(hi) << 16); }
__device__ __forceinline__ float bf_lo(unsigned w) { return __builtin_bit_cast(float, w << 16); }
__device__ __forceinline__ float bf_hi(unsigned w) { return __builtin_bit_cast(float, w & 0xffff0000u); }
__device__ __forceinline__ float bf2f(bf16 b) { return __builtin_bit_cast(float, ((unsigned)b) << 16); }

#define XB_TMO      128
#define XB_XCNT(j)  (256  + 64 * (j))
#define XB_XSUB(j)  (1280 + 64 * (j))
#define XB_XGEN(j)  (2304 + 64 * (j))
#define XB_TOP      3328
#define XB_TOPGEN   3392
#define XCD_BAR_WORDS 3456
#define XB_SPIN_CAP (1u << 18)

__device__ __forceinline__ unsigned xb_ld(unsigned* p)              { return __hip_atomic_load(p, __ATOMIC_RELAXED, __HIP_MEMORY_SCOPE_AGENT); }
__device__ __forceinline__ unsigned xb_add(unsigned* p, unsigned v) { return __hip_atomic_fetch_add(p, v, __ATOMIC_RELAXED, __HIP_MEMORY_SCOPE_AGENT); }
__device__ __forceinline__ unsigned xb_xcc_id() { return (unsigned)__builtin_amdgcn_s_getreg((3 << 11) | 20) & 0xFu; }
#define XB_SPIN(cond, bar) do { unsigned _sp = 0; while (cond) { __builtin_amdgcn_s_sleep(1); \
    if ((++_sp & 255u) == 0u) { if (xb_ld(&(bar)[XB_TMO])) break; if (_sp > XB_SPIN_CAP) { atomicAdd(&(bar)[XB_TMO], 1u); break; } } } } while (0)

struct XcdBarrier {
    unsigned* bar; unsigned x;
    volatile LAS unsigned* st;
};

__device__ __forceinline__ XcdBarrier xcd_barrier_post(unsigned* bar, volatile LAS unsigned* st) {
    XcdBarrier b; b.bar = bar; b.x = xb_xcc_id(); b.st = st;
    if (threadIdx.x == 0) (void)xb_add(&bar[XB_XCNT(b.x)], 1u);
    return b;
}
__device__ __forceinline__ void xcd_barrier_complete(unsigned* bar, unsigned x, unsigned& nloc, unsigned& nx) {
    const unsigned G = gridDim.x * gridDim.y * gridDim.z;
    unsigned sum, cnt, mine, sp = 0u;
    for (;;) {
        sum = 0u; cnt = 0u; mine = 0u;
#pragma unroll
        for (unsigned j = 0; j < 16; ++j) { const unsigned c = xb_ld(&bar[XB_XCNT(j)]); sum += c; cnt += (c > 0u) ? 1u : 0u; mine = (j == x) ? c : mine; }
        if (sum == G) break;
        __builtin_amdgcn_s_sleep(1);
        if ((++sp & 255u) == 0u) { if (xb_ld(&bar[XB_TMO])) break; if (sp > XB_SPIN_CAP) { atomicAdd(&bar[XB_TMO], 1u); break; } }
    }
    nloc = mine > 0u ? mine : 1u; nx = cnt > 0u ? cnt : 1u;
}

__device__ __forceinline__ void xcd_barrier(const XcdBarrier& b) {
    asm volatile("s_waitcnt vmcnt(0)" ::: "memory");
    __syncthreads();
    if (threadIdx.x == 0) {
        unsigned* bar = b.bar;
        __builtin_amdgcn_s_waitcnt(0);
        unsigned nloc = b.st[0], nx = b.st[1];
        if (nloc == 0u) { xcd_barrier_complete(bar, b.x, nloc, nx); b.st[0] = nloc; b.st[1] = nx; }
        const unsigned old = xb_add(&bar[XB_XSUB(b.x)], 1u);
        const unsigned gen = old / nloc;
        if (old + 1u == (gen + 1u) * nloc) {
            __builtin_amdgcn_fence(__ATOMIC_RELEASE, "agent");
            asm volatile("s_waitcnt vmcnt(0)" ::: "memory");
            const unsigned og = xb_add(&bar[XB_TOP], 1u);
            const unsigned tg = og / nx;
            if (og + 1u == (tg + 1u) * nx) xb_add(&bar[XB_TOPGEN], 1u);
            else XB_SPIN(xb_ld(&bar[XB_TOPGEN]) == tg, bar);
            __builtin_amdgcn_fence(__ATOMIC_ACQUIRE, "agent");
            xb_add(&bar[XB_XGEN(b.x)], 1u);
            asm volatile("s_waitcnt vmcnt(0)" ::: "memory");
        } else {
            XB_SPIN(xb_ld(&bar[XB_XGEN(b.x)]) == gen, bar);
            __builtin_amdgcn_fence(__ATOMIC_ACQUIRE, "agent");
            asm volatile("s_waitcnt vmcnt(0)" ::: "memory");
        }
    }
    __syncthreads();
}


#ifndef PROBE_P0
#define PROBE_P0 1
#endif
#ifndef PROBE_P2
#define PROBE_P2 1
#endif
#ifndef PROBE_P3
#define PROBE_P3 1
#endif
#ifndef MK_FUSED_MIXERS
#define MK_FUSED_MIXERS 1
#endif
#ifndef FAST_ATTN
#define FAST_ATTN 0
#endif
#ifndef FAST_SSM
#define FAST_SSM 0
#endif
#ifndef FAST_SGU
#define FAST_SGU 0
#endif
struct Frame {
    LAS unsigned char* lds;
    volatile LAS unsigned* MISC;
    gu32* ctl;
    int tid, lane, wave;
    int vcu, G;
    const float* const* inp;
    float* out;
    unsigned char* ws;
};
#define F_IN(k) (F.inp[(k)])
#define F_WS(type, off) ((type*)(F.ws + (off)))
enum { I_XP = 0, I_XS, I_CK, I_CV, I_SRE, I_SIM, I_RELB, I_WIN, I_WOUT, I_GPREMIX, I_GPOSTMIX, I_GMIXOUT, I_LAMRE, I_LAMIM, I_LOGSTEP, I_BRE, I_BIM, I_CRE, I_CIM,
       I_SSMD, I_WGLU, I_BGLU, I_SGUG, I_SGUW, I_SGUB, I_GPREFFN, I_GPOSTFFN, I_WGATE, I_WUP, I_WDOWN };

__device__ __forceinline__ float wave_sum(float v) {
#pragma unroll
    for (int o = 1; o < 64; o <<= 1) v += __shfl_xor(v, o);
    return v;
}

__device__ __forceinline__ void p0_transpose_item(const float* W, int K, int N, bf16* WT, LAS float* scr, int item, int lane, const float* kscale, float cscale, int cs_limit, int mode) {
    const int nblk = N / 32, kb = item / nblk, nb = item % nblk, k0 = 64 * kb, n0 = 32 * nb;
    const float cs = (n0 < cs_limit) ? cscale : 1.0f;
#pragma unroll 8
    for (int i = 0; i < 32; ++i) { const int kk = 2 * i + (lane >> 5); float v = W[(size_t)(k0 + kk) * N + n0 + (lane & 31)]; if (kscale) v *= kscale[k0 + kk]; scr[kk * 33 + (lane & 31)] = v * cs; }
    LDS_WAIT(); asm volatile("" ::: "memory");
    const int c = lane & 7;
#pragma unroll
    for (int j = 0; j < 4; ++j) { const int n = (lane >> 3) + 8 * j; const LAS float* s = scr + (8 * c) * 33 + n;
        v4u o; o.x = pk2(s[0 * 33], s[1 * 33]); o.y = pk2(s[2 * 33], s[3 * 33]); o.z = pk2(s[4 * 33], s[5 * 33]); o.w = pk2(s[6 * 33], s[7 * 33]);
        const int col = n0 + n; const int row = (mode == 0) ? col : (256 * (col >> 7) + (col & 127) + (mode == 2 ? 128 : 0));
        *(GAS v4u*)(WT + (size_t)row * K + k0 + 8 * c) = o; }
    LDS_WAIT(); asm volatile("" ::: "memory");
}
__device__ __forceinline__ int t5_bucket(int dist) {
    if (dist < 16) return dist;
    int large = 16 + (int)(logf((float)dist / 16.0f) / logf(128.0f) * 16.0f);
    return large < 31 ? large : 31;
}
__device__ __forceinline__ void p0_prologue(Frame& F) {
    LAS float* scr = (LAS float*)(F.lds + RING_OFF + F.wave * 16384);
    const int gw = F.vcu * NWAVES + F.wave, NGW = F.G * NWAVES;
    constexpr int I_IN = (DM / 64) * (INC / 32), I_OUT = (DM / 64) * (DM / 32), I_G = (DM / 64) * (FF / 32), I_D = (FF / 64) * (DM / 32);
    constexpr int I_GLU = (SW / 64) * (SW / 32);
    constexpr int PER_L = I_IN + I_OUT + 2 * I_G + I_D + I_GLU;
    for (int it = gw; it < DEPTH * PER_L; it += NGW) {
        const int l = it / PER_L; int r = it % PER_L;
        if (r < I_IN) { p0_transpose_item(F_IN(I_WIN) + (size_t)l * DM * INC, DM, INC, F_WS(bf16, WS_WIN) + (size_t)l * INC * DM, scr, r, F.lane, F_IN(I_GPREMIX) + l * DM, QSCALE, AW, 0); continue; } r -= I_IN;
        if (r < I_OUT) { p0_transpose_item(F_IN(I_WOUT) + (size_t)l * DM * DM, DM, DM, F_WS(bf16, WS_WOUT) + (size_t)l * DM * DM, scr, r, F.lane, nullptr, 1.f, 0, 0); continue; } r -= I_OUT;
        if (r < I_G) { p0_transpose_item(F_IN(I_WGATE) + (size_t)l * DM * FF, DM, FF, F_WS(bf16, WS_WGU) + (size_t)l * FF2 * DM, scr, r, F.lane, F_IN(I_GPREFFN) + l * DM, 1.f, 0, 1); continue; } r -= I_G;
        if (r < I_G) { p0_transpose_item(F_IN(I_WUP) + (size_t)l * DM * FF, DM, FF, F_WS(bf16, WS_WGU) + (size_t)l * FF2 * DM, scr, r, F.lane, F_IN(I_GPREFFN) + l * DM, 1.f, 0, 2); continue; } r -= I_G;
        if (r < I_D) { p0_transpose_item(F_IN(I_WDOWN) + (size_t)l * FF * DM, FF, DM, F_WS(bf16, WS_WDN) + (size_t)l * DM * FF, scr, r, F.lane, nullptr, 1.f, 0, 0); continue; } r -= I_D;
        p0_transpose_item(F_IN(I_WGLU) + (size_t)l * SW * SW, SW, SW, F_WS(bf16, WS_WGLU) + (size_t)l * SW * SW, scr, r, F.lane, nullptr, 1.f, 0, 0);
    }
    for (int i = gw * 64 + F.lane; i < DEPTH * 32 * 64; i += NGW * 64) {
        const int p = i & 63, g = (i >> 6) & 31, l = i >> 11;
        const float lr = F_IN(I_LAMRE)[i], li = F_IN(I_LAMIM)[i], step = expf(F_IN(I_LOGSTEP)[l * 32 + g]);
        const float mag = expf(lr * step), are = mag * cosf(li * step), aim = mag * sinf(li * step);
        const float den = lr * lr + li * li, cre_ = ((are - 1.0f) * lr + aim * li) / den, cim_ = (aim * lr - (are - 1.0f) * li) / den;
        float pr = are, pim = aim; float* ap = F_WS(float, WS_AP) + (size_t)i * 8; ap[0] = are; ap[1] = aim;
        for (int k = 0; k < 5; ++k) { const float nr = pr * pr - pim * pim, ni = 2.0f * pr * pim; pr = nr; pim = ni; }
        ap[2] = pr; ap[3] = pim;
        for (int k = 0; k < 3; ++k) { const float nr = pr * pr - pim * pim, ni = 2.0f * pr * pim; pr = nr; pim = ni; }
        ap[4] = pr; ap[5] = pim; ap[6] = 0.f; ap[7] = 0.f;
        bf16* BB = F_WS(bf16, WS_BBF) + ((size_t)(l * 32 + g) * 8) * 512; bf16* CFp = F_WS(bf16, WS_CF) + ((size_t)(l * 32 + g) * 4) * 512;
        const int mt = p >> 4, rowi = p & 15;
        for (int c = 0; c < 16; ++c) { const float br = F_IN(I_BRE)[(size_t)i * 16 + c], bi = F_IN(I_BIM)[(size_t)i * 16 + c];
            const int ln = rowi + 16 * (c >> 3), j = c & 7;
            BB[(mt * 64 + ln) * 8 + j] = (bf16)f2bf(cre_ * br - cim_ * bi); BB[((4 + mt) * 64 + ln) * 8 + j] = (bf16)f2bf(cre_ * bi + cim_ * br);
            const int lc = c + 16 * ((p >> 3) & 3), jc = p & 7;
            CFp[((p >> 5) * 64 + lc) * 8 + jc] = (bf16)f2bf(F_IN(I_CRE)[(((size_t)l * 32 + g) * 16 + c) * 64 + p]);
            CFp[((2 + (p >> 5)) * 64 + lc) * 8 + jc] = (bf16)f2bf(-F_IN(I_CIM)[(((size_t)l * 32 + g) * 16 + c) * 64 + p]); }
        for (int g4 = 2; g4 < 4; ++g4) for (int j = 0; j < 8; ++j) { BB[(mt * 64 + rowi + 16 * g4) * 8 + j] = 0; BB[((4 + mt) * 64 + rowi + 16 * g4) * 8 + j] = 0; }
    }
    for (int i = gw * 64 + F.lane; i < DEPTH * 4 * 128 * 128; i += NGW * 64) { const int s = i & 127, t = (i >> 7) & 127; F_WS(bf16, WS_WM)[i] = (s <= t) ? (bf16)f2bf(F_IN(I_SGUW)[i]) : (bf16)0; }
    for (int m = gw; m < MTOT; m += NGW) {
        GAS v2u* xo = (GAS v2u*)(F_WS(bf16, WS_XN) + (size_t)m * DM) + F.lane;
        if (m < MREAL) {
            const float* src = (m < MP) ? F_IN(I_XP) + (size_t)m * DM : F_IN(I_XS) + (size_t)(m - MP) * DM;
            const GAS f32x4* xr = (const GAS f32x4*)src + F.lane; GAS f32x4* xw = (GAS f32x4*)(F.out + (size_t)m * DM) + F.lane;
            f32x4 v[8]; float s = 0.f;
#pragma unroll
            for (int j = 0; j < 8; ++j) { v[j] = xr[64 * j]; s += (v[j].x * v[j].x + v[j].y * v[j].y) + (v[j].z * v[j].z + v[j].w * v[j].w); }
            s = wave_sum(s);
#pragma unroll
            for (int j = 0; j < 8; ++j) { xw[64 * j] = v[j]; v2u w; w.x = pk2(v[j].x, v[j].y); w.y = pk2(v[j].z, v[j].w); xo[64 * j] = w; }
            if (F.lane == 0) F_WS(float, WS_RS)[m] = 1.0f / sqrtf(s * (1.0f / DM) + EPS);
        } else {
#pragma unroll
            for (int j = 0; j < 8; ++j) { v2u w; w.x = 0u; w.y = 0u; xo[64 * j] = w; }
            if (F.lane == 0) F_WS(float, WS_RS)[m] = 0.f;
        }
    }
    for (int i = gw * 64 + F.lane; i < 3 * 8 * 129; i += NGW * 64) {
        const int jj = i % 129, h = (i / 129) % 8, pi = i / (129 * 8); const int d = pi == 0 ? 1 : (pi == 1 ? 4 : 16);
        F_WS(float, WS_BIAS)[i] = F_IN(I_RELB)[t5_bucket(jj * d) * 8 + h] * LOG2E;
    }
}

__device__ __forceinline__ void norm_rows(Frame& F, const float* g) {
    const int gw = F.vcu * NWAVES + F.wave, NGW = F.G * NWAVES;
    for (int m = gw; m < MREAL; m += NGW) {
        const GAS f32x4* tr = (const GAS f32x4*)(F_WS(float, WS_T) + (size_t)m * DM) + F.lane; GAS f32x4* xw = (GAS f32x4*)(F.out + (size_t)m * DM) + F.lane;
        const GAS f32x4* gr = (const GAS f32x4*)g + F.lane; GAS v2u* xo = (GAS v2u*)(F_WS(bf16, WS_XN) + (size_t)m * DM) + F.lane;
        f32x4 tv[8]; float s = 0.f;
#pragma unroll
        for (int j = 0; j < 8; ++j) { tv[j] = tr[64 * j]; s += (tv[j].x * tv[j].x + tv[j].y * tv[j].y) + (tv[j].z * tv[j].z + tv[j].w * tv[j].w); }
        const float r = 1.0f / sqrtf(wave_sum(s) * (1.0f / DM) + EPS);
        float s2 = 0.f;
#pragma unroll
        for (int j = 0; j < 8; ++j) { const f32x4 xv = xw[64 * j], gv = gr[64 * j]; tv[j] = xv + tv[j] * r * gv; s2 += (tv[j].x * tv[j].x + tv[j].y * tv[j].y) + (tv[j].z * tv[j].z + tv[j].w * tv[j].w); }
        s2 = wave_sum(s2);
#pragma unroll
        for (int j = 0; j < 8; ++j) { xw[64 * j] = tv[j]; v2u w; w.x = pk2(tv[j].x, tv[j].y); w.y = pk2(tv[j].z, tv[j].w); xo[64 * j] = w; }
        if (F.lane == 0) F_WS(float, WS_RS)[m] = 1.0f / sqrtf(s2 * (1.0f / DM) + EPS);
    }
}


typedef short s16x4 __attribute__((ext_vector_type(4)));
typedef short v4i16_t __attribute__((ext_vector_type(4)));
typedef LAS const char* lds_cptr;
#define MFMA16(a, b, c) __builtin_amdgcn_mfma_f32_16x16x32_bf16((a), (b), (c), 0, 0, 0)
__device__ __forceinline__ unsigned off_b(unsigned row, unsigned ch) { return 256u * row + 16u * (ch ^ (((row & 3u) << 2) | ((row >> 2) & 3u))); }
__device__ __forceinline__ unsigned tr_addr16(unsigned lane, unsigned c, unsigned ks, unsigned t) {
    const unsigned g = lane >> 4, q = (lane & 15u) >> 2, p = lane & 3u;
    return off_b(32u * ks + 8u * g + 4u * t + q, 2u * c + (p >> 1)) + 8u * (p & 1u);
}
__device__ __forceinline__ s16x4 vtr(lds_cptr p) { return __builtin_bit_cast(s16x4, __builtin_amdgcn_ds_read_tr16_b64_v4i16((LAS v4i16_t*)p)); }
__device__ __forceinline__ unsigned cvtpk(float lo, float hi) { unsigned r; asm volatile("v_cvt_pk_bf16_f32 %0, %1, %2" : "=v"(r) : "v"(lo), "v"(hi)); return r; }

constexpr int LDS_X_OFF = 132096;
constexpr int ATT_UNITS = 1536;

struct AttnU { int pi, n, h, r, b, d; };
__device__ __forceinline__ AttnU attn_decode(int unit) {
    AttnU a; a.pi = unit >> 9; const int r2 = unit & 511; a.n = r2 >> 8; a.h = (r2 >> 5) & 7; const int rb = r2 & 31;
    const int dsh = 2 * a.pi, nbs = 5 - dsh; a.d = 1 << dsh;
    a.r = rb >> nbs; a.b = rb & ((1 << nbs) - 1); return a;
}
__device__ __forceinline__ void attn_stage_load(unsigned char* ws, int unit, int tid, v4u (&kv)[8], v4u (&vv)[8]) {
    const AttnU a = attn_decode(unit);
    const bf16* Kg = (const bf16*)(ws + WS_K); const bf16* Vg = (const bf16*)(ws + WS_V);
    const int ch = tid & 15, jr = tid >> 4;
#pragma unroll
    for (int p = 0; p < 8; ++p) { const int j = p * 32 + jr; const int tk = a.r + a.d * (128 * (a.b - 1) + j);
        if (tk >= 0) { const size_t off = ((size_t)(a.n * SEQ + tk)) * AW + a.h * 128 + ch * 8; kv[p] = *(const v4u*)(Kg + off); vv[p] = *(const v4u*)(Vg + off); }
        else { kv[p] = (v4u){0u, 0u, 0u, 0u}; vv[p] = (v4u){0u, 0u, 0u, 0u}; } }
}
__device__ __forceinline__ void attn_compute(LAS unsigned char* lds, unsigned char* ws, int unit, int tid);
__device__ __forceinline__ void attn_units(LAS unsigned char* lds, unsigned char* ws, int first, int stride, int tid) {
    if (first >= ATT_UNITS) return;
    LAS unsigned char* Kimg = lds; LAS unsigned char* Vimg = lds + 65536; LAS float* btab = (LAS float*)(lds + LDS_X_OFF);
    v4u kv[8], vv[8];
    int u = first;
    attn_stage_load(ws, u, tid, kv, vv);
    for (;;) {
        { const int ch = tid & 15, jr = tid >> 4;
#pragma unroll
          for (int p = 0; p < 8; ++p) { const int j = p * 32 + jr; const unsigned o = off_b(j, ch); *(LAS v4u*)(Kimg + o) = kv[p]; *(LAS v4u*)(Vimg + o) = vv[p]; }
          const AttnU a = attn_decode(u);
          if (tid < 129) btab[tid] = ((const float*)(ws + WS_BIAS))[(a.pi * 8 + a.h) * 129 + tid]; }
        __syncthreads();
        const int un = u + stride; const bool more = un < ATT_UNITS;
        if (more) attn_stage_load(ws, un, tid, kv, vv);
        attn_compute(lds, ws, u, tid);
        __syncthreads();
        if (!more) break;
        u = un;
    }
}
__device__ __forceinline__ void attn_compute(LAS unsigned char* lds, unsigned char* ws, int unit, int tid) {
    const int lane = tid & 63, w = __builtin_amdgcn_readfirstlane(tid >> 6);
    const AttnU a_ = attn_decode(unit); const int pi = a_.pi, n = a_.n, h = a_.h, r = a_.r, b = a_.b, d = a_.d;
    const bf16* Qg = (const bf16*)(ws + WS_Q);
    LAS unsigned char* Kimg = lds; LAS unsigned char* Vimg = lds + 65536; LAS float* btab = (LAS float*)(lds + LDS_X_OFF);
    const int q = lane & 15, g4 = lane >> 4, qi = 16 * w + q;
    const int rowq = n * SEQ + r + d * (128 * b + qi);
    bf16x8 qf[4];
#pragma unroll
    for (int s = 0; s < 4; ++s) qf[s] = *(const bf16x8*)(Qg + (size_t)rowq * AW + h * 128 + 32 * s + 8 * g4);
    const int ks0 = w >> 1;
    f32x4 sacc[5][2];
    {
        const int rr = lane & 15;
#pragma unroll
        for (int kb = 0; kb < 5; ++kb)
#pragma unroll
            for (int t = 0; t < 2; ++t) {
                const int j = 32 * (ks0 + kb) + 8 * (rr >> 2) + 4 * t + (rr & 3);
                f32x4 acc = (f32x4){0.f, 0.f, 0.f, 0.f};
#pragma unroll
                for (int s = 0; s < 4; ++s) { const bf16x8 kf = *(const LAS bf16x8*)(Kimg + off_b(j, 4 * s + g4)); acc = MFMA16(kf, qf[s], acc); }
                sacc[kb][t] = acc;
            }
    }
    float mx = -3.0e38f;
#pragma unroll
    for (int kb = 0; kb < 5; ++kb)
#pragma unroll
        for (int t = 0; t < 2; ++t)
#pragma unroll
            for (int i = 0; i < 4; ++i) {
                const int j = 32 * (ks0 + kb) + 8 * g4 + 4 * t + i; const int delta = 128 + qi - j;
                const bool valid = (delta >= 0) && (delta <= 128) && (b > 0 || j >= 128);
                const int dc = delta < 0 ? 0 : (delta > 128 ? 128 : delta);
                const float sv = valid ? sacc[kb][t][i] + btab[dc] : -1.0e30f;
                sacc[kb][t][i] = sv; mx = fmaxf(mx, sv);
            }
    mx = fmaxf(mx, __shfl_xor(mx, 16)); mx = fmaxf(mx, __shfl_xor(mx, 32));
    float ls = 0.f;
    bf16x8 pf[5];
#pragma unroll
    for (int kb = 0; kb < 5; ++kb) {
        float p[8];
#pragma unroll
        for (int t = 0; t < 2; ++t)
#pragma unroll
            for (int i = 0; i < 4; ++i) { p[4 * t + i] = __builtin_amdgcn_exp2f(sacc[kb][t][i] - mx); ls += p[4 * t + i]; }
        v4u pk; pk.x = cvtpk(p[0], p[1]); pk.y = cvtpk(p[2], p[3]); pk.z = cvtpk(p[4], p[5]); pk.w = cvtpk(p[6], p[7]);
        pf[kb] = __builtin_bit_cast(bf16x8, pk);
    }
    ls += __shfl_xor(ls, 16); ls += __shfl_xor(ls, 32);
    const float inv = 1.0f / ls;
    bf16* Og = (bf16*)(ws + WS_OBUF) + ((size_t)pi * MP + rowq) * AW + h * 128;
#pragma unroll
    for (int c = 0; c < 8; ++c) {
        f32x4 oacc = (f32x4){0.f, 0.f, 0.f, 0.f};
#pragma unroll
        for (int kb = 0; kb < 5; ++kb) {
            const s16x4 lo = vtr((lds_cptr)(Vimg + tr_addr16(lane, c, ks0 + kb, 0))), hi = vtr((lds_cptr)(Vimg + tr_addr16(lane, c, ks0 + kb, 1)));
            const bf16x8 vf = __builtin_shufflevector(lo, hi, 0, 1, 2, 3, 4, 5, 6, 7);
            oacc = MFMA16(vf, pf[kb], oacc);
        }
        v2u ow; ow.x = cvtpk(oacc[0] * inv, oacc[1] * inv); ow.y = cvtpk(oacc[2] * inv, oacc[3] * inv);
        *(v2u*)(Og + 16 * c + 4 * g4) = ow;
    }
    if (g4 == 0) ((float*)(ws + WS_LSE))[((size_t)pi * MP + rowq) * 8 + h] = mx + __builtin_amdgcn_logf(ls);
}

__device__ __forceinline__ void attn_sample_task(unsigned char* ws, const float* const* inp, float* out, int l, int task, int lane) {
    const int rs_ = task >> 3, h = task & 7, n = rs_ >> 3, t = rs_ & 7, row = MP + rs_;
    const unsigned qw = ((const unsigned*)((const bf16*)(ws + WS_Q) + (size_t)row * AW + h * 128))[lane];
    const float q0 = bf_lo(qw), q1 = bf_hi(qw);
    float m = -3.0e38f, ls = 0.f, o0 = 0.f, o1 = 0.f;
#pragma nounroll
    for (int pi = 0; pi < 3; ++pi) {
        const int d = 1 << (2 * pi);
        const float* bt = (const float*)(ws + WS_BIAS) + (pi * 8 + h) * 129;
#pragma nounroll
        for (int jj = 0; jj <= 128; ++jj) {
            const int idx = 2048 + t - jj * d; const float *kp, *vp;
            if (idx < 2048) { const size_t off = ((((size_t)l * 8 + n) * 2048 + idx) * 8 + h) * 128; kp = inp[I_CK] + off; vp = inp[I_CV] + off; }
            else { const size_t off = (((size_t)l * 8 + n) * 8 + (idx - 2048)) * 1024 + h * 128; kp = out + O_NKS + off; vp = out + O_NVS + off; }
            const f32x2v kk = ((const f32x2v*)kp)[lane], vv = ((const f32x2v*)vp)[lane];
            const float s = wave_sum(q0 * kk.x + q1 * kk.y) + bt[jj];
            const float mn = fmaxf(m, s), al = exp2f(m - mn), p = exp2f(s - mn);
            ls = ls * al + p; o0 = o0 * al + p * vv.x; o1 = o1 * al + p * vv.y; m = mn;
        }
    }
    const float inv = 1.0f / ls; f32x2v ov; ov.x = o0 * inv; ov.y = o1 * inv;
    ((f32x2v*)((float*)(ws + WS_SATT) + (size_t)rs_ * AW + h * 128))[lane] = ov;
}

__device__ __forceinline__ void attn_combine_row(unsigned char* ws, const float* const* inp, int l, int row, int lane) {
    float o[16];
    if (row < MP) {
        const int h = lane >> 3; const float* L = (const float*)(ws + WS_LSE);
        const float l0 = L[((size_t)0 * MP + row) * 8 + h], l1 = L[((size_t)1 * MP + row) * 8 + h], l2 = L[((size_t)2 * MP + row) * 8 + h];
        const float mm = fmaxf(l0, fmaxf(l1, l2)); float w0 = exp2f(l0 - mm), w1 = exp2f(l1 - mm), w2 = exp2f(l2 - mm);
        const float is = 1.0f / (w0 + w1 + w2); w0 *= is; w1 *= is; w2 *= is;
        const bf16* O = (const bf16*)(ws + WS_OBUF);
#pragma unroll
        for (int half = 0; half < 2; ++half) {
            const v4u a = *(const v4u*)(O + ((size_t)0 * MP + row) * AW + 16 * lane + 8 * half), b = *(const v4u*)(O + ((size_t)1 * MP + row) * AW + 16 * lane + 8 * half),
                      c = *(const v4u*)(O + ((size_t)2 * MP + row) * AW + 16 * lane + 8 * half);
            o[8 * half + 0] = w0 * bf_lo(a.x) + w1 * bf_lo(b.x) + w2 * bf_lo(c.x); o[8 * half + 1] = w0 * bf_hi(a.x) + w1 * bf_hi(b.x) + w2 * bf_hi(c.x);
            o[8 * half + 2] = w0 * bf_lo(a.y) + w1 * bf_lo(b.y) + w2 * bf_lo(c.y); o[8 * half + 3] = w0 * bf_hi(a.y) + w1 * bf_hi(b.y) + w2 * bf_hi(c.y);
            o[8 * half + 4] = w0 * bf_lo(a.z) + w1 * bf_lo(b.z) + w2 * bf_lo(c.z); o[8 * half + 5] = w0 * bf_hi(a.z) + w1 * bf_hi(b.z) + w2 * bf_hi(c.z);
            o[8 * half + 6] = w0 * bf_lo(a.w) + w1 * bf_lo(b.w) + w2 * bf_lo(c.w); o[8 * half + 7] = w0 * bf_hi(a.w) + w1 * bf_hi(b.w) + w2 * bf_hi(c.w);
        }
    } else {
        const f32x4* S = (const f32x4*)((const float*)(ws + WS_SATT) + (size_t)(row - MP) * AW + 16 * lane);
#pragma unroll
        for (int k = 0; k < 4; ++k) { const f32x4 v = S[k]; o[4 * k] = v.x; o[4 * k + 1] = v.y; o[4 * k + 2] = v.z; o[4 * k + 3] = v.w; }
    }
    float ss = 0.f;
#pragma unroll
    for (int k = 0; k < 16; ++k) ss += o[k] * o[k];
    const float r = 1.0f / sqrtf(wave_sum(ss) * (1.0f / AW) + EPS);
    const f32x4* g = (const f32x4*)(inp[I_GMIXOUT] + l * DM + 16 * lane);
    v4u w0, w1; const f32x4 g0 = g[0], g1 = g[1], g2 = g[2], g3 = g[3];
    w0.x = pk2(o[0] * r * g0.x, o[1] * r * g0.y); w0.y = pk2(o[2] * r * g0.z, o[3] * r * g0.w); w0.z = pk2(o[4] * r * g1.x, o[5] * r * g1.y); w0.w = pk2(o[6] * r * g1.z, o[7] * r * g1.w);
    w1.x = pk2(o[8] * r * g2.x, o[9] * r * g2.y); w1.y = pk2(o[10] * r * g2.z, o[11] * r * g2.w); w1.z = pk2(o[12] * r * g3.x, o[13] * r * g3.y); w1.w = pk2(o[14] * r * g3.z, o[15] * r * g3.w);
    v4u* dst = (v4u*)((bf16*)(ws + WS_MIX) + (size_t)row * DM + 16 * lane); dst[0] = w0; dst[1] = w1;
}

constexpr int XW_STRIDE = 528, XW_BYTES = 16 * XW_STRIDE;
__device__ __forceinline__ void ssm_pass1_unit(LAS unsigned char* xw, unsigned char* ws, int l, int wu, int lane) {
    const int g = wu & 31, sc = (wu >> 5) & 15, n = wu >> 9, q = lane & 15, g4 = lane >> 4;
    const bf16* BB = (const bf16*)(ws + WS_BBF) + ((size_t)(l * 32 + g) * 8) * 512;
    bf16x8 bb[8];
#pragma unroll
    for (int mt = 0; mt < 8; ++mt) bb[mt] = *(const bf16x8*)(BB + (mt * 64 + lane) * 8);
    const float* ap = (const float*)(ws + WS_AP) + ((size_t)(l * 32 + g) * 64 + lane) * 8;
    const float are = ap[0], aim = ap[1];
    float hr = 0.f, hi_ = 0.f;
    const bf16* U = (const bf16*)(ws + WS_U); float* SL = (float*)(ws + WS_SLOC);
    const bf16* up = U + (size_t)(n * SEQ + sc * 256 + q) * SW + g * 16 + 8 * (g4 & 1);
    bf16x8 ufn = *(const bf16x8*)up;
#pragma nounroll
    for (int tt = 0; tt < 16; ++tt) {
        bf16x8 uf = ufn; if (g4 >= 2) uf = (bf16x8){0, 0, 0, 0, 0, 0, 0, 0};
        if (tt < 15) ufn = *(const bf16x8*)(up + (size_t)(tt + 1) * 16 * SW);
#pragma unroll
        for (int mt = 0; mt < 8; ++mt) { const f32x4 dd = MFMA16(bb[mt], uf, ((f32x4){0.f, 0.f, 0.f, 0.f})); *(LAS f32x4*)(xw + q * XW_STRIDE + (16 * mt + 4 * g4) * 4) = dd; }
        asm volatile("s_waitcnt lgkmcnt(0)" ::: "memory");
#pragma unroll
        for (int t = 0; t < 16; ++t) { const float xr = *(const LAS float*)(xw + t * XW_STRIDE + lane * 4), xi = *(const LAS float*)(xw + t * XW_STRIDE + 256 + lane * 4);
            const float nr = are * hr - aim * hi_ + xr, ni = are * hi_ + aim * hr + xi; hr = nr; hi_ = ni; }
        asm volatile("s_waitcnt lgkmcnt(0)" ::: "memory");
        if (tt & 1) { f32x2v e; e.x = hr; e.y = hi_; ((f32x2v*)SL)[((((size_t)n * 16 + sc) * 8 + (tt >> 1)) * 32 + g) * 64 + lane] = e; }
    }
}
constexpr int YB_OFF = 8 * XW_BYTES, YB_STRIDE = 1040, RED_OFF = YB_OFF + 32 * YB_STRIDE;
constexpr int SSM2_UNITS = 264;
__device__ __forceinline__ void ssm_pass2_unit(LAS unsigned char* lds, unsigned char* ws, const float* const* inp, float* out, int l, int unit, int tid) {
    const int lane = tid & 63, w = __builtin_amdgcn_readfirstlane(tid >> 6), q = lane & 15, g4 = lane >> 4;
    const bool samp = unit >= 256;
    const int n = samp ? unit - 256 : unit >> 7, c32 = unit & 127;
    const int row0 = samp ? MP + n * 8 : n * SEQ + c32 * 32, ntile = samp ? 1 : 2;
    LAS unsigned char* xw = lds + w * XW_BYTES; LAS unsigned char* ybuf = lds + YB_OFF; LAS float* red = (LAS float*)(lds + RED_OFF);
    const bf16* U = (const bf16*)(ws + WS_U); const f32x2v* SL = (const f32x2v*)(ws + WS_SLOC);
#pragma nounroll
    for (int gi = 0; gi < 4; ++gi) {
        const int g = 4 * w + gi;
        const bf16* BB = (const bf16*)(ws + WS_BBF) + ((size_t)(l * 32 + g) * 8) * 512; const bf16* CFp = (const bf16*)(ws + WS_CF) + ((size_t)(l * 32 + g) * 4) * 512;
        const float* ap = (const float*)(ws + WS_AP) + ((size_t)(l * 32 + g) * 64 + lane) * 8;
        const int sc = c32 >> 3, c2 = c32 & 7;
        const f32x4 ap0 = *(const f32x4*)ap; const f32x2v ap1 = *(const f32x2v*)(ap + 4);
        f32x2v es[15]; f32x2v e1 = (f32x2v){0.f, 0.f}; float hr = 0.f, hi_ = 0.f;
        if (!samp) {
#pragma unroll
            for (int s2 = 0; s2 < 15; ++s2) { es[s2] = (f32x2v){0.f, 0.f}; if (s2 < sc) es[s2] = SL[((((size_t)n * 16 + s2) * 8 + 7) * 32 + g) * 64 + lane]; }
            if (c2 > 0) e1 = SL[((((size_t)n * 16 + sc) * 8 + (c2 - 1)) * 32 + g) * 64 + lane];
        } else { hr = inp[I_SRE][(((size_t)l * 8 + n) * 32 + g) * 64 + lane]; hi_ = inp[I_SIM][(((size_t)l * 8 + n) * 32 + g) * 64 + lane]; }
        bf16x8 bb[8], cf[4];
#pragma unroll
        for (int mt = 0; mt < 8; ++mt) bb[mt] = *(const bf16x8*)(BB + (mt * 64 + lane) * 8);
#pragma unroll
        for (int ks = 0; ks < 4; ++ks) cf[ks] = *(const bf16x8*)(CFp + (ks * 64 + lane) * 8);
        bf16x8 uf2[2]; v2u uw2[2];
#pragma unroll
        for (int tt = 0; tt < 2; ++tt) { uf2[tt] = *(const bf16x8*)(U + (size_t)(row0 + tt * 16 + q) * SW + g * 16 + 8 * (g4 & 1)); uw2[tt] = *(const v2u*)(U + (size_t)(row0 + tt * 16 + q) * SW + 16 * g + 4 * g4); }
        const f32x4 dsk = *(const f32x4*)(inp[I_SSMD] + l * SW + 16 * g + 4 * g4);
        const float are = ap0.x, aim = ap0.y;
        if (!samp) {
            const float a32r = ap0.z, a32i = ap0.w, a256r = ap1.x, a256i = ap1.y;
#pragma unroll
            for (int s2 = 0; s2 < 15; ++s2) { if (s2 < sc) { const float nr = a256r * hr - a256i * hi_ + es[s2].x, ni = a256r * hi_ + a256i * hr + es[s2].y; hr = nr; hi_ = ni; } }
#pragma nounroll
            for (int k = 0; k < c2; ++k) { const float nr = a32r * hr - a32i * hi_, ni = a32r * hi_ + a32i * hr; hr = nr; hi_ = ni; }
            hr += e1.x; hi_ += e1.y;
        }
#pragma unroll
        for (int tt = 0; tt < 2; ++tt) {
            if (tt < ntile) {
            bf16x8 uf = uf2[tt]; if (g4 >= 2) uf = (bf16x8){0, 0, 0, 0, 0, 0, 0, 0};
#pragma unroll
            for (int mt = 0; mt < 8; ++mt) { const f32x4 dd = MFMA16(bb[mt], uf, ((f32x4){0.f, 0.f, 0.f, 0.f})); *(LAS f32x4*)(xw + q * XW_STRIDE + (16 * mt + 4 * g4) * 4) = dd; }
            asm volatile("s_waitcnt lgkmcnt(0)" ::: "memory");
#pragma unroll
            for (int t = 0; t < 16; ++t) { const float xr = *(const LAS float*)(xw + t * XW_STRIDE + lane * 4), xi = *(const LAS float*)(xw + t * XW_STRIDE + 256 + lane * 4);
                const float nr = are * hr - aim * hi_ + xr, ni = are * hi_ + aim * hr + xi; hr = nr; hi_ = ni;
                asm volatile("" ::: "memory");
                *(LAS bf16*)(xw + t * XW_STRIDE + lane * 2) = (bf16)f2bf(hr); *(LAS bf16*)(xw + t * XW_STRIDE + 128 + lane * 2) = (bf16)f2bf(hi_);
                if (samp && t == 7) { out[O_SRS + (((size_t)l * 8 + n) * 32 + g) * 64 + lane] = hr; out[O_SIS + (((size_t)l * 8 + n) * 32 + g) * 64 + lane] = hi_; } }
            asm volatile("s_waitcnt lgkmcnt(0)" ::: "memory");
            f32x4 yacc = (f32x4){0.f, 0.f, 0.f, 0.f};
#pragma unroll
            for (int ks = 0; ks < 4; ++ks) { const bf16x8 hf = *(const LAS bf16x8*)(xw + q * XW_STRIDE + (32 * ks + 8 * g4) * 2); yacc = MFMA16(cf[ks], hf, yacc); }
            const v2u uw = uw2[tt];
            const float y0 = yacc[0] + dsk.x * bf_lo(uw.x), y1 = yacc[1] + dsk.y * bf_hi(uw.x), y2 = yacc[2] + dsk.z * bf_lo(uw.y), y3 = yacc[3] + dsk.w * bf_hi(uw.y);
            v2u yw; yw.x = cvtpk(y0, y1); yw.y = cvtpk(y2, y3);
            *(LAS v2u*)(ybuf + (tt * 16 + q) * YB_STRIDE + (16 * g + 4 * g4) * 2) = yw;
            asm volatile("s_waitcnt lgkmcnt(0)" ::: "memory");
            }
        }
        if (!samp && c32 == 127) { out[O_SRP + (((size_t)l * 2 + n) * 32 + g) * 64 + lane] = hr; out[O_SIP + (((size_t)l * 2 + n) * 32 + g) * 64 + lane] = hi_; }
    }
    __syncthreads();
    f32x4 acc[2][4];
#pragma unroll
    for (int mt = 0; mt < 2; ++mt)
#pragma unroll
        for (int nt = 0; nt < 4; ++nt) acc[mt][nt] = (f32x4){0.f, 0.f, 0.f, 0.f};
    const bf16* Wg = (const bf16*)(ws + WS_WGLU) + (size_t)l * 512 * 512;
#pragma unroll 4
    for (int ks = 0; ks < 16; ++ks) {
        bf16x8 af[2];
#pragma unroll
        for (int mt = 0; mt < 2; ++mt) af[mt] = *(const LAS bf16x8*)(ybuf + (16 * mt + q) * YB_STRIDE + (32 * ks + 8 * g4) * 2);
#pragma unroll
        for (int nt = 0; nt < 4; ++nt) { const bf16x8 bfr = *(const bf16x8*)(Wg + (size_t)(64 * w + 16 * nt + q) * 512 + 32 * ks + 8 * g4);
#pragma unroll
            for (int mt = 0; mt < 2; ++mt) acc[mt][nt] = MFMA16(bfr, af[mt], acc[mt][nt]); }
    }
#pragma unroll
    for (int mt = 0; mt < 2; ++mt) { const int t = 16 * mt + q; float ss = 0.f;
#pragma unroll
        for (int nt = 0; nt < 4; ++nt) { const int n0 = 64 * w + 16 * nt + 4 * g4; const f32x4 bg = *(const f32x4*)(inp[I_BGLU] + l * SW + n0);
            const v2u yw = *(const LAS v2u*)(ybuf + t * YB_STRIDE + n0 * 2);
            f32x4 o; o.x = bf_lo(yw.x) * pg8::fast_sigmoid(acc[mt][nt].x + bg.x); o.y = bf_hi(yw.x) * pg8::fast_sigmoid(acc[mt][nt].y + bg.y);
            o.z = bf_lo(yw.y) * pg8::fast_sigmoid(acc[mt][nt].z + bg.z); o.w = bf_hi(yw.y) * pg8::fast_sigmoid(acc[mt][nt].w + bg.w);
            acc[mt][nt] = o; ss += (o.x * o.x + o.y * o.y) + (o.z * o.z + o.w * o.w); }
        ss += __shfl_xor(ss, 16); ss += __shfl_xor(ss, 32);
        if (g4 == 0) red[t * 8 + w] = ss; }
    __syncthreads();
#pragma unroll
    for (int mt = 0; mt < 2; ++mt) { const int t = 16 * mt + q; const LAS f32x4* rp = (const LAS f32x4*)(red + t * 8); const f32x4 r0 = rp[0], r1 = rp[1];
        const float r = 1.0f / sqrtf(((r0.x + r0.y) + (r0.z + r0.w) + (r1.x + r1.y) + (r1.z + r1.w)) * (1.0f / SW) + EPS);
        const bool valid = !samp || t < 8;
        if (valid) {
#pragma unroll
            for (int nt = 0; nt < 4; ++nt) { const int n0 = 64 * w + 16 * nt + 4 * g4; const f32x4 gg = *(const f32x4*)(inp[I_GMIXOUT] + l * DM + 1024 + n0);
                v2u ow; ow.x = cvtpk(acc[mt][nt].x * r * gg.x, acc[mt][nt].y * r * gg.y); ow.y = cvtpk(acc[mt][nt].z * r * gg.z, acc[mt][nt].w * r * gg.w);
                *(v2u*)((bf16*)(ws + WS_MIX) + (size_t)(row0 + t) * DM + 1024 + n0) = ow; } } }
    __syncthreads();
}

constexpr int SGU_UNITS = 72, SGU_RED_OFF = LDS_X_OFF + 1024;
__device__ __forceinline__ void sgu_unit(LAS unsigned char* lds, unsigned char* ws, const float* const* inp, float* out, int l, int unit, int tid) {
    const int lane = tid & 63, w = __builtin_amdgcn_readfirstlane(tid >> 6), q = lane & 15, g4 = lane >> 4;
    const bool samp = unit >= 64;
    const int row0 = samp ? MP + 8 * (unit - 64) : (unit >> 5) * SEQ + (unit & 31) * 128, nrows = samp ? 8 : 128;
    LAS float* red = (LAS float*)(lds + SGU_RED_OFF);
    {
        const bf16* GVg = (const bf16*)(ws + WS_GV); const f32x4* sgp = (const f32x4*)(inp[I_SGUG] + l * GW + 8 * lane); const f32x4 sg0 = sgp[0], sg1 = sgp[1];
#pragma unroll 4
        for (int k = 0; k < 16; ++k) { const int s = w + 8 * k; v4u pk = (v4u){0u, 0u, 0u, 0u};
            if (s < nrows) { const v4u raw = *(const v4u*)(GVg + (size_t)(row0 + s) * GW + 8 * lane);
                float x[8] = {bf_lo(raw.x), bf_hi(raw.x), bf_lo(raw.y), bf_hi(raw.y), bf_lo(raw.z), bf_hi(raw.z), bf_lo(raw.w), bf_hi(raw.w)};
                float sm = 0.f;
#pragma unroll
                for (int j = 0; j < 8; ++j) sm += x[j];
                const float mean = wave_sum(sm) * (1.0f / GW); float qq = 0.f;
#pragma unroll
                for (int j = 0; j < 8; ++j) { x[j] -= mean; qq += x[j] * x[j]; }
                const float rstd = 1.0f / sqrtf(wave_sum(qq) * (1.0f / GW) + EPS);
                x[0] *= rstd * sg0.x; x[1] *= rstd * sg0.y; x[2] *= rstd * sg0.z; x[3] *= rstd * sg0.w; x[4] *= rstd * sg1.x; x[5] *= rstd * sg1.y; x[6] *= rstd * sg1.z; x[7] *= rstd * sg1.w;
                if (samp) { f32x4* od = (f32x4*)(out + O_SGV + ((size_t)l * 64 + (row0 + s - MP)) * GW + 8 * lane); od[0] = (f32x4){x[0], x[1], x[2], x[3]}; od[1] = (f32x4){x[4], x[5], x[6], x[7]}; }
                pk.x = pk2(x[0], x[1]); pk.y = pk2(x[2], x[3]); pk.z = pk2(x[4], x[5]); pk.w = pk2(x[6], x[7]); }
            *(LAS v4u*)(lds + (lane >> 4) * 32768 + off_b(s, lane & 15)) = pk; }
    }
    __syncthreads();
    const int hh = w >> 1, th = w & 1;
    LAS unsigned char* img = lds + hh * 32768;
    const bf16* Wm = (const bf16*)(ws + WS_WM) + ((size_t)(l * 4 + hh) * 128) * 128;
    const bf16* GUg = (const bf16*)(ws + WS_GU);
#pragma nounroll
    for (int mp = 0; mp < 2; ++mp) {
        f32x4 acc[2][8];
#pragma unroll
        for (int m2 = 0; m2 < 2; ++m2)
#pragma unroll
            for (int c = 0; c < 8; ++c) acc[m2][c] = (f32x4){0.f, 0.f, 0.f, 0.f};
#pragma nounroll
        for (int ks = 0; ks <= 2 * th + mp; ++ks) {
            bf16x8 gf[8];
#pragma unroll
            for (int c = 0; c < 8; ++c) { const s16x4 lo = vtr((lds_cptr)(img + tr_addr16(lane, c, ks, 0))), hi = vtr((lds_cptr)(img + tr_addr16(lane, c, ks, 1))); gf[c] = __builtin_shufflevector(lo, hi, 0, 1, 2, 3, 4, 5, 6, 7); }
#pragma unroll
            for (int m2 = 0; m2 < 2; ++m2) { const bf16x8 wf = *(const bf16x8*)(Wm + (size_t)(64 * th + 32 * mp + 16 * m2 + q) * 128 + 32 * ks + 8 * g4);
#pragma unroll
                for (int c = 0; c < 8; ++c) acc[m2][c] = MFMA16(gf[c], wf, acc[m2][c]); }
        }
#pragma unroll
        for (int m2 = 0; m2 < 2; ++m2) { const int tl = 64 * th + 32 * mp + 16 * m2 + q; const bool valid = tl < nrows; const float bias = inp[I_SGUB][((size_t)l * 4 + hh) * 128 + tl]; float ss = 0.f;
#pragma unroll
            for (int c = 0; c < 8; ++c) { v2u gw2 = (v2u){0u, 0u}; if (valid) gw2 = *(const v2u*)(GUg + (size_t)(row0 + tl) * GW + hh * 128 + 16 * c + 4 * g4);
                v2u ow; ow.x = cvtpk(bf_lo(gw2.x) * (acc[m2][c].x + bias), bf_hi(gw2.x) * (acc[m2][c].y + bias)); ow.y = cvtpk(bf_lo(gw2.y) * (acc[m2][c].z + bias), bf_hi(gw2.y) * (acc[m2][c].w + bias));
                const float o0 = bf_lo(ow.x), o1 = bf_hi(ow.x), o2 = bf_lo(ow.y), o3 = bf_hi(ow.y); ss += (o0 * o0 + o1 * o1) + (o2 * o2 + o3 * o3);
                if (valid) *(v2u*)((bf16*)(ws + WS_MIX) + (size_t)(row0 + tl) * DM + 1536 + hh * 128 + 16 * c + 4 * g4) = ow; }
            ss += __shfl_xor(ss, 16); ss += __shfl_xor(ss, 32);
            if (g4 == 0) red[tl * 4 + hh] = ss; }
    }
    __syncthreads();
#pragma nounroll
    for (int mt = 0; mt < 4; ++mt) { const int tl = 64 * th + 16 * mt + q; const f32x4 rr = *(const LAS f32x4*)(red + tl * 4);
        const float r = 1.0f / sqrtf(((rr.x + rr.y) + (rr.z + rr.w)) * (1.0f / GW) + EPS);
        if (tl < nrows) {
#pragma unroll
            for (int c = 0; c < 8; ++c) { const int ch = hh * 128 + 16 * c + 4 * g4; const f32x4 gg = *(const f32x4*)(inp[I_GMIXOUT] + l * DM + 1536 + ch);
                v2u* mp_ = (v2u*)((bf16*)(ws + WS_MIX) + (size_t)(row0 + tl) * DM + 1536 + ch); const v2u ow = *mp_;
                v2u nw; nw.x = cvtpk(bf_lo(ow.x) * r * gg.x, bf_hi(ow.x) * r * gg.y); nw.y = cvtpk(bf_lo(ow.y) * r * gg.z, bf_hi(ow.y) * r * gg.w); *mp_ = nw; } } }
    __syncthreads();
}

template <int K>
__device__ __forceinline__ void sample_gemm_n2048(LAS unsigned char* lds, const bf16* A  , const bf16* Wt  , float* T, int c, int tid) {
    const int lane = tid & 63, w = __builtin_amdgcn_readfirstlane(tid >> 6), q = lane & 15, g4 = lane >> 4;
    constexpr int KW = K / 8, NKS = KW / 32;
    const bf16* wp = Wt + (size_t)(8 * c + (q & 7)) * K + w * KW + 8 * g4;
    const bf16* ap = A + (size_t)q * K + w * KW + 8 * g4;
    f32x4 acc[4];
#pragma unroll
    for (int mt = 0; mt < 4; ++mt) acc[mt] = (f32x4){0.f, 0.f, 0.f, 0.f};
#pragma unroll 2
    for (int ks = 0; ks < NKS; ++ks) {
        const bf16x8 wf = *(const bf16x8*)(wp + 32 * ks);
#pragma unroll
        for (int mt = 0; mt < 4; ++mt) { const bf16x8 af = *(const bf16x8*)(ap + (size_t)(16 * mt) * K + 32 * ks); acc[mt] = MFMA16(wf, af, acc[mt]); }
    }
    LAS f32x4* part = (LAS f32x4*)lds;
#pragma unroll
    for (int mt = 0; mt < 4; ++mt) part[(w * 4 + mt) * 64 + lane] = acc[mt];
    __syncthreads();
    if (w < 4 && g4 < 2) { f32x4 s = part[(0 * 4 + w) * 64 + lane];
#pragma unroll
        for (int ww = 1; ww < 8; ++ww) s += part[(ww * 4 + w) * 64 + lane];
        *(f32x4*)(T + (size_t)(MP + 16 * w + q) * DM + 8 * c + 4 * g4) = s; }
    __syncthreads();
}

constexpr int SATT_LDS_PER_WAVE = 4096;
__device__ __forceinline__ const float* samp_row_ptr(const float* cache, const float* fresh, int l, int n, int t, int h, int kk) {
    const int pi = kk >= 258 ? 2 : (kk >= 129 ? 1 : 0), jj = kk - 129 * pi, idx = 2048 + t - (jj << (2 * pi));
    return (idx < 2048) ? cache + ((((size_t)l * 8 + n) * 2048 + idx) * 8 + h) * 128 : fresh + (((size_t)l * 8 + n) * 8 + (idx - 2048)) * 1024 + h * 128;
}
__device__ __forceinline__ void attn_sample_task2(LAS unsigned char* ldsw, unsigned char* ws, const float* const* inp, float* out, int l, int task, int lane) {
    const int rs_ = task >> 3, h = task & 7, n = rs_ >> 3, t = rs_ & 7, row = MP + rs_;
    const int kg = lane >> 4, e0 = 8 * (lane & 15);
    LAS float* sc = (LAS float*)ldsw;
    float qv[8];
    { const v4u qw = *(const v4u*)((const bf16*)(ws + WS_Q) + (size_t)row * AW + h * 128 + e0);
      qv[0] = bf_lo(qw.x); qv[1] = bf_hi(qw.x); qv[2] = bf_lo(qw.y); qv[3] = bf_hi(qw.y); qv[4] = bf_lo(qw.z); qv[5] = bf_hi(qw.z); qv[6] = bf_lo(qw.w); qv[7] = bf_hi(qw.w); }
    const float* ck = inp[I_CK]; const float* cv = inp[I_CV]; const float* fk = out + O_NKS; const float* fv = out + O_NVS;
    const float* bt = (const float*)(ws + WS_BIAS);
#pragma unroll 4
    for (int it = 0; it < 97; ++it) {
        const int kk = 4 * it + kg, kc = kk < 387 ? kk : 386;
        const f32x4* kp = (const f32x4*)(samp_row_ptr(ck, fk, l, n, t, h, kc) + e0);
        const f32x4 k0 = kp[0], k1 = kp[1];
        float dsum = (qv[0] * k0.x + qv[1] * k0.y) + (qv[2] * k0.z + qv[3] * k0.w) + (qv[4] * k1.x + qv[5] * k1.y) + (qv[6] * k1.z + qv[7] * k1.w);
        dsum += __shfl_xor(dsum, 1); dsum += __shfl_xor(dsum, 2); dsum += __shfl_xor(dsum, 4); dsum += __shfl_xor(dsum, 8);
        const int pi = kc >= 258 ? 2 : (kc >= 129 ? 1 : 0), jj = kc - 129 * pi;
        if ((lane & 15) == 0 && kk < 387) sc[kk] = dsum + bt[(pi * 8 + h) * 129 + jj];
    }
    asm volatile("s_waitcnt lgkmcnt(0)" ::: "memory");
    float sv[7]; float m = -3.0e38f;
#pragma unroll
    for (int c = 0; c < 7; ++c) { const int kk = lane + 64 * c; sv[c] = kk < 387 ? sc[kk] : -3.0e38f; m = fmaxf(m, sv[c]); }
#pragma unroll
    for (int o = 1; o < 64; o <<= 1) m = fmaxf(m, __shfl_xor(m, o));
    float ls = 0.f;
#pragma unroll
    for (int c = 0; c < 7; ++c) { const int kk = lane + 64 * c; const float p = kk < 387 ? __builtin_amdgcn_exp2f(sv[c] - m) : 0.f; ls += p; if (kk < 387) sc[kk] = p; }
    ls = wave_sum(ls);
    asm volatile("s_waitcnt lgkmcnt(0)" ::: "memory");
    float o[8];
#pragma unroll
    for (int j = 0; j < 8; ++j) o[j] = 0.f;
#pragma unroll 4
    for (int it = 0; it < 97; ++it) {
        const int kk = 4 * it + kg, kc = kk < 387 ? kk : 386;
        const f32x4* vp = (const f32x4*)(samp_row_ptr(cv, fv, l, n, t, h, kc) + e0);
        const f32x4 v0 = vp[0], v1 = vp[1]; const float p = kk < 387 ? sc[kc] : 0.f;
        o[0] += p * v0.x; o[1] += p * v0.y; o[2] += p * v0.z; o[3] += p * v0.w; o[4] += p * v1.x; o[5] += p * v1.y; o[6] += p * v1.z; o[7] += p * v1.w;
    }
    const float inv = 1.0f / ls;
#pragma unroll
    for (int j = 0; j < 8; ++j) { o[j] += __shfl_xor(o[j], 16); o[j] += __shfl_xor(o[j], 32); o[j] *= inv; }
    if (lane < 16) { f32x4* od = (f32x4*)((float*)(ws + WS_SATT) + (size_t)rs_ * AW + h * 128 + e0); od[0] = (f32x4){o[0], o[1], o[2], o[3]}; od[1] = (f32x4){o[4], o[5], o[6], o[7]}; }
}

__device__ __forceinline__ void attn_sample_wg(LAS unsigned char* lds, unsigned char* ws, const float* const* inp, float* out, int l, int task, int tid) {
    const int lane = tid & 63, w = __builtin_amdgcn_readfirstlane(tid >> 6);
    const int rs_ = task >> 3, h = task & 7, n = rs_ >> 3, t = rs_ & 7, row = MP + rs_;
    const int e0 = 8 * (lane & 15), grp = w * 4 + (lane >> 4);
    float qv[8];
    { const v4u qw = *(const v4u*)((const bf16*)(ws + WS_Q) + (size_t)row * AW + h * 128 + e0);
      qv[0] = bf_lo(qw.x); qv[1] = bf_hi(qw.x); qv[2] = bf_lo(qw.y); qv[3] = bf_hi(qw.y); qv[4] = bf_lo(qw.z); qv[5] = bf_hi(qw.z); qv[6] = bf_lo(qw.w); qv[7] = bf_hi(qw.w); }
    const float* ck = inp[I_CK]; const float* cv = inp[I_CV]; const float* fk = out + O_NKS; const float* fv = out + O_NVS;
    const float* bt = (const float*)(ws + WS_BIAS);
    float m = -3.0e38f, ls = 0.f, o[8];
#pragma unroll
    for (int j = 0; j < 8; ++j) o[j] = 0.f;
#pragma unroll 4
    for (int it = 0; it < 13; ++it) {
        const int kk = grp + 32 * it; const bool valid = kk < 387; const int kc = valid ? kk : 386;
        const f32x4* kp = (const f32x4*)(samp_row_ptr(ck, fk, l, n, t, h, kc) + e0); const f32x4* vp = (const f32x4*)(samp_row_ptr(cv, fv, l, n, t, h, kc) + e0);
        const f32x4 k0 = kp[0], k1 = kp[1], v0 = vp[0], v1 = vp[1];
        float dsum = (qv[0] * k0.x + qv[1] * k0.y) + (qv[2] * k0.z + qv[3] * k0.w) + (qv[4] * k1.x + qv[5] * k1.y) + (qv[6] * k1.z + qv[7] * k1.w);
        dsum += __shfl_xor(dsum, 1); dsum += __shfl_xor(dsum, 2); dsum += __shfl_xor(dsum, 4); dsum += __shfl_xor(dsum, 8);
        const int pi = kc >= 258 ? 2 : (kc >= 129 ? 1 : 0), jj = kc - 129 * pi;
        const float s = valid ? dsum + bt[(pi * 8 + h) * 129 + jj] : -3.0e38f;
        const float mn = fmaxf(m, s), al = __builtin_amdgcn_exp2f(m - mn), p = valid ? __builtin_amdgcn_exp2f(s - mn) : 0.f;
        ls = ls * al + p; m = mn;
        o[0] = o[0] * al + p * v0.x; o[1] = o[1] * al + p * v0.y; o[2] = o[2] * al + p * v0.z; o[3] = o[3] * al + p * v0.w;
        o[4] = o[4] * al + p * v1.x; o[5] = o[5] * al + p * v1.y; o[6] = o[6] * al + p * v1.z; o[7] = o[7] * al + p * v1.w;
    }
    LAS float* pml = (LAS float*)lds;
    LAS float* po = (LAS float*)(lds + 256);
    if ((lane & 15) == 0) { pml[2 * grp] = m; pml[2 * grp + 1] = ls; }
    { LAS f32x4* pd = (LAS f32x4*)(po + grp * 128 + e0); pd[0] = (f32x4){o[0], o[1], o[2], o[3]}; pd[1] = (f32x4){o[4], o[5], o[6], o[7]}; }
    __syncthreads();
    if (tid < 128) {
        float M = -3.0e38f;
#pragma unroll
        for (int i = 0; i < 32; ++i) M = fmaxf(M, pml[2 * i]);
        float L = 0.f, O = 0.f;
#pragma unroll
        for (int i = 0; i < 32; ++i) { const float sc = __builtin_amdgcn_exp2f(pml[2 * i] - M); L += pml[2 * i + 1] * sc; O += po[i * 128 + tid] * sc; }
        ((float*)(ws + WS_SATT))[(size_t)rs_ * AW + h * 128 + tid] = O / L;
    }
    __syncthreads();
}

__device__ __forceinline__ void attn_row_naive(Frame& F, int l, int row) {
    const int lane = F.lane; const bool samp = row >= MP;
    const int n = samp ? ((row - MP) >> 3) : (row >> 12), t = samp ? ((row - MP) & 7) : (row & 4095);
    float ssq = 0.f; float* tmp = F_WS(float, WS_T) + (size_t)row * DM;
#pragma nounroll
    for (int h = 0; h < 8; ++h) {
        const unsigned qw = ((const unsigned*)(F_WS(bf16, WS_Q) + (size_t)row * AW + h * 128))[lane];
        const float q0 = bf_lo(qw), q1 = bf_hi(qw);
        float m = -3.0e38f, ls = 0.f, o0 = 0.f, o1 = 0.f;
#pragma nounroll
        for (int pi = 0; pi < 3; ++pi) {
            const int d = pi == 0 ? 1 : (pi == 1 ? 4 : 16);
            const float* bt = F_WS(float, WS_BIAS) + (pi * 8 + h) * 129;
#pragma nounroll
            for (int jj = 0; jj <= 128; ++jj) {
                float k0, k1, v0, v1;
                if (!samp) { const int tk = t - jj * d; if (tk < 0) break;
                    const size_t off = ((size_t)(n * SEQ + tk)) * AW + h * 128;
                    const unsigned kw = ((const unsigned*)(F_WS(bf16, WS_K) + off))[lane], vw = ((const unsigned*)(F_WS(bf16, WS_V) + off))[lane];
                    k0 = bf_lo(kw); k1 = bf_hi(kw); v0 = bf_lo(vw); v1 = bf_hi(vw);
                } else { const int idx = 2048 + t - jj * d; const float *kp, *vp;
                    if (idx < 2048) { const size_t off = ((((size_t)l * 8 + n) * 2048 + idx) * 8 + h) * 128; kp = F_IN(I_CK) + off; vp = F_IN(I_CV) + off; }
                    else { const size_t off = (((size_t)l * 8 + n) * 8 + (idx - 2048)) * 1024 + h * 128; kp = F.out + O_NKS + off; vp = F.out + O_NVS + off; }
                    const f32x2v kk = ((const f32x2v*)kp)[lane], vv = ((const f32x2v*)vp)[lane]; k0 = kk.x; k1 = kk.y; v0 = vv.x; v1 = vv.y; }
                const float s = wave_sum(q0 * k0 + q1 * k1) + bt[jj];
                const float mn = fmaxf(m, s), al = exp2f(m - mn), p = exp2f(s - mn);
                ls = ls * al + p; o0 = o0 * al + p * v0; o1 = o1 * al + p * v1; m = mn;
            }
        }
        const float inv = 1.0f / ls; o0 *= inv; o1 *= inv; ssq += o0 * o0 + o1 * o1;
        f32x2v ov; ov.x = o0; ov.y = o1; ((f32x2v*)(tmp + h * 128))[lane] = ov;
    }
    const float r = 1.0f / sqrtf(wave_sum(ssq) * (1.0f / AW) + EPS);
    const float* g = F_IN(I_GMIXOUT) + l * DM;
#pragma nounroll
    for (int h = 0; h < 8; ++h) { const int col = h * 128 + 2 * lane; const f32x2v ov = ((const f32x2v*)(tmp + h * 128))[lane];
        ((unsigned*)(F_WS(bf16, WS_MIX) + (size_t)row * DM + col))[0] = pk2(ov.x * r * g[col], ov.y * r * g[col + 1]); }
}

__device__ __forceinline__ void ssm_seq_naive(Frame& F, int l, int seq, int g) {
    const int p = F.lane; const bool samp = seq >= 2; const int n = samp ? seq - 2 : seq;
    const int L = samp ? 8 : SEQ, row0 = samp ? MP + n * 8 : n * SEQ;
    const size_t gp = ((size_t)l * 32 + g) * 64 + p;
    const float lr = F_IN(I_LAMRE)[gp], li = F_IN(I_LAMIM)[gp], step = expf(F_IN(I_LOGSTEP)[l * 32 + g]);
    const float mag = expf(lr * step), are = mag * cosf(li * step), aim = mag * sinf(li * step);
    const float den = lr * lr + li * li, cre_ = ((are - 1.0f) * lr + aim * li) / den, cim_ = (aim * lr - (are - 1.0f) * li) / den;
    float bbr[16], bbi[16], ccr[16], cci[16];
#pragma unroll
    for (int c = 0; c < 16; ++c) { const float br = F_IN(I_BRE)[gp * 16 + c], bi = F_IN(I_BIM)[gp * 16 + c];
        bbr[c] = cre_ * br - cim_ * bi; bbi[c] = cre_ * bi + cim_ * br;
        ccr[c] = F_IN(I_CRE)[(((size_t)l * 32 + g) * 16 + c) * 64 + p]; cci[c] = F_IN(I_CIM)[(((size_t)l * 32 + g) * 16 + c) * 64 + p]; }
    float hr = 0.f, hi = 0.f;
    if (samp) { hr = F_IN(I_SRE)[(((size_t)l * 8 + n) * 32 + g) * 64 + p]; hi = F_IN(I_SIM)[(((size_t)l * 8 + n) * 32 + g) * 64 + p]; }
    const float dsk = (p < 16) ? F_IN(I_SSMD)[l * SW + g * 16 + p] : 0.f;
#pragma nounroll
    for (int t = 0; t < L; ++t) {
        const int row = row0 + t;
        const v4u ua = *(const v4u*)(F_WS(bf16, WS_U) + (size_t)row * SW + g * 16), ub = *(const v4u*)(F_WS(bf16, WS_U) + (size_t)row * SW + g * 16 + 8);
        float u[16];
        u[0] = bf_lo(ua.x); u[1] = bf_hi(ua.x); u[2] = bf_lo(ua.y); u[3] = bf_hi(ua.y); u[4] = bf_lo(ua.z); u[5] = bf_hi(ua.z); u[6] = bf_lo(ua.w); u[7] = bf_hi(ua.w);
        u[8] = bf_lo(ub.x); u[9] = bf_hi(ub.x); u[10] = bf_lo(ub.y); u[11] = bf_hi(ub.y); u[12] = bf_lo(ub.z); u[13] = bf_hi(ub.z); u[14] = bf_lo(ub.w); u[15] = bf_hi(ub.w);
        float xr = 0.f, xi = 0.f;
#pragma unroll
        for (int c = 0; c < 16; ++c) { xr += bbr[c] * u[c]; xi += bbi[c] * u[c]; }
        const float nhr = are * hr - aim * hi + xr, nhi = are * hi + aim * hr + xi; hr = nhr; hi = nhi;
        float ymine = 0.f;
#pragma unroll
        for (int c = 0; c < 16; ++c) { const float yc = wave_sum(ccr[c] * hr - cci[c] * hi) + 0.f; if (p == c) ymine = yc + dsk * u[c]; }
        if (p < 16) F_WS(float, WS_Y)[(size_t)row * SW + g * 16 + p] = ymine;
    }
    if (!samp) { F.out[O_SRP + (((size_t)l * 2 + n) * 32 + g) * 64 + p] = hr; F.out[O_SIP + (((size_t)l * 2 + n) * 32 + g) * 64 + p] = hi; }
    else { F.out[O_SRS + (((size_t)l * 8 + n) * 32 + g) * 64 + p] = hr; F.out[O_SIS + (((size_t)l * 8 + n) * 32 + g) * 64 + p] = hi; }
}

__device__ __forceinline__ void glu_row_naive(Frame& F, int l, int row) {
    const int lane = F.lane; const float* yrow = F_WS(float, WS_Y) + (size_t)row * SW; const float* W = F_IN(I_WGLU) + (size_t)l * SW * SW;
    float acc[8];
#pragma unroll
    for (int i = 0; i < 8; ++i) acc[i] = F_IN(I_BGLU)[l * SW + lane + 64 * i];
#pragma nounroll
    for (int k = 0; k < SW; ++k) { const float yk = yrow[k];
#pragma unroll
        for (int i = 0; i < 8; ++i) acc[i] += yk * W[(size_t)k * SW + lane + 64 * i]; }
    float o[8]; float ss = 0.f;
#pragma unroll
    for (int i = 0; i < 8; ++i) { o[i] = yrow[lane + 64 * i] * (1.0f / (1.0f + expf(-acc[i]))); ss += o[i] * o[i]; }
    const float r = 1.0f / sqrtf(wave_sum(ss) * (1.0f / SW) + EPS);
    const float* g = F_IN(I_GMIXOUT) + l * DM + 1024;
#pragma unroll
    for (int i = 0; i < 8; ++i) F_WS(bf16, WS_MIX)[(size_t)row * DM + 1024 + lane + 64 * i] = (bf16)f2bf(o[i] * r * g[lane + 64 * i]);
}

__device__ __forceinline__ void sgu_row_naive(Frame& F, int l, int row) {
    const int lane = F.lane; const bool samp = row >= MP;
    const int t = samp ? ((row - MP) & 7) : (row & 4095), tl = samp ? t : (t & 127), rowc = row - tl;
    float acc[8];
#pragma unroll
    for (int i = 0; i < 8; ++i) acc[i] = 0.f;
    const float* sg = F_IN(I_SGUG) + l * GW;
#pragma nounroll
    for (int sl = 0; sl <= tl; ++sl) {
        const int srow = rowc + sl; float xv[8]; float s = 0.f;
#pragma unroll
        for (int i = 0; i < 8; ++i) { xv[i] = bf2f(F_WS(bf16, WS_GV)[(size_t)srow * GW + lane + 64 * i]); s += xv[i]; }
        const float mean = wave_sum(s) * (1.0f / GW); float q = 0.f;
#pragma unroll
        for (int i = 0; i < 8; ++i) { xv[i] -= mean; q += xv[i] * xv[i]; }
        const float rstd = 1.0f / sqrtf(wave_sum(q) * (1.0f / GW) + EPS);
#pragma unroll
        for (int i = 0; i < 8; ++i) { const float gvv = xv[i] * rstd * sg[lane + 64 * i];
            const float w = F_IN(I_SGUW)[(((size_t)l * 4 + (i >> 1)) * 128 + tl) * 128 + sl];
            acc[i] += w * gvv;
            if (samp && sl == tl) F.out[O_SGV + ((size_t)l * 64 + (row - MP)) * GW + lane + 64 * i] = gvv; }
    }
    float o[8]; float ss = 0.f;
#pragma unroll
    for (int i = 0; i < 8; ++i) { const float mixed = acc[i] + F_IN(I_SGUB)[((size_t)l * 4 + (i >> 1)) * 128 + tl];
        o[i] = bf2f(F_WS(bf16, WS_GU)[(size_t)row * GW + lane + 64 * i]) * mixed; ss += o[i] * o[i]; }
    const float r = 1.0f / sqrtf(wave_sum(ss) * (1.0f / GW) + EPS);
    const float* g = F_IN(I_GMIXOUT) + l * DM + 1536;
#pragma unroll
    for (int i = 0; i < 8; ++i) F_WS(bf16, WS_MIX)[(size_t)row * DM + 1536 + lane + 64 * i] = (bf16)f2bf(o[i] * r * g[lane + 64 * i]);
}

struct ArgsN { const float* in[30]; float* out; unsigned char* ws; int l, pad; };
__global__ void __launch_bounds__(512) k_p2_naive(ArgsN a) {
    const int l = a.l, lane = threadIdx.x & 63, gw = blockIdx.x * 8 + (threadIdx.x >> 6), NGW = gridDim.x * 8; const float* const* inp = a.in; float* out = a.out; unsigned char* ws = a.ws;
    Frame F; F.lds = nullptr; F.MISC = nullptr; F.ctl = nullptr; F.tid = 0; F.lane = lane; F.wave = 0; F.vcu = 0; F.G = 0; F.inp = inp; F.out = out; F.ws = ws;
#if !FAST_SSM
    for (int k = gw; k < 320 * 6; k += NGW) if (k % 6 == 0) { const int task = k / 6; ssm_seq_naive(F, l, task / 32, task % 32); }
#endif
#if !FAST_ATTN
    for (int row = gw; row < MREAL; row += NGW) attn_row_naive(F, l, row);
#endif
#if !FAST_SGU
    for (int row = gw; row < MREAL; row += NGW) sgu_row_naive(F, l, row);
#endif
}
__global__ void __launch_bounds__(512, 2) k_p2_fast(ArgsN a) {
    extern __shared__ __attribute__((aligned(16))) unsigned char ldsf[];
    const int tid = threadIdx.x, lane = tid & 63, gw = blockIdx.x * 8 + (tid >> 6), NGW = gridDim.x * 8; (void)lane; (void)gw; (void)NGW;
#if FAST_ATTN
    attn_units((LAS unsigned char*)ldsf, a.ws, blockIdx.x, gridDim.x, tid);
    for (int task = gw; task < 512; task += NGW) attn_sample_task(a.ws, a.in, a.out, a.l, task, lane);
#endif
#if FAST_SGU
    __syncthreads();
    for (int u = blockIdx.x; u < SGU_UNITS; u += gridDim.x) sgu_unit((LAS unsigned char*)ldsf, a.ws, a.in, a.out, a.l, u, tid);
#endif
#if FAST_SSM
    __syncthreads();
    for (int wu = gw; wu < 1024; wu += NGW) ssm_pass1_unit((LAS unsigned char*)ldsf + (tid >> 6) * XW_BYTES, a.ws, a.l, wu, lane);
#endif
}
__global__ void __launch_bounds__(512, 2) k_p3_fast(ArgsN a) {
    extern __shared__ __attribute__((aligned(16))) unsigned char ldsf[];
    const int tid = threadIdx.x, lane = tid & 63, gw = blockIdx.x * 8 + (tid >> 6), NGW = gridDim.x * 8; (void)lane; (void)gw; (void)NGW;
#if FAST_ATTN
    for (int row = gw; row < MREAL; row += NGW) attn_combine_row(a.ws, a.in, a.l, row, lane);
#endif
#if FAST_SSM
    __syncthreads();
    for (int u = blockIdx.x; u < SSM2_UNITS; u += gridDim.x) ssm_pass2_unit((LAS unsigned char*)ldsf, a.ws, a.in, a.out, a.l, u, tid);
#endif
}
__global__ void __launch_bounds__(512) k_p3_naive(ArgsN a) {
    const int l = a.l, lane = threadIdx.x & 63, gw = blockIdx.x * 8 + (threadIdx.x >> 6), NGW = gridDim.x * 8; const float* const* inp = a.in; float* out = a.out; unsigned char* ws = a.ws;
    Frame F; F.lds = nullptr; F.MISC = nullptr; F.ctl = nullptr; F.tid = 0; F.lane = lane; F.wave = 0; F.vcu = 0; F.G = 0; F.inp = inp; F.out = out; F.ws = ws;
#if !FAST_SSM
    for (int row = gw; row < MREAL; row += NGW) glu_row_naive(F, l, row);
#endif
}

struct Args { const float* in[30]; float* out; unsigned char* ws; int ph_lo, ph_hi, li, pad; };
__global__ void __launch_bounds__(NWAVES * 64, 2) fwd(Args args) {
    extern __shared__ __attribute__((aligned(16))) unsigned char lds[];
    Frame F;
    F.lds = (LAS unsigned char*)lds;
    F.MISC = (volatile LAS unsigned*)(F.lds + MISC_OFF);
    F.tid = threadIdx.x; F.lane = F.tid & 63; F.wave = __builtin_amdgcn_readfirstlane(F.tid >> 6);
    F.G = gridDim.x; { const int bx = blockIdx.x; F.vcu = (F.G % 8 == 0) ? (bx % 8) * (F.G / 8) + bx / 8 : bx; }
    unsigned char* ws = args.ws;
    F.ctl = (gu32*)(ws + WS_CTL);
    F.inp = args.in; F.out = args.out; F.ws = ws;
    for (int u = F.tid; u < (LDS_BYTES - LDSCTL_OFF) / 4; u += NWAVES * 64) ((LAS unsigned*)(F.lds + LDSCTL_OFF))[u] = 0u;
    __syncthreads();
    XcdBarrier bar; bar.bar = (unsigned*)(F.ctl + CW_BAR); bar.x = 0; bar.st = nullptr;
    if (!MK_PER_PHASE) bar = xcd_barrier_post((unsigned*)(F.ctl + CW_BAR), F.MISC + 8);
#define GRID_BAR() do { if (!MK_PER_PHASE) xcd_barrier(bar); } while (0)
    const int lo = args.ph_lo, hi = args.ph_hi;
#define IN(k) (lo <= (k) && (k) < hi)
#define BOTH(k) (IN(k) && IN((k) + 1))
    const int gw = F.vcu * NWAVES + F.wave, NGW = F.G * NWAVES;

    if (IN(0)) { p0_prologue(F); if (BOTH(0)) GRID_BAR(); }

    for (int l = 0; l < DEPTH; ++l) {
        const int pb = 1 + 8 * l;
        if (IN(pb + 0)) {
            pg8::Gemm g{F_WS(bf16, WS_XN), F_WS(bf16, WS_WIN) + (size_t)l * INC * DM, MTOT, INC, DM}; pg8::StaticOrder S; S.init(MTOT, INC, F.G, (int)blockIdx.x);
            pg8::EpiIn E{F.ws, F.out, l};
            pg8::gemm_phase<pg8::EpiIn, pg8::StaticOrder, true, true>(F.lds + RING_OFF, g, S, E);
            if (BOTH(pb + 0)) GRID_BAR();
        }
        if (IN(pb + 1)) {
#if MK_FUSED_MIXERS
            { int tl_ = threadIdx.x; asm volatile("" : "+v"(tl_));
              const int ln_ = tl_ & 63;
              attn_units(F.lds, F.ws, (int)blockIdx.x, F.G, tl_);
              for (int u = (int)blockIdx.x; u < 512; u += F.G) attn_sample_wg(F.lds, F.ws, F.inp, F.out, l, u, tl_);
              if ((int)blockIdx.x >= 200 && (int)blockIdx.x < 208) ssm_pass2_unit(F.lds, F.ws, F.inp, F.out, l, 256 + ((int)blockIdx.x - 200), tl_);
              for (int u = (int)blockIdx.x; u < SGU_UNITS; u += F.G) sgu_unit(F.lds, F.ws, F.inp, F.out, l, u, tl_);
              for (int wu = ((int)blockIdx.x - SGU_UNITS) * NWAVES + (tl_ >> 6); wu >= 0 && wu < 1024; wu += (F.G - SGU_UNITS) * NWAVES) ssm_pass1_unit(F.lds + (tl_ >> 6) * XW_BYTES, F.ws, l, wu, ln_); }
#endif
            if (BOTH(pb + 1)) GRID_BAR();
        }
        if (IN(pb + 2)) {
#if MK_FUSED_MIXERS
            { int tl_ = threadIdx.x; asm volatile("" : "+v"(tl_));
              const int ln_ = tl_ & 63;
              for (int row = gw; row < MREAL; row += NGW) attn_combine_row(F.ws, F.inp, l, row, ln_);
              __syncthreads();
              for (int u = (int)blockIdx.x; u < 256; u += F.G) ssm_pass2_unit(F.lds, F.ws, F.inp, F.out, l, u, tl_); }
#endif
            if (BOTH(pb + 2)) GRID_BAR();
        }
        if (IN(pb + 3)) {
            { int tl_ = threadIdx.x; asm volatile("" : "+v"(tl_));
              for (int c = (int)blockIdx.x; c < 256; c += F.G) sample_gemm_n2048<DM>(F.lds, F_WS(bf16, WS_MIX) + (size_t)MP * DM, F_WS(bf16, WS_WOUT) + (size_t)l * DM * DM, F_WS(float, WS_T), c, tl_); }
            pg8::Gemm g{F_WS(bf16, WS_MIX), F_WS(bf16, WS_WOUT) + (size_t)l * DM * DM, MP, DM, DM}; pg8::StaticOrder S; S.init(MP, DM, F.G, (int)blockIdx.x);
            pg8::EpiF32 E{F_WS(float, WS_T), DM};
            pg8::gemm_phase<pg8::EpiF32, pg8::StaticOrder, true, true>(F.lds + RING_OFF, g, S, E);
            if (BOTH(pb + 3)) GRID_BAR();
        }
        if (IN(pb + 4)) { { Frame Fn = F; int ln_ = threadIdx.x & 63; asm volatile("" : "+v"(ln_)); Fn.lane = ln_; norm_rows(Fn, F_IN(I_GPOSTMIX) + l * DM); } if (BOTH(pb + 4)) GRID_BAR(); }
        if (IN(pb + 5)) {
            pg8::Gemm g{F_WS(bf16, WS_XN), F_WS(bf16, WS_WGU) + (size_t)l * FF2 * DM, MTOT, FF2, DM}; pg8::StaticOrder S; S.init(MTOT, FF2, F.G, (int)blockIdx.x);
            pg8::EpiGU E{F.ws};
            pg8::gemm_phase<pg8::EpiGU, pg8::StaticOrder, true, true>(F.lds + RING_OFF, g, S, E);
            if (BOTH(pb + 5)) GRID_BAR();
        }
        if (IN(pb + 6)) {
            { int tl_ = threadIdx.x; asm volatile("" : "+v"(tl_));
              for (int c = (int)blockIdx.x; c < 256; c += F.G) sample_gemm_n2048<FF>(F.lds, F_WS(bf16, WS_H) + (size_t)MP * FF, F_WS(bf16, WS_WDN) + (size_t)l * DM * FF, F_WS(float, WS_T), c, tl_); }
            pg8::Gemm g{F_WS(bf16, WS_H), F_WS(bf16, WS_WDN) + (size_t)l * DM * FF, MP, DM, FF}; pg8::StaticOrder S; S.init(MP, DM, F.G, (int)blockIdx.x);
            pg8::EpiF32 E{F_WS(float, WS_T), DM};
            pg8::gemm_phase<pg8::EpiF32, pg8::StaticOrder, true, true>(F.lds + RING_OFF, g, S, E);
            if (BOTH(pb + 6)) GRID_BAR();
        }
        if (IN(pb + 7)) { { Frame Fn = F; int ln_ = threadIdx.x & 63; asm volatile("" : "+v"(ln_)); Fn.lane = ln_; norm_rows(Fn, F_IN(I_GPOSTFFN) + l * DM); } if (BOTH(pb + 7)) GRID_BAR(); }
    }
#undef IN
#undef BOTH
}

extern "C" void kernel_launch(void* const* d_in, const int* in_sizes, int n_in, void* d_out, int out_size, void* d_ws, size_t ws_size, hipStream_t stream) {
    static int grid = 0;
    if (grid == 0) {
        if (n_in != 30 || out_size < (int)O_END || ws_size < WS_END) { fprintf(stderr, "kernel_launch: unexpected problem shape (n_in %d out %d ws %zu)\n", n_in, out_size, ws_size); grid = -1; return; }
        int dev = 0, cus = 0;
        if (hipGetDevice(&dev) != hipSuccess || hipDeviceGetAttribute(&cus, hipDeviceAttributeMultiprocessorCount, dev) != hipSuccess) { grid = -1; return; }
#if MK_PER_PHASE
        (void)hipFuncSetAttribute((const void*)k_p2_fast, hipFuncAttributeMaxDynamicSharedMemorySize, LDS_BYTES); (void)hipFuncSetAttribute((const void*)k_p3_fast, hipFuncAttributeMaxDynamicSharedMemorySize, LDS_BYTES);
#endif
        if (hipFuncSetAttribute((const void*)fwd, hipFuncAttributeMaxDynamicSharedMemorySize, LDS_BYTES) != hipSuccess) { fprintf(stderr, "kernel_launch: hipFuncSetAttribute failed\n"); grid = -1; return; }
        int per_cu = 0;
        if (hipOccupancyMaxActiveBlocksPerMultiprocessor(&per_cu, (const void*)fwd, NWAVES * 64, LDS_BYTES) != hipSuccess || per_cu < 1) { fprintf(stderr, "kernel_launch: occupancy query says %d\n", per_cu); }
        (void)hipGetLastError();
        grid = cus;
    }
    if (grid < 0) return;
    if (hipMemsetAsync((char*)d_ws + WS_CTL, 0, CTL_ZERO_BYTES, stream) != hipSuccess) return;
    Args a{};
    for (int i = 0; i < 30; ++i) a.in[i] = (const float*)d_in[i];
    a.out = (float*)d_out; a.ws = (unsigned char*)d_ws; a.li = 0; a.pad = 0;
#if MK_PER_PHASE
    ArgsN an{}; for (int i = 0; i < 30; ++i) an.in[i] = (const float*)d_in[i]; an.out = (float*)d_out; an.ws = (unsigned char*)d_ws;
    for (int p = 0; p < N_PHASES; ++p) {
        const int k = (p == 0) ? -1 : (p - 1) % 8, l = (p - 1) / 8;
        if (k == 1) { an.l = l; hipLaunchKernelGGL(k_p2_naive, dim3(256), dim3(512), 0, stream, an); hipLaunchKernelGGL(k_p2_fast, dim3(256), dim3(512), LDS_BYTES, stream, an); }
        else if (k == 2) { an.l = l; hipLaunchKernelGGL(k_p3_naive, dim3(256), dim3(512), 0, stream, an); hipLaunchKernelGGL(k_p3_fast, dim3(256), dim3(512), LDS_BYTES, stream, an); }
        else { a.ph_lo = p; a.ph_hi = p + 1; hipLaunchKernelGGL(fwd, dim3(grid), dim3(NWAVES * 64), LDS_BYTES, stream, a); }
    }
#else
#ifdef PROBE_DUP_PHASE
    { int cur = 0;
      auto launch = [&](int lo_, int hi_) { if (lo_ >= hi_) return; (void)hipMemsetAsync((char*)d_ws + WS_CTL, 0, CTL_ZERO_BYTES, stream); a.ph_lo = lo_; a.ph_hi = hi_; hipLaunchKernelGGL(fwd, dim3(grid), dim3(NWAVES * 64), LDS_BYTES, stream, a); };
      if (PROBE_DUP_PHASE == 0) { launch(0, 1); launch(0, 1); cur = 1; }
      else for (int l = 0; l < DEPTH; ++l) { const int p = 8 * l + PROBE_DUP_PHASE; launch(cur, p + 1); launch(p, p + 1); cur = p + 1; }
      launch(cur, N_PHASES); }
#else
    a.ph_lo = 0; a.ph_hi = N_PHASES;
    hipLaunchKernelGGL(fwd, dim3(grid), dim3(NWAVES * 64), LDS_BYTES, stream, a);
#endif
#endif
}
```

```cpp
#include <hip/hip_runtime.h>
#include <cstdio>
#include <cstdint>
#define MK_PER_PHASE 0
#define FAST_ATTN 1
#define FAST_SSM 1
#define FAST_SGU 1
constexpr int NWAVES = 8;
#ifndef MK_PER_PHASE
#define MK_PER_PHASE 0
#endif
constexpr int DM = 2048, MP = 8192, MS = 64, MREAL = 8256, MTOT = 8448, SEQ = 4096;
constexpr int AW = 1024, SW = 512, GW = 512, INC = 4608, FF = 5632, FF2 = 11264, DEPTH = 4;
constexpr int N_PHASES = 1 + 8 * DEPTH;
constexpr float EPS = 1e-6f;
constexpr float LOG2E = 1.4426950408889634f;
constexpr float QSCALE = 0.08838834764831845f * 1.4426950408889634f;

constexpr size_t O_YP = 0, O_YS = 16777216, O_NKP = 16908288, O_NVP = 33685504, O_SRP = 50462720, O_SIP = 50479104, O_NKS = 50495488,
                 O_NVS = 50757632, O_SRS = 51019776, O_SIS = 51085312, O_SGV = 51150848, O_END = 51281920;
constexpr size_t MiB = 1u << 20;
constexpr size_t WS_CTL = 0, CTL_ZERO_BYTES = 1 * MiB;
constexpr size_t WS_WIN = 1 * MiB, SZ_WIN = (size_t)INC * DM * 2;
constexpr size_t WS_WOUT = WS_WIN + DEPTH * SZ_WIN, SZ_WOUT = (size_t)DM * DM * 2;
constexpr size_t WS_WGU = WS_WOUT + DEPTH * SZ_WOUT, SZ_WGU = (size_t)FF2 * DM * 2;
constexpr size_t WS_WDN = WS_WGU + DEPTH * SZ_WGU, SZ_WDN = (size_t)DM * FF * 2;
constexpr size_t WS_XN = WS_WDN + DEPTH * SZ_WDN;
constexpr size_t WS_Q = WS_XN + (size_t)MTOT * DM * 2;
constexpr size_t WS_K = WS_Q + (size_t)MTOT * AW * 2;
constexpr size_t WS_V = WS_K + (size_t)MTOT * AW * 2;
constexpr size_t WS_U = WS_V + (size_t)MTOT * AW * 2;
constexpr size_t WS_GU = WS_U + (size_t)MTOT * SW * 2;
constexpr size_t WS_GV = WS_GU + (size_t)MTOT * GW * 2;
constexpr size_t WS_MIX = WS_GV + (size_t)MTOT * GW * 2;
constexpr size_t WS_T = WS_MIX + (size_t)MTOT * DM * 2;
constexpr size_t WS_H = WS_T + (size_t)MTOT * DM * 4;
constexpr size_t WS_Y = WS_H + (size_t)MTOT * FF * 2;
constexpr size_t WS_RS = WS_Y + (size_t)MTOT * SW * 4;
constexpr size_t WS_BIAS = WS_RS + 65536;
constexpr size_t WS_WGLU = WS_BIAS + 65536;
constexpr size_t WS_WM = WS_WGLU + (size_t)DEPTH * 512 * 512 * 2;
constexpr size_t WS_AP = WS_WM + (size_t)DEPTH * 4 * 128 * 128 * 2;
constexpr size_t WS_BBF = WS_AP + (size_t)DEPTH * 32 * 64 * 8 * 4;
constexpr size_t WS_CF = WS_BBF + (size_t)DEPTH * 32 * 8 * 64 * 8 * 2;
constexpr size_t WS_SLOC = WS_CF + (size_t)DEPTH * 32 * 4 * 64 * 8 * 2;
constexpr size_t WS_END = WS_SLOC + (size_t)2 * 16 * 8 * 32 * 64 * 2 * 4;
constexpr size_t WS_OBUF = WS_H;
constexpr size_t WS_LSE = WS_T;
constexpr size_t WS_SATT = WS_T + 1 * MiB;
static_assert((size_t)3 * 8192 * 1024 * 2 <= (size_t)MTOT * FF * 2 && (size_t)3 * 8192 * 8 * 4 <= MiB, "overlays");
static_assert(WS_XN % 256 == 0 && WS_Q % 256 == 0 && WS_U % 256 == 0 && WS_MIX % 256 == 0 && WS_T % 256 == 0 && WS_H % 256 == 0 && WS_Y % 256 == 0 && WS_RS % 256 == 0, "ws alignment");
constexpr int CW_BAR = 4096;
constexpr int RING_OFF = 0, RING_BYTES = 131072;
constexpr int LDSCTL_OFF = RING_BYTES, MISC_OFF = LDSCTL_OFF + 320;
constexpr int LDS_BYTES = 147456;

namespace pg8 {
#define PG8_LAS __attribute__((address_space(3)))
typedef unsigned short bf16_t;
typedef short bf16x8 __attribute__((ext_vector_type(8)));
typedef float f32x4 __attribute__((ext_vector_type(4)));
typedef unsigned u32x4 __attribute__((ext_vector_type(4)));
constexpr int BM = 256, BK = 64, HALF = 128, HTB = HALF * BK * 2  , STAGE_BYTES = 8 * HTB, NXCD = 8, WGM = 8;

__host__ __device__ __forceinline__ int lds_byte(int r, int c) { const int st = (r >> 4) * 2 + (c >> 5), rr = r & 15, cc = c & 31, ob = rr * 64 + cc * 2; return st * 1024 + (ob ^ (((ob >> 9) & 1) << 5)); }
__host__ __device__ __forceinline__ void stage_rc(int b, int& R, int& C) { const int st = b / 1024, sb = b % 1024, swz = sb ^ (((sb >> 9) & 1) << 5); R = (st >> 1) * 16 + swz / 64; C = (st & 1) * 32 + (swz % 64) / 2; }
__host__ __device__ __forceinline__ int perm32(int rho) { const int n = rho >> 4, i = rho & 15; return 8 * (i >> 2) + 4 * n + (i & 3); }

struct Unit { int pm, pn; };
struct Gemm { const bf16_t* A; const bf16_t* Bt; int M, N, K; };

struct StaticOrder {
    int nM, nN, nwg, G, c;
    __host__ __device__ void init(int M, int N, int G_, int c_) { nM = M / BM; nN = N / BM; nwg = nM * nN; G = G_; c = c_; }
    __host__ __device__ bool next(int i, Unit& u) const {
        const long L = (long)i * G + c; if (L >= nwg) return false;
        int wgid = (int)L; { const int q = nwg / NXCD, r = nwg % NXCD, xcd = wgid % NXCD, off = wgid / NXCD; wgid = (xcd < r ? xcd * (q + 1) : r * (q + 1) + (xcd - r) * q) + off; }
        const int nig = WGM * nN, gid = wgid / nig, fm = gid * WGM, gsz = (nM - fm) < WGM ? (nM - fm) : WGM;
        u.pm = fm + ((wgid % nig) % gsz); u.pn = (wgid % nig) / gsz; return true;
    }
    __device__ __forceinline__ void a_ready(const Unit&) const {}
    __device__ __forceinline__ void done(const Unit&) const {}
};
__device__ __forceinline__ unsigned cvt_pk_bf16(float lo, float hi) { unsigned r; asm volatile("v_cvt_pk_bf16_f32 %0, %1, %2" : "=v"(r) : "v"(lo), "v"(hi)); return r; }
template <class Epi, class Sched, bool ALIGN_EPI = false, bool SP2 = false>
__device__ __forceinline__ void gemm_phase(PG8_LAS unsigned char* lds, const Gemm g, const Sched& S, const Epi& E) {
    int tid_raw = threadIdx.x; asm volatile("" : "+v"(tid_raw));
    const int tid = tid_raw, wid = __builtin_amdgcn_readfirstlane(tid >> 6), lane = tid & 63, wr = wid >> 2, wc = wid & 3, fr = lane & 15, fq = lane >> 4;
    const int K = g.K, nt = K / BK;
    unsigned voffA[2], voffB[2];
#pragma unroll
    for (int i = 0; i < 2; ++i) { int R, C; stage_rc(tid * 16 + i * 8192, R, C); const int Rb = Epi::PERM ? ((R & ~31) + perm32(R & 31)) : R;
        voffA[i] = (unsigned)(R * K + C) * 2u; voffB[i] = (unsigned)(Rb * K + C) * 2u; }
    const size_t kstep = (size_t)(BK * 2);
    const size_t hstep = (size_t)HALF * K * 2;
    const size_t tstep = 2 * hstep;
    const unsigned ldsw = (unsigned)wid * 1024u;
    const int aoff = lds_byte(wr * 64 + fr, fq * 8), boff = lds_byte(wc * 32 + fr, fq * 8);
#define PG8_SA(b, h) (((b) * 2 + (h)) * HTB)
#define PG8_SB(b, h) ((4 + (b) * 2 + (h)) * HTB)
#define PG8_STAGE(bufoff, gbase, voff) do { _Pragma("unroll") for (int _i = 0; _i < 2; ++_i) \
        __builtin_amdgcn_global_load_lds((const unsigned*)((const char*)(gbase) + (voff)[_i]), (PG8_LAS unsigned*)(lds + (bufoff) + ldsw + _i * 8192), 16, 0, 0); } while (0)
#define PG8_LDA(dst, b, h) do { _Pragma("unroll") for (int m = 0; m < 4; ++m) _Pragma("unroll") for (int k = 0; k < 2; ++k) dst[m][k] = *(const PG8_LAS bf16x8*)(lds + PG8_SA(b, h) + aoff + m * 2048 + k * 1024); } while (0)
#define PG8_LDB(dst, b, h) do { _Pragma("unroll") for (int n = 0; n < 2; ++n) _Pragma("unroll") for (int k = 0; k < 2; ++k) dst[n][k] = *(const PG8_LAS bf16x8*)(lds + PG8_SB(b, h) + boff + n * 2048 + k * 1024); } while (0)
#define PG8_MMA(ai, bj, At, Bt) do { __builtin_amdgcn_s_setprio(1); _Pragma("unroll") for (int m = 0; m < 4; ++m) _Pragma("unroll") for (int n = 0; n < 2; ++n) _Pragma("unroll") for (int k = 0; k < 2; ++k) \
        acc[ai][bj][m][n] = __builtin_amdgcn_mfma_f32_16x16x32_bf16(Bt[n][k], At[m][k], acc[ai][bj][m][n], 0, 0, 0); __builtin_amdgcn_s_setprio(0); } while (0)
#define PG8_WAIT_V(n) asm volatile("s_waitcnt vmcnt(" #n ")" ::: "memory")
#define PG8_WAIT_L(n) asm volatile("s_waitcnt lgkmcnt(" #n ")" ::: "memory")
#define PG8_BAR __builtin_amdgcn_s_barrier()
#define PG8_SCHED __builtin_amdgcn_sched_barrier(0)
    Unit cur, nxt; int ui = 0;
    if (!S.next(0, cur)) return;
    f32x4 acc[2][2][4][2];
#pragma unroll
    for (int a = 0; a < 2; ++a)
#pragma unroll
        for (int b = 0; b < 2; ++b)
#pragma unroll
            for (int m = 0; m < 4; ++m)
#pragma unroll
                for (int n = 0; n < 2; ++n) acc[a][b][m][n] = (f32x4){0.f, 0.f, 0.f, 0.f};
    bf16x8 At[4][2], B0[2][2], B1[2][2];
    const char* cA = (const char*)g.A + (size_t)cur.pm * tstep; const char* cB = (const char*)g.Bt + (size_t)cur.pn * tstep;
    S.a_ready(cur);
    if constexpr (SP2) {
        PG8_STAGE(PG8_SB(0, 0), cB, voffB); PG8_STAGE(PG8_SB(0, 1), cB + hstep, voffB); PG8_STAGE(PG8_SA(0, 0), cA, voffA); PG8_STAGE(PG8_SA(0, 1), cA + hstep, voffA);
        if (wr == 1) PG8_BAR;
        PG8_WAIT_V(2); PG8_BAR;
        PG8_STAGE(PG8_SB(1, 0), cB + kstep, voffB); PG8_STAGE(PG8_SA(1, 0), cA + kstep, voffA); PG8_STAGE(PG8_SB(1, 1), cB + hstep + kstep, voffB);
        PG8_WAIT_V(6); PG8_BAR;
    } else {
        PG8_STAGE(PG8_SB(0, 0), cB, voffB); PG8_STAGE(PG8_SA(0, 0), cA, voffA); PG8_STAGE(PG8_SB(0, 1), cB + hstep, voffB); PG8_STAGE(PG8_SA(0, 1), cA + hstep, voffA);
        if (wr == 1) PG8_BAR;
        PG8_WAIT_V(4); PG8_BAR;
        PG8_STAGE(PG8_SB(1, 0), cB + kstep, voffB); PG8_STAGE(PG8_SA(1, 0), cA + kstep, voffA); PG8_STAGE(PG8_SB(1, 1), cB + hstep + kstep, voffB);
        PG8_WAIT_V(6); PG8_BAR;
    }
    for (;;) {
        const bool has_next = S.next(ui + 1, nxt);
        const char* nA = has_next ? (const char*)g.A + (size_t)nxt.pm * tstep : cA; const char* nB = has_next ? (const char*)g.Bt + (size_t)nxt.pn * tstep : cB;
        for (int t = 0; t < nt; t += 2) {
            const bool last = (t == nt - 2);
            const char* a1 = cA + (size_t)(t + 1) * kstep;
            const char* a2 = last ? nA : cA + (size_t)(t + 2) * kstep; const char* b2 = last ? nB : cB + (size_t)(t + 2) * kstep;
            const char* a3 = a2 + kstep; const char* b3 = b2 + kstep;
            if (last && has_next) S.a_ready(nxt);
            if constexpr (SP2) {
            PG8_LDB(B0, 0, 0); PG8_LDB(B1, 0, 1); PG8_SCHED; PG8_LDA(At, 0, 0); PG8_STAGE(PG8_SA(1, 1), a1 + hstep, voffA);
            PG8_WAIT_V(8); PG8_WAIT_L(0); PG8_BAR; PG8_MMA(0, 0, At, B0); PG8_MMA(0, 1, At, B1); PG8_BAR; PG8_SCHED;
            PG8_LDA(At, 0, 1); PG8_STAGE(PG8_SB(0, 0), b2, voffB); PG8_STAGE(PG8_SB(0, 1), b2 + hstep, voffB); PG8_STAGE(PG8_SA(0, 0), a2, voffA);
            PG8_WAIT_V(8); PG8_WAIT_L(0); PG8_BAR; PG8_MMA(1, 0, At, B0); PG8_MMA(1, 1, At, B1); PG8_BAR; PG8_SCHED;
            PG8_LDB(B0, 1, 0); PG8_LDB(B1, 1, 1); PG8_SCHED; PG8_LDA(At, 1, 0); PG8_STAGE(PG8_SA(0, 1), a2 + hstep, voffA);
            PG8_WAIT_V(8); PG8_WAIT_L(0); PG8_BAR; PG8_MMA(0, 0, At, B0); PG8_MMA(0, 1, At, B1); PG8_BAR; PG8_SCHED;
            PG8_LDA(At, 1, 1); PG8_STAGE(PG8_SB(1, 0), b3, voffB); PG8_STAGE(PG8_SB(1, 1), b3 + hstep, voffB); PG8_STAGE(PG8_SA(1, 0), a3, voffA);
            PG8_WAIT_V(8); PG8_WAIT_L(0); PG8_BAR; PG8_MMA(1, 0, At, B0); PG8_MMA(1, 1, At, B1); PG8_BAR; PG8_SCHED;
            } else {
            PG8_LDB(B0, 0, 0); PG8_SCHED; PG8_LDA(At, 0, 0); PG8_STAGE(PG8_SA(1, 1), a1 + hstep, voffA);
            PG8_WAIT_L(8); PG8_BAR; PG8_WAIT_L(0); PG8_MMA(0, 0, At, B0); PG8_BAR; PG8_SCHED;
            PG8_LDB(B1, 0, 1); PG8_STAGE(PG8_SB(0, 0), b2, voffB);
            PG8_BAR; PG8_WAIT_L(0); PG8_MMA(0, 1, At, B1); PG8_BAR;
            PG8_LDA(At, 0, 1); PG8_STAGE(PG8_SA(0, 0), a2, voffA);
            PG8_BAR; PG8_WAIT_L(0); PG8_MMA(1, 0, At, B0); PG8_BAR; PG8_SCHED;
            PG8_STAGE(PG8_SB(0, 1), b2 + hstep, voffB);
            PG8_WAIT_V(6); PG8_BAR; PG8_MMA(1, 1, At, B1); PG8_BAR;
            PG8_LDB(B0, 1, 0); PG8_SCHED; PG8_LDA(At, 1, 0); PG8_STAGE(PG8_SA(0, 1), a2 + hstep, voffA);
            PG8_WAIT_L(8); PG8_BAR; PG8_WAIT_L(0); PG8_MMA(0, 0, At, B0); PG8_BAR; PG8_SCHED;
            PG8_LDB(B1, 1, 1); PG8_STAGE(PG8_SB(1, 0), b3, voffB);
            PG8_BAR; PG8_WAIT_L(0); PG8_MMA(0, 1, At, B1); PG8_BAR;
            PG8_LDA(At, 1, 1); PG8_STAGE(PG8_SA(1, 0), a3, voffA);
            PG8_BAR; PG8_WAIT_L(0); PG8_MMA(1, 0, At, B0); PG8_BAR; PG8_SCHED;
            PG8_STAGE(PG8_SB(1, 1), b3 + hstep, voffB);
            PG8_WAIT_V(6); PG8_BAR; PG8_MMA(1, 1, At, B1); PG8_BAR;
            }
        }
        if constexpr (ALIGN_EPI) { if (wr == 0) PG8_BAR; }
        if constexpr (!Epi::AFTER_DRAIN) { E(acc, cur, wr, wc, fr, fq); S.done(cur); }
        if (!has_next) break;
#pragma unroll
        for (int a = 0; a < 2; ++a)
#pragma unroll
            for (int b = 0; b < 2; ++b)
#pragma unroll
                for (int m = 0; m < 4; ++m)
#pragma unroll
                    for (int n = 0; n < 2; ++n) acc[a][b][m][n] = (f32x4){0.f, 0.f, 0.f, 0.f};
        cur = nxt; cA = nA; cB = nB; ++ui;
        if constexpr (ALIGN_EPI) { if (wr == 1) PG8_BAR; }
    }
    PG8_WAIT_V(0);
    if constexpr (!ALIGN_EPI) { if (wr == 0) PG8_BAR; }
    PG8_BAR;
    if constexpr (Epi::AFTER_DRAIN) { E.fused(acc, cur, wr, wc, fr, fq, lds, wid, lane); S.done(cur); }
#undef PG8_SA
#undef PG8_SB
#undef PG8_STAGE
#undef PG8_LDA
#undef PG8_LDB
#undef PG8_MMA
#undef PG8_WAIT_V
#undef PG8_WAIT_L
#undef PG8_BAR
#undef PG8_SCHED
}
}

namespace pg8 {
__device__ __forceinline__ float fast_sigmoid(float w) { return __builtin_amdgcn_rcpf(1.0f + __builtin_amdgcn_exp2f(-1.4426950408889634f * w)); }
__device__ __forceinline__ float gelu_tanh(float x) { return x * fast_sigmoid(1.5957691216057308f * (x + 0.044715f * x * x * x)); }

struct EpiF32 {
    static constexpr bool PERM = false, AFTER_DRAIN = false;
    float* C; int ldc;
    __device__ __forceinline__ void operator()(const f32x4 (&acc)[2][2][4][2], const Unit& u, int wr, int wc, int fr, int fq) const {
        const int row0 = u.pm * BM + wr * 64 + fr, col0 = u.pn * BM + wc * 32 + 4 * fq;
#pragma unroll
        for (int ai = 0; ai < 2; ++ai)
#pragma unroll
            for (int m = 0; m < 4; ++m) { float* rowp = C + (size_t)(row0 + ai * HALF + m * 16) * ldc + col0;
#pragma unroll
                for (int bj = 0; bj < 2; ++bj)
#pragma unroll
                    for (int n = 0; n < 2; ++n) *(f32x4*)(rowp + bj * HALF + n * 16) = acc[ai][bj][m][n]; }
    }
};

struct EpiIn {
    static constexpr bool PERM = true, AFTER_DRAIN = false;
    unsigned char* ws; float* out; int layer;
    __device__ __forceinline__ void operator()(const f32x4 (&acc)[2][2][4][2], const Unit& u, int wr, int wc, int fr, int fq) const {
        const int row0 = u.pm * BM + wr * 64 + fr;
        const int pn = u.pn;
#pragma unroll
        for (int ai = 0; ai < 2; ++ai)
#pragma unroll
            for (int m = 0; m < 4; ++m) {
                const int row = row0 + ai * HALF + m * 16;
                const float r = ((const float*)(ws + WS_RS))[row];
#pragma unroll
                for (int bj = 0; bj < 2; ++bj) {
                    f32x4 v0 = acc[ai][bj][m][0] * r, v1 = acc[ai][bj][m][1] * r;
                    const int col = pn * BM + bj * HALF + wc * 32 + 8 * fq;
                    bf16_t* dst;
                    if (pn < 4) dst = (bf16_t*)(ws + WS_Q) + (size_t)row * 1024 + col;
                    else if (pn < 8) dst = (bf16_t*)(ws + WS_K) + (size_t)row * 1024 + (col - 1024);
                    else if (pn < 12) dst = (bf16_t*)(ws + WS_V) + (size_t)row * 1024 + (col - 2048);
                    else if (pn < 14) dst = (bf16_t*)(ws + WS_U) + (size_t)row * 512 + (col - 3072);
                    else if (pn < 16) dst = (bf16_t*)(ws + WS_GU) + (size_t)row * 512 + (col - 3584);
                    else dst = (bf16_t*)(ws + WS_GV) + (size_t)row * 512 + (col - 4096);
                    if (pn >= 4 && pn < 12) {
                        const int c2 = (pn < 8) ? col - 1024 : col - 2048;
                        float* o = nullptr;
                        if (row < 8192) { const int b = row >> 12, t = row & 4095;
                            if (t >= 2048) o = out + ((pn < 8) ? O_NKP : O_NVP) + ((size_t)((layer * 2 + b) * 2048 + (t - 2048))) * 1024 + c2; }
                        else if (row < 8256) o = out + ((pn < 8) ? O_NKS : O_NVS) + ((size_t)(layer * 64 + (row - 8192))) * 1024 + c2;
                        if (o) { *(f32x4*)o = v0; *(f32x4*)(o + 4) = v1; }
                    }
                    if (pn >= 14) {
#pragma unroll
                        for (int j = 0; j < 4; ++j) { v0[j] = gelu_tanh(v0[j]); v1[j] = gelu_tanh(v1[j]); }
                    }
                    u32x4 w; w.x = cvt_pk_bf16(v0[0], v0[1]); w.y = cvt_pk_bf16(v0[2], v0[3]); w.z = cvt_pk_bf16(v1[0], v1[1]); w.w = cvt_pk_bf16(v1[2], v1[3]);
                    *(u32x4*)dst = w;
                }
            }
    }
};

struct EpiGU {
    static constexpr bool PERM = true, AFTER_DRAIN = false;
    unsigned char* ws;
    __device__ __forceinline__ void operator()(const f32x4 (&acc)[2][2][4][2], const Unit& u, int wr, int wc, int fr, int fq) const {
        const int row0 = u.pm * BM + wr * 64 + fr, j0 = u.pn * HALF + wc * 32 + 8 * fq;
#pragma unroll
        for (int ai = 0; ai < 2; ++ai)
#pragma unroll
            for (int m = 0; m < 4; ++m) {
                const int row = row0 + ai * HALF + m * 16;
                const float r = ((const float*)(ws + WS_RS))[row];
                float o[8];
#pragma unroll
                for (int n = 0; n < 2; ++n)
#pragma unroll
                    for (int j = 0; j < 4; ++j) { const float g = acc[ai][0][m][n][j] * r, up = acc[ai][1][m][n][j] * r; o[4 * n + j] = g * fast_sigmoid(g) * up; }
                u32x4 w; w.x = cvt_pk_bf16(o[0], o[1]); w.y = cvt_pk_bf16(o[2], o[3]); w.z = cvt_pk_bf16(o[4], o[5]); w.w = cvt_pk_bf16(o[6], o[7]);
                *(u32x4*)((bf16_t*)(ws + WS_H) + (size_t)row * 5632 + j0) = w;
            }
    }
};
}

#define GAS __attribute__((address_space(1)))
#define LAS __attribute__((address_space(3)))
typedef unsigned short bf16;
typedef unsigned v4u __attribute__((ext_vector_type(4)));
typedef unsigned v2u __attribute__((ext_vector_type(2)));
typedef float f32x4 __attribute__((ext_vector_type(4)));
typedef float f32x2v __attribute__((ext_vector_type(2)));
typedef short bf16x8 __attribute__((ext_vector_type(8)));
typedef GAS unsigned gu32;
#define RLX_AGENT __ATOMIC_RELAXED, __HIP_MEMORY_SCOPE_AGENT
#define LDS_WAIT() asm volatile("s_waitcnt lgkmcnt(0)" ::: "memory")
#define VM_WAIT() asm volatile("s_waitcnt vmcnt(0)" ::: "memory")
__device__ __forceinline__ unsigned f2bf(float f) { unsigned u = __builtin_bit_cast(unsigned, f); return (u + 0x7fffu + ((u >> 16) & 1u)) >> 16; }
__device__ __forceinline__ unsigned pk2(float lo, float hi) { return f2bf(lo) | (f2bf(hi) << 16); }
__device__ __forceinline__ float bf_lo(unsigned w) { return __builtin_bit_cast(float, w << 16); }
__device__ __forceinline__ float bf_hi(unsigned w) { return __builtin_bit_cast(float, w & 0xffff0000u); }
__device__ __forceinline__ float bf2f(bf16 b) { return __builtin_bit_cast(float, ((unsigned)b) << 16); }

#define XB_TMO      128
#define XB_XCNT(j)  (256  + 64 * (j))
#define XB_XSUB(j)  (1280 + 64 * (j))
#define XB_XGEN(j)  (2304 + 64 * (j))
#define XB_TOP      3328
#define XB_TOPGEN   3392
#define XCD_BAR_WORDS 3456
#define XB_SPIN_CAP (1u << 18)

__device__ __forceinline__ unsigned xb_ld(unsigned* p)              { return __hip_atomic_load(p, __ATOMIC_RELAXED, __HIP_MEMORY_SCOPE_AGENT); }
__device__ __forceinline__ unsigned xb_add(unsigned* p, unsigned v) { return __hip_atomic_fetch_add(p, v, __ATOMIC_RELAXED, __HIP_MEMORY_SCOPE_AGENT); }
__device__ __forceinline__ unsigned xb_xcc_id() { return (unsigned)__builtin_amdgcn_s_getreg((3 << 11) | 20) & 0xFu; }
#define XB_SPIN(cond, bar) do { unsigned _sp = 0; while (cond) { __builtin_amdgcn_s_sleep(1); \
    if ((++_sp & 255u) == 0u) { if (xb_ld(&(bar)[XB_TMO])) break; if (_sp > XB_SPIN_CAP) { atomicAdd(&(bar)[XB_TMO], 1u); break; } } } } while (0)

struct XcdBarrier {
    unsigned* bar; unsigned x;
    volatile LAS unsigned* st;
};

__device__ __forceinline__ XcdBarrier xcd_barrier_post(unsigned* bar, volatile LAS unsigned* st) {
    XcdBarrier b; b.bar = bar; b.x = xb_xcc_id(); b.st = st;
    if (threadIdx.x == 0) (void)xb_add(&bar[XB_XCNT(b.x)], 1u);
    return b;
}
__device__ __forceinline__ void xcd_barrier_complete(unsigned* bar, unsigned x, unsigned& nloc, unsigned& nx) {
    const unsigned G = gridDim.x * gridDim.y * gridDim.z;
    unsigned sum, cnt, mine, sp = 0u;
    for (;;) {
        sum = 0u; cnt = 0u; mine = 0u;
#pragma unroll
        for (unsigned j = 0; j < 16; ++j) { const unsigned c = xb_ld(&bar[XB_XCNT(j)]); sum += c; cnt += (c > 0u) ? 1u : 0u; mine = (j == x) ? c : mine; }
        if (sum == G) break;
        __builtin_amdgcn_s_sleep(1);
        if ((++sp & 255u) == 0u) { if (xb_ld(&bar[XB_TMO])) break; if (sp > XB_SPIN_CAP) { atomicAdd(&bar[XB_TMO], 1u); break; } }
    }
    nloc = mine > 0u ? mine : 1u; nx = cnt > 0u ? cnt : 1u;
}

__device__ __forceinline__ void xcd_barrier(const XcdBarrier& b) {
    asm volatile("s_waitcnt vmcnt(0)" ::: "memory");
    __syncthreads();
    if (threadIdx.x == 0) {
        unsigned* bar = b.bar;
        __builtin_amdgcn_s_waitcnt(0);
        unsigned nloc = b.st[0], nx = b.st[1];
        if (nloc == 0u) { xcd_barrier_complete(bar, b.x, nloc, nx); b.st[0] = nloc; b.st[1] = nx; }
        const unsigned old = xb_add(&bar[XB_XSUB(b.x)], 1u);
        const unsigned gen = old / nloc;
        if (old + 1u == (gen + 1u) * nloc) {
            __builtin_amdgcn_fence(__ATOMIC_RELEASE, "agent");
            asm volatile("s_waitcnt vmcnt(0)" ::: "memory");
            const unsigned og = xb_add(&bar[XB_TOP], 1u);
            const unsigned tg = og / nx;
            if (og + 1u == (tg + 1u) * nx) xb_add(&bar[XB_TOPGEN], 1u);
            else XB_SPIN(xb_ld(&bar[XB_TOPGEN]) == tg, bar);
            __builtin_amdgcn_fence(__ATOMIC_ACQUIRE, "agent");
            xb_add(&bar[XB_XGEN(b.x)], 1u);
            asm volatile("s_waitcnt vmcnt(0)" ::: "memory");
        } else {
            XB_SPIN(xb_ld(&bar[XB_XGEN(b.x)]) == gen, bar);
            __builtin_amdgcn_fence(__ATOMIC_ACQUIRE, "agent");
            asm volatile("s_waitcnt vmcnt(0)" ::: "memory");
        }
    }
    __syncthreads();
}


#ifndef PROBE_P0
#define PROBE_P0 1
#endif
#ifndef PROBE_P2
#define PROBE_P2 1
#endif
#ifndef PROBE_P3
#define PROBE_P3 1
#endif
#ifndef MK_FUSED_MIXERS
#define MK_FUSED_MIXERS 1
#endif
#ifndef FAST_ATTN
#define FAST_ATTN 0
#endif
#ifndef FAST_SSM
#define FAST_SSM 0
#endif
#ifndef FAST_SGU
#define FAST_SGU 0
#endif
struct Frame {
    LAS unsigned char* lds;
    volatile LAS unsigned* MISC;
    gu32* ctl;
    int tid, lane, wave;
    int vcu, G;
    const float* const* inp;
    float* out;
    unsigned char* ws;
};
#define F_IN(k) (F.inp[(k)])
#define F_WS(type, off) ((type*)(F.ws + (off)))
enum { I_XP = 0, I_XS, I_CK, I_CV, I_SRE, I_SIM, I_RELB, I_WIN, I_WOUT, I_GPREMIX, I_GPOSTMIX, I_GMIXOUT, I_LAMRE, I_LAMIM, I_LOGSTEP, I_BRE, I_BIM, I_CRE, I_CIM,
       I_SSMD, I_WGLU, I_BGLU, I_SGUG, I_SGUW, I_SGUB, I_GPREFFN, I_GPOSTFFN, I_WGATE, I_WUP, I_WDOWN };

__device__ __forceinline__ float wave_sum(float v) {
#pragma unroll
    for (int o = 1; o < 64; o <<= 1) v += __shfl_xor(v, o);
    return v;
}

constexpr int TP_ROW = 36;
__device__ __forceinline__ void p0_transpose_item(const float* W, int K, int N, bf16* WT, LAS unsigned* scr, int item, int lane, const float* kscale, float cscale, int cs_limit, int mode) {
    const int nblk = N / 64, kb = item / nblk, nb = item % nblk, k0 = 64 * kb, n0 = 64 * nb;
    const float cs = (n0 < cs_limit) ? cscale : 1.0f;
    const int g = lane >> 4, n4 = (lane & 15) * 4;
    f32x4 v[16];
#pragma unroll
    for (int i = 0; i < 16; ++i) v[i] = *(const GAS f32x4*)(W + (size_t)(k0 + 16 * g + i) * N + n0 + n4);
    if (kscale) {
        const GAS f32x4* ks = (const GAS f32x4*)(kscale + k0 + 16 * g);
#pragma unroll
        for (int i4 = 0; i4 < 4; ++i4) { const f32x4 s = ks[i4]; v[4 * i4] = v[4 * i4] * s.x; v[4 * i4 + 1] = v[4 * i4 + 1] * s.y; v[4 * i4 + 2] = v[4 * i4 + 2] * s.z; v[4 * i4 + 3] = v[4 * i4 + 3] * s.w; }
    }
#pragma unroll
    for (int ip = 0; ip < 8; ++ip)
#pragma unroll
        for (int j = 0; j < 4; ++j) scr[(n4 + j) * TP_ROW + 8 * g + ip] = pk2(v[2 * ip][j] * cs, v[2 * ip + 1][j] * cs);
    LDS_WAIT(); asm volatile("" ::: "memory");
    const int c = lane & 7;
#pragma unroll
    for (int i2 = 0; i2 < 8; ++i2) { const int n = (lane >> 3) + 8 * i2;
        const v4u o = *(const LAS v4u*)(scr + n * TP_ROW + 4 * c);
        const int col = n0 + n; const int row = (mode == 0) ? col : (256 * (col >> 7) + (col & 127) + (mode == 2 ? 128 : 0));
        *(GAS v4u*)(WT + (size_t)row * K + k0 + 8 * c) = o; }
    LDS_WAIT(); asm volatile("" ::: "memory");
}
__device__ __forceinline__ int t5_bucket(int dist) {
    if (dist < 16) return dist;
    int large = 16 + (int)(logf((float)dist / 16.0f) / logf(128.0f) * 16.0f);
    return large < 31 ? large : 31;
}
__device__ __forceinline__ void p0_prologue(Frame& F) {
    LAS unsigned* scr = (LAS unsigned*)(F.lds + RING_OFF + F.wave * 16384);
    const int gw = F.vcu * NWAVES + F.wave, NGW = F.G * NWAVES;
    constexpr int I_IN = (DM / 64) * (INC / 64), I_OUT = (DM / 64) * (DM / 64), I_G = (DM / 64) * (FF / 64), I_D = (FF / 64) * (DM / 64);
    constexpr int I_GLU = (SW / 64) * (SW / 64);
    constexpr int PER_L = I_IN + I_OUT + 2 * I_G + I_D + I_GLU;
    for (int it = gw; it < DEPTH * PER_L; it += NGW) {
        const int l = it / PER_L; int r = it % PER_L;
        if (r < I_IN) { p0_transpose_item(F_IN(I_WIN) + (size_t)l * DM * INC, DM, INC, F_WS(bf16, WS_WIN) + (size_t)l * INC * DM, scr, r, F.lane, F_IN(I_GPREMIX) + l * DM, QSCALE, AW, 0); continue; } r -= I_IN;
        if (r < I_OUT) { p0_transpose_item(F_IN(I_WOUT) + (size_t)l * DM * DM, DM, DM, F_WS(bf16, WS_WOUT) + (size_t)l * DM * DM, scr, r, F.lane, nullptr, 1.f, 0, 0); continue; } r -= I_OUT;
        if (r < I_G) { p0_transpose_item(F_IN(I_WGATE) + (size_t)l * DM * FF, DM, FF, F_WS(bf16, WS_WGU) + (size_t)l * FF2 * DM, scr, r, F.lane, F_IN(I_GPREFFN) + l * DM, 1.f, 0, 1); continue; } r -= I_G;
        if (r < I_G) { p0_transpose_item(F_IN(I_WUP) + (size_t)l * DM * FF, DM, FF, F_WS(bf16, WS_WGU) + (size_t)l * FF2 * DM, scr, r, F.lane, F_IN(I_GPREFFN) + l * DM, 1.f, 0, 2); continue; } r -= I_G;
        if (r < I_D) { p0_transpose_item(F_IN(I_WDOWN) + (size_t)l * FF * DM, FF, DM, F_WS(bf16, WS_WDN) + (size_t)l * DM * FF, scr, r, F.lane, nullptr, 1.f, 0, 0); continue; } r -= I_D;
        p0_transpose_item(F_IN(I_WGLU) + (size_t)l * SW * SW, SW, SW, F_WS(bf16, WS_WGLU) + (size_t)l * SW * SW, scr, r, F.lane, nullptr, 1.f, 0, 0);
    }
    for (int i = gw * 64 + F.lane; i < DEPTH * 32 * 64; i += NGW * 64) {
        const int p = i & 63, g = (i >> 6) & 31, l = i >> 11;
        const float lr = F_IN(I_LAMRE)[i], li = F_IN(I_LAMIM)[i], step = expf(F_IN(I_LOGSTEP)[l * 32 + g]);
        const float mag = expf(lr * step), are = mag * cosf(li * step), aim = mag * sinf(li * step);
        const float den = lr * lr + li * li, cre_ = ((are - 1.0f) * lr + aim * li) / den, cim_ = (aim * lr - (are - 1.0f) * li) / den;
        float pr = are, pim = aim; float* ap = F_WS(float, WS_AP) + (size_t)i * 8; ap[0] = are; ap[1] = aim;
        for (int k = 0; k < 5; ++k) { const float nr = pr * pr - pim * pim, ni = 2.0f * pr * pim; pr = nr; pim = ni; }
        ap[2] = pr; ap[3] = pim;
        for (int k = 0; k < 3; ++k) { const float nr = pr * pr - pim * pim, ni = 2.0f * pr * pim; pr = nr; pim = ni; }
        ap[4] = pr; ap[5] = pim; ap[6] = 0.f; ap[7] = 0.f;
        bf16* BB = F_WS(bf16, WS_BBF) + ((size_t)(l * 32 + g) * 8) * 512; bf16* CFp = F_WS(bf16, WS_CF) + ((size_t)(l * 32 + g) * 4) * 512;
        const int mt = p >> 4, rowi = p & 15;
        for (int c = 0; c < 16; ++c) { const float br = F_IN(I_BRE)[(size_t)i * 16 + c], bi = F_IN(I_BIM)[(size_t)i * 16 + c];
            const int ln = rowi + 16 * (c >> 3), j = c & 7;
            BB[(mt * 64 + ln) * 8 + j] = (bf16)f2bf(cre_ * br - cim_ * bi); BB[((4 + mt) * 64 + ln) * 8 + j] = (bf16)f2bf(cre_ * bi + cim_ * br);
            const int lc = c + 16 * ((p >> 3) & 3), jc = p & 7;
            CFp[((p >> 5) * 64 + lc) * 8 + jc] = (bf16)f2bf(F_IN(I_CRE)[(((size_t)l * 32 + g) * 16 + c) * 64 + p]);
            CFp[((2 + (p >> 5)) * 64 + lc) * 8 + jc] = (bf16)f2bf(-F_IN(I_CIM)[(((size_t)l * 32 + g) * 16 + c) * 64 + p]); }
        for (int g4 = 2; g4 < 4; ++g4) for (int j = 0; j < 8; ++j) { BB[(mt * 64 + rowi + 16 * g4) * 8 + j] = 0; BB[((4 + mt) * 64 + rowi + 16 * g4) * 8 + j] = 0; }
    }
    for (int i = gw * 64 + F.lane; i < DEPTH * 4 * 128 * 128; i += NGW * 64) { const int s = i & 127, t = (i >> 7) & 127; F_WS(bf16, WS_WM)[i] = (s <= t) ? (bf16)f2bf(F_IN(I_SGUW)[i]) : (bf16)0; }
    for (int m = gw; m < MTOT; m += NGW) {
        GAS v2u* xo = (GAS v2u*)(F_WS(bf16, WS_XN) + (size_t)m * DM) + F.lane;
        if (m < MREAL) {
            const float* src = (m < MP) ? F_IN(I_XP) + (size_t)m * DM : F_IN(I_XS) + (size_t)(m - MP) * DM;
            const GAS f32x4* xr = (const GAS f32x4*)src + F.lane; GAS f32x4* xw = (GAS f32x4*)(F.out + (size_t)m * DM) + F.lane;
            f32x4 v[8]; float s = 0.f;
#pragma unroll
            for (int j = 0; j < 8; ++j) { v[j] = xr[64 * j]; s += (v[j].x * v[j].x + v[j].y * v[j].y) + (v[j].z * v[j].z + v[j].w * v[j].w); }
            s = wave_sum(s);
#pragma unroll
            for (int j = 0; j < 8; ++j) { xw[64 * j] = v[j]; v2u w; w.x = pk2(v[j].x, v[j].y); w.y = pk2(v[j].z, v[j].w); xo[64 * j] = w; }
            if (F.lane == 0) F_WS(float, WS_RS)[m] = 1.0f / sqrtf(s * (1.0f / DM) + EPS);
        } else {
#pragma unroll
            for (int j = 0; j < 8; ++j) { v2u w; w.x = 0u; w.y = 0u; xo[64 * j] = w; }
            if (F.lane == 0) F_WS(float, WS_RS)[m] = 0.f;
        }
    }
    for (int i = gw * 64 + F.lane; i < 3 * 8 * 129; i += NGW * 64) {
        const int jj = i % 129, h = (i / 129) % 8, pi = i / (129 * 8); const int d = pi == 0 ? 1 : (pi == 1 ? 4 : 16);
        F_WS(float, WS_BIAS)[i] = F_IN(I_RELB)[t5_bucket(jj * d) * 8 + h] * LOG2E;
    }
}

__device__ __forceinline__ void norm_rows(Frame& F, const float* g) {
    const int gw = F.vcu * NWAVES + F.wave, NGW = F.G * NWAVES;
    for (int m = gw; m < MREAL; m += NGW) {
        const GAS f32x4* tr = (const GAS f32x4*)(F_WS(float, WS_T) + (size_t)m * DM) + F.lane; GAS f32x4* xw = (GAS f32x4*)(F.out + (size_t)m * DM) + F.lane;
        const GAS f32x4* gr = (const GAS f32x4*)g + F.lane; GAS v2u* xo = (GAS v2u*)(F_WS(bf16, WS_XN) + (size_t)m * DM) + F.lane;
        f32x4 tv[8]; float s = 0.f;
#pragma unroll
        for (int j = 0; j < 8; ++j) { tv[j] = tr[64 * j]; s += (tv[j].x * tv[j].x + tv[j].y * tv[j].y) + (tv[j].z * tv[j].z + tv[j].w * tv[j].w); }
        const float r = 1.0f / sqrtf(wave_sum(s) * (1.0f / DM) + EPS);
        float s2 = 0.f;
#pragma unroll
        for (int j = 0; j < 8; ++j) { const f32x4 xv = xw[64 * j], gv = gr[64 * j]; tv[j] = xv + tv[j] * r * gv; s2 += (tv[j].x * tv[j].x + tv[j].y * tv[j].y) + (tv[j].z * tv[j].z + tv[j].w * tv[j].w); }
        s2 = wave_sum(s2);
#pragma unroll
        for (int j = 0; j < 8; ++j) { xw[64 * j] = tv[j]; v2u w; w.x = pk2(tv[j].x, tv[j].y); w.y = pk2(tv[j].z, tv[j].w); xo[64 * j] = w; }
        if (F.lane == 0) F_WS(float, WS_RS)[m] = 1.0f / sqrtf(s2 * (1.0f / DM) + EPS);
    }
}


typedef short s16x4 __attribute__((ext_vector_type(4)));
typedef short v4i16_t __attribute__((ext_vector_type(4)));
typedef LAS const char* lds_cptr;
#define MFMA16(a, b, c) __builtin_amdgcn_mfma_f32_16x16x32_bf16((a), (b), (c), 0, 0, 0)
__device__ __forceinline__ unsigned off_b(unsigned row, unsigned ch) { return 256u * row + 16u * (ch ^ (((row & 3u) << 2) | ((row >> 2) & 3u))); }
__device__ __forceinline__ unsigned tr_addr16(unsigned lane, unsigned c, unsigned ks, unsigned t) {
    const unsigned g = lane >> 4, q = (lane & 15u) >> 2, p = lane & 3u;
    return off_b(32u * ks + 8u * g + 4u * t + q, 2u * c + (p >> 1)) + 8u * (p & 1u);
}
__device__ __forceinline__ s16x4 vtr(lds_cptr p) { return __builtin_bit_cast(s16x4, __builtin_amdgcn_ds_read_tr16_b64_v4i16((LAS v4i16_t*)p)); }
__device__ __forceinline__ unsigned cvtpk(float lo, float hi) { unsigned r; asm volatile("v_cvt_pk_bf16_f32 %0, %1, %2" : "=v"(r) : "v"(lo), "v"(hi)); return r; }

constexpr int LDS_X_OFF = 132096;
constexpr int ATT_UNITS = 1536;

struct AttnU { int pi, n, h, r, b, d; };
__device__ __forceinline__ AttnU attn_decode(int unit) {
    AttnU a; a.pi = unit >> 9; const int r2 = unit & 511; a.n = r2 >> 8; a.h = (r2 >> 5) & 7; const int rb = r2 & 31;
    const int dsh = 2 * a.pi, nbs = 5 - dsh; a.d = 1 << dsh;
    a.r = rb >> nbs; a.b = rb & ((1 << nbs) - 1); return a;
}
__device__ __forceinline__ void attn_stage_load(unsigned char* ws, int unit, int tid, v4u (&kv)[8], v4u (&vv)[8]) {
    const AttnU a = attn_decode(unit);
    const bf16* Kg = (const bf16*)(ws + WS_K); const bf16* Vg = (const bf16*)(ws + WS_V);
    const int ch = tid & 15, jr = tid >> 4;
#pragma unroll
    for (int p = 0; p < 8; ++p) { const int j = p * 32 + jr; const int tk = a.r + a.d * (128 * (a.b - 1) + j);
        if (tk >= 0) { const size_t off = ((size_t)(a.n * SEQ + tk)) * AW + a.h * 128 + ch * 8; kv[p] = *(const v4u*)(Kg + off); vv[p] = *(const v4u*)(Vg + off); }
        else { kv[p] = (v4u){0u, 0u, 0u, 0u}; vv[p] = (v4u){0u, 0u, 0u, 0u}; } }
}
__device__ __forceinline__ void attn_compute(LAS unsigned char* lds, unsigned char* ws, int unit, int tid);
__device__ __forceinline__ void attn_units(LAS unsigned char* lds, unsigned char* ws, int first, int stride, int tid) {
    if (first >= ATT_UNITS) return;
    LAS unsigned char* Kimg = lds; LAS unsigned char* Vimg = lds + 65536; LAS float* btab = (LAS float*)(lds + LDS_X_OFF);
    v4u kv[8], vv[8];
    int u = first;
    attn_stage_load(ws, u, tid, kv, vv);
    for (;;) {
        { const int ch = tid & 15, jr = tid >> 4;
#pragma unroll
          for (int p = 0; p < 8; ++p) { const int j = p * 32 + jr; const unsigned o = off_b(j, ch); *(LAS v4u*)(Kimg + o) = kv[p]; *(LAS v4u*)(Vimg + o) = vv[p]; }
          const AttnU a = attn_decode(u);
          if (tid < 129) btab[tid] = ((const float*)(ws + WS_BIAS))[(a.pi * 8 + a.h) * 129 + tid]; }
        __syncthreads();
        const int un = u + stride; const bool more = un < ATT_UNITS;
        if (more) attn_stage_load(ws, un, tid, kv, vv);
        attn_compute(lds, ws, u, tid);
        __syncthreads();
        if (!more) break;
        u = un;
    }
}
__device__ __forceinline__ void attn_compute(LAS unsigned char* lds, unsigned char* ws, int unit, int tid) {
    const int lane = tid & 63, w = __builtin_amdgcn_readfirstlane(tid >> 6);
    const AttnU a_ = attn_decode(unit); const int pi = a_.pi, n = a_.n, h = a_.h, r = a_.r, b = a_.b, d = a_.d;
    const bf16* Qg = (const bf16*)(ws + WS_Q);
    LAS unsigned char* Kimg = lds; LAS unsigned char* Vimg = lds + 65536; LAS float* btab = (LAS float*)(lds + LDS_X_OFF);
    const int q = lane & 15, g4 = lane >> 4, qi = 16 * w + q;
    const int rowq = n * SEQ + r + d * (128 * b + qi);
    bf16x8 qf[4];
#pragma unroll
    for (int s = 0; s < 4; ++s) qf[s] = *(const bf16x8*)(Qg + (size_t)rowq * AW + h * 128 + 32 * s + 8 * g4);
    const int ks0 = w >> 1;
    f32x4 sacc[5][2];
    {
        const int rr = lane & 15;
#pragma unroll
        for (int kb = 0; kb < 5; ++kb)
#pragma unroll
            for (int t = 0; t < 2; ++t) {
                const int j = 32 * (ks0 + kb) + 8 * (rr >> 2) + 4 * t + (rr & 3);
                f32x4 acc = (f32x4){0.f, 0.f, 0.f, 0.f};
#pragma unroll
                for (int s = 0; s < 4; ++s) { const bf16x8 kf = *(const LAS bf16x8*)(Kimg + off_b(j, 4 * s + g4)); acc = MFMA16(kf, qf[s], acc); }
                sacc[kb][t] = acc;
            }
    }
    float mx = -3.0e38f;
#pragma unroll
    for (int kb = 0; kb < 5; ++kb)
#pragma unroll
        for (int t = 0; t < 2; ++t)
#pragma unroll
            for (int i = 0; i < 4; ++i) {
                const int j = 32 * (ks0 + kb) + 8 * g4 + 4 * t + i; const int delta = 128 + qi - j;
                const bool valid = (delta >= 0) && (delta <= 128) && (b > 0 || j >= 128);
                const int dc = delta < 0 ? 0 : (delta > 128 ? 128 : delta);
                const float sv = valid ? sacc[kb][t][i] + btab[dc] : -1.0e30f;
                sacc[kb][t][i] = sv; mx = fmaxf(mx, sv);
            }
    mx = fmaxf(mx, __shfl_xor(mx, 16)); mx = fmaxf(mx, __shfl_xor(mx, 32));
    float ls = 0.f;
    bf16x8 pf[5];
#pragma unroll
    for (int kb = 0; kb < 5; ++kb) {
        float p[8];
#pragma unroll
        for (int t = 0; t < 2; ++t)
#pragma unroll
            for (int i = 0; i < 4; ++i) { p[4 * t + i] = __builtin_amdgcn_exp2f(sacc[kb][t][i] - mx); ls += p[4 * t + i]; }
        v4u pk; pk.x = cvtpk(p[0], p[1]); pk.y = cvtpk(p[2], p[3]); pk.z = cvtpk(p[4], p[5]); pk.w = cvtpk(p[6], p[7]);
        pf[kb] = __builtin_bit_cast(bf16x8, pk);
    }
    ls += __shfl_xor(ls, 16); ls += __shfl_xor(ls, 32);
    const float inv = 1.0f / ls;
    bf16* Og = (bf16*)(ws + WS_OBUF) + ((size_t)pi * MP + rowq) * AW + h * 128;
#pragma unroll
    for (int c = 0; c < 8; ++c) {
        f32x4 oacc = (f32x4){0.f, 0.f, 0.f, 0.f};
#pragma unroll
        for (int kb = 0; kb < 5; ++kb) {
            const s16x4 lo = vtr((lds_cptr)(Vimg + tr_addr16(lane, c, ks0 + kb, 0))), hi = vtr((lds_cptr)(Vimg + tr_addr16(lane, c, ks0 + kb, 1)));
            const bf16x8 vf = __builtin_shufflevector(lo, hi, 0, 1, 2, 3, 4, 5, 6, 7);
            oacc = MFMA16(vf, pf[kb], oacc);
        }
        v2u ow; ow.x = cvtpk(oacc[0] * inv, oacc[1] * inv); ow.y = cvtpk(oacc[2] * inv, oacc[3] * inv);
        *(v2u*)(Og + 16 * c + 4 * g4) = ow;
    }
    if (g4 == 0) ((float*)(ws + WS_LSE))[((size_t)pi * MP + rowq) * 8 + h] = mx + __builtin_amdgcn_logf(ls);
}

__device__ __forceinline__ void attn_sample_task(unsigned char* ws, const float* const* inp, float* out, int l, int task, int lane) {
    const int rs_ = task >> 3, h = task & 7, n = rs_ >> 3, t = rs_ & 7, row = MP + rs_;
    const unsigned qw = ((const unsigned*)((const bf16*)(ws + WS_Q) + (size_t)row * AW + h * 128))[lane];
    const float q0 = bf_lo(qw), q1 = bf_hi(qw);
    float m = -3.0e38f, ls = 0.f, o0 = 0.f, o1 = 0.f;
#pragma nounroll
    for (int pi = 0; pi < 3; ++pi) {
        const int d = 1 << (2 * pi);
        const float* bt = (const float*)(ws + WS_BIAS) + (pi * 8 + h) * 129;
#pragma nounroll
        for (int jj = 0; jj <= 128; ++jj) {
            const int idx = 2048 + t - jj * d; const float *kp, *vp;
            if (idx < 2048) { const size_t off = ((((size_t)l * 8 + n) * 2048 + idx) * 8 + h) * 128; kp = inp[I_CK] + off; vp = inp[I_CV] + off; }
            else { const size_t off = (((size_t)l * 8 + n) * 8 + (idx - 2048)) * 1024 + h * 128; kp = out + O_NKS + off; vp = out + O_NVS + off; }
            const f32x2v kk = ((const f32x2v*)kp)[lane], vv = ((const f32x2v*)vp)[lane];
            const float s = wave_sum(q0 * kk.x + q1 * kk.y) + bt[jj];
            const float mn = fmaxf(m, s), al = exp2f(m - mn), p = exp2f(s - mn);
            ls = ls * al + p; o0 = o0 * al + p * vv.x; o1 = o1 * al + p * vv.y; m = mn;
        }
    }
    const float inv = 1.0f / ls; f32x2v ov; ov.x = o0 * inv; ov.y = o1 * inv;
    ((f32x2v*)((float*)(ws + WS_SATT) + (size_t)rs_ * AW + h * 128))[lane] = ov;
}

__device__ __forceinline__ void attn_combine_row(unsigned char* ws, const float* const* inp, int l, int row, int lane) {
    float o[16];
    if (row < MP) {
        const int h = lane >> 3; const float* L = (const float*)(ws + WS_LSE);
        const float l0 = L[((size_t)0 * MP + row) * 8 + h], l1 = L[((size_t)1 * MP + row) * 8 + h], l2 = L[((size_t)2 * MP + row) * 8 + h];
        const float mm = fmaxf(l0, fmaxf(l1, l2)); float w0 = exp2f(l0 - mm), w1 = exp2f(l1 - mm), w2 = exp2f(l2 - mm);
        const float is = 1.0f / (w0 + w1 + w2); w0 *= is; w1 *= is; w2 *= is;
        const bf16* O = (const bf16*)(ws + WS_OBUF);
#pragma unroll
        for (int half = 0; half < 2; ++half) {
            const v4u a = *(const v4u*)(O + ((size_t)0 * MP + row) * AW + 16 * lane + 8 * half), b = *(const v4u*)(O + ((size_t)1 * MP + row) * AW + 16 * lane + 8 * half),
                      c = *(const v4u*)(O + ((size_t)2 * MP + row) * AW + 16 * lane + 8 * half);
            o[8 * half + 0] = w0 * bf_lo(a.x) + w1 * bf_lo(b.x) + w2 * bf_lo(c.x); o[8 * half + 1] = w0 * bf_hi(a.x) + w1 * bf_hi(b.x) + w2 * bf_hi(c.x);
            o[8 * half + 2] = w0 * bf_lo(a.y) + w1 * bf_lo(b.y) + w2 * bf_lo(c.y); o[8 * half + 3] = w0 * bf_hi(a.y) + w1 * bf_hi(b.y) + w2 * bf_hi(c.y);
            o[8 * half + 4] = w0 * bf_lo(a.z) + w1 * bf_lo(b.z) + w2 * bf_lo(c.z); o[8 * half + 5] = w0 * bf_hi(a.z) + w1 * bf_hi(b.z) + w2 * bf_hi(c.z);
            o[8 * half + 6] = w0 * bf_lo(a.w) + w1 * bf_lo(b.w) + w2 * bf_lo(c.w); o[8 * half + 7] = w0 * bf_hi(a.w) + w1 * bf_hi(b.w) + w2 * bf_hi(c.w);
        }
    } else {
        const f32x4* S = (const f32x4*)((const float*)(ws + WS_SATT) + (size_t)(row - MP) * AW + 16 * lane);
#pragma unroll
        for (int k = 0; k < 4; ++k) { const f32x4 v = S[k]; o[4 * k] = v.x; o[4 * k + 1] = v.y; o[4 * k + 2] = v.z; o[4 * k + 3] = v.w; }
    }
    float ss = 0.f;
#pragma unroll
    for (int k = 0; k < 16; ++k) ss += o[k] * o[k];
    const float r = 1.0f / sqrtf(wave_sum(ss) * (1.0f / AW) + EPS);
    const f32x4* g = (const f32x4*)(inp[I_GMIXOUT] + l * DM + 16 * lane);
    v4u w0, w1; const f32x4 g0 = g[0], g1 = g[1], g2 = g[2], g3 = g[3];
    w0.x = pk2(o[0] * r * g0.x, o[1] * r * g0.y); w0.y = pk2(o[2] * r * g0.z, o[3] * r * g0.w); w0.z = pk2(o[4] * r * g1.x, o[5] * r * g1.y); w0.w = pk2(o[6] * r * g1.z, o[7] * r * g1.w);
    w1.x = pk2(o[8] * r * g2.x, o[9] * r * g2.y); w1.y = pk2(o[10] * r * g2.z, o[11] * r * g2.w); w1.z = pk2(o[12] * r * g3.x, o[13] * r * g3.y); w1.w = pk2(o[14] * r * g3.z, o[15] * r * g3.w);
    v4u* dst = (v4u*)((bf16*)(ws + WS_MIX) + (size_t)row * DM + 16 * lane); dst[0] = w0; dst[1] = w1;
}

constexpr int XW_STRIDE = 528, XW_BYTES = 16 * XW_STRIDE;
__device__ __forceinline__ void ssm_pass1_unit(LAS unsigned char* xw, unsigned char* ws, int l, int wu, int lane) {
    const int g = wu & 31, sc = (wu >> 5) & 15, n = wu >> 9, q = lane & 15, g4 = lane >> 4;
    const bf16* BB = (const bf16*)(ws + WS_BBF) + ((size_t)(l * 32 + g) * 8) * 512;
    bf16x8 bb[8];
#pragma unroll
    for (int mt = 0; mt < 8; ++mt) bb[mt] = *(const bf16x8*)(BB + (mt * 64 + lane) * 8);
    const float* ap = (const float*)(ws + WS_AP) + ((size_t)(l * 32 + g) * 64 + lane) * 8;
    const float are = ap[0], aim = ap[1];
    float hr = 0.f, hi_ = 0.f;
    const bf16* U = (const bf16*)(ws + WS_U); float* SL = (float*)(ws + WS_SLOC);
    const bf16* up = U + (size_t)(n * SEQ + sc * 256 + q) * SW + g * 16 + 8 * (g4 & 1);
    bf16x8 ufn = *(const bf16x8*)up;
#pragma nounroll
    for (int tt = 0; tt < 16; ++tt) {
        bf16x8 uf = ufn; if (g4 >= 2) uf = (bf16x8){0, 0, 0, 0, 0, 0, 0, 0};
        if (tt < 15) ufn = *(const bf16x8*)(up + (size_t)(tt + 1) * 16 * SW);
#pragma unroll
        for (int mt = 0; mt < 8; ++mt) { const f32x4 dd = MFMA16(bb[mt], uf, ((f32x4){0.f, 0.f, 0.f, 0.f})); *(LAS f32x4*)(xw + q * XW_STRIDE + (16 * mt + 4 * g4) * 4) = dd; }
        asm volatile("s_waitcnt lgkmcnt(0)" ::: "memory");
#pragma unroll
        for (int t = 0; t < 16; ++t) { const float xr = *(const LAS float*)(xw + t * XW_STRIDE + lane * 4), xi = *(const LAS float*)(xw + t * XW_STRIDE + 256 + lane * 4);
            const float nr = are * hr - aim * hi_ + xr, ni = are * hi_ + aim * hr + xi; hr = nr; hi_ = ni; }
        asm volatile("s_waitcnt lgkmcnt(0)" ::: "memory");
        if (tt & 1) { f32x2v e; e.x = hr; e.y = hi_; ((f32x2v*)SL)[((((size_t)n * 16 + sc) * 8 + (tt >> 1)) * 32 + g) * 64 + lane] = e; }
    }
}
constexpr int YB_OFF = 8 * XW_BYTES, YB_STRIDE = 1040, RED_OFF = YB_OFF + 32 * YB_STRIDE;
constexpr int SSM2_UNITS = 264;
__device__ __forceinline__ void ssm_pass2_unit(LAS unsigned char* lds, unsigned char* ws, const float* const* inp, float* out, int l, int unit, int tid) {
    const int lane = tid & 63, w = __builtin_amdgcn_readfirstlane(tid >> 6), q = lane & 15, g4 = lane >> 4;
    const bool samp = unit >= 256;
    const int n = samp ? unit - 256 : unit >> 7, c32 = unit & 127;
    const int row0 = samp ? MP + n * 8 : n * SEQ + c32 * 32, ntile = samp ? 1 : 2;
    LAS unsigned char* xw = lds + w * XW_BYTES; LAS unsigned char* ybuf = lds + YB_OFF; LAS float* red = (LAS float*)(lds + RED_OFF);
    const bf16* U = (const bf16*)(ws + WS_U); const f32x2v* SL = (const f32x2v*)(ws + WS_SLOC);
#pragma nounroll
    for (int gi = 0; gi < 4; ++gi) {
        const int g = 4 * w + gi;
        const bf16* BB = (const bf16*)(ws + WS_BBF) + ((size_t)(l * 32 + g) * 8) * 512; const bf16* CFp = (const bf16*)(ws + WS_CF) + ((size_t)(l * 32 + g) * 4) * 512;
        const float* ap = (const float*)(ws + WS_AP) + ((size_t)(l * 32 + g) * 64 + lane) * 8;
        const int sc = c32 >> 3, c2 = c32 & 7;
        const f32x4 ap0 = *(const f32x4*)ap; const f32x2v ap1 = *(const f32x2v*)(ap + 4);
        f32x2v es[15]; f32x2v e1 = (f32x2v){0.f, 0.f}; float hr = 0.f, hi_ = 0.f;
        if (!samp) {
#pragma unroll
            for (int s2 = 0; s2 < 15; ++s2) { es[s2] = (f32x2v){0.f, 0.f}; if (s2 < sc) es[s2] = SL[((((size_t)n * 16 + s2) * 8 + 7) * 32 + g) * 64 + lane]; }
            if (c2 > 0) e1 = SL[((((size_t)n * 16 + sc) * 8 + (c2 - 1)) * 32 + g) * 64 + lane];
        } else { hr = inp[I_SRE][(((size_t)l * 8 + n) * 32 + g) * 64 + lane]; hi_ = inp[I_SIM][(((size_t)l * 8 + n) * 32 + g) * 64 + lane]; }
        bf16x8 bb[8], cf[4];
#pragma unroll
        for (int mt = 0; mt < 8; ++mt) bb[mt] = *(const bf16x8*)(BB + (mt * 64 + lane) * 8);
#pragma unroll
        for (int ks = 0; ks < 4; ++ks) cf[ks] = *(const bf16x8*)(CFp + (ks * 64 + lane) * 8);
        bf16x8 uf2[2]; v2u uw2[2];
#pragma unroll
        for (int tt = 0; tt < 2; ++tt) { uf2[tt] = *(const bf16x8*)(U + (size_t)(row0 + tt * 16 + q) * SW + g * 16 + 8 * (g4 & 1)); uw2[tt] = *(const v2u*)(U + (size_t)(row0 + tt * 16 + q) * SW + 16 * g + 4 * g4); }
        const f32x4 dsk = *(const f32x4*)(inp[I_SSMD] + l * SW + 16 * g + 4 * g4);
        const float are = ap0.x, aim = ap0.y;
        if (!samp) {
            const float a32r = ap0.z, a32i = ap0.w, a256r = ap1.x, a256i = ap1.y;
#pragma unroll
            for (int s2 = 0; s2 < 15; ++s2) { if (s2 < sc) { const float nr = a256r * hr - a256i * hi_ + es[s2].x, ni = a256r * hi_ + a256i * hr + es[s2].y; hr = nr; hi_ = ni; } }
#pragma nounroll
            for (int k = 0; k < c2; ++k) { const float nr = a32r * hr - a32i * hi_, ni = a32r * hi_ + a32i * hr; hr = nr; hi_ = ni; }
            hr += e1.x; hi_ += e1.y;
        }
#pragma unroll
        for (int tt = 0; tt < 2; ++tt) {
            if (tt < ntile) {
            bf16x8 uf = uf2[tt]; if (g4 >= 2) uf = (bf16x8){0, 0, 0, 0, 0, 0, 0, 0};
#pragma unroll
            for (int mt = 0; mt < 8; ++mt) { const f32x4 dd = MFMA16(bb[mt], uf, ((f32x4){0.f, 0.f, 0.f, 0.f})); *(LAS f32x4*)(xw + q * XW_STRIDE + (16 * mt + 4 * g4) * 4) = dd; }
            asm volatile("s_waitcnt lgkmcnt(0)" ::: "memory");
#pragma unroll
            for (int t = 0; t < 16; ++t) { const float xr = *(const LAS float*)(xw + t * XW_STRIDE + lane * 4), xi = *(const LAS float*)(xw + t * XW_STRIDE + 256 + lane * 4);
                const float nr = are * hr - aim * hi_ + xr, ni = are * hi_ + aim * hr + xi; hr = nr; hi_ = ni;
                asm volatile("" ::: "memory");
                *(LAS bf16*)(xw + t * XW_STRIDE + lane * 2) = (bf16)f2bf(hr); *(LAS bf16*)(xw + t * XW_STRIDE + 128 + lane * 2) = (bf16)f2bf(hi_);
                if (samp && t == 7) { out[O_SRS + (((size_t)l * 8 + n) * 32 + g) * 64 + lane] = hr; out[O_SIS + (((size_t)l * 8 + n) * 32 + g) * 64 + lane] = hi_; } }
            asm volatile("s_waitcnt lgkmcnt(0)" ::: "memory");
            f32x4 yacc = (f32x4){0.f, 0.f, 0.f, 0.f};
#pragma unroll
            for (int ks = 0; ks < 4; ++ks) { const bf16x8 hf = *(const LAS bf16x8*)(xw + q * XW_STRIDE + (32 * ks + 8 * g4) * 2); yacc = MFMA16(cf[ks], hf, yacc); }
            const v2u uw = uw2[tt];
            const float y0 = yacc[0] + dsk.x * bf_lo(uw.x), y1 = yacc[1] + dsk.y * bf_hi(uw.x), y2 = yacc[2] + dsk.z * bf_lo(uw.y), y3 = yacc[3] + dsk.w * bf_hi(uw.y);
            v2u yw; yw.x = cvtpk(y0, y1); yw.y = cvtpk(y2, y3);
            *(LAS v2u*)(ybuf + (tt * 16 + q) * YB_STRIDE + (16 * g + 4 * g4) * 2) = yw;
            asm volatile("s_waitcnt lgkmcnt(0)" ::: "memory");
            }
        }
        if (!samp && c32 == 127) { out[O_SRP + (((size_t)l * 2 + n) * 32 + g) * 64 + lane] = hr; out[O_SIP + (((size_t)l * 2 + n) * 32 + g) * 64 + lane] = hi_; }
    }
    __syncthreads();
    f32x4 acc[2][4];
#pragma unroll
    for (int mt = 0; mt < 2; ++mt)
#pragma unroll
        for (int nt = 0; nt < 4; ++nt) acc[mt][nt] = (f32x4){0.f, 0.f, 0.f, 0.f};
    const bf16* Wg = (const bf16*)(ws + WS_WGLU) + (size_t)l * 512 * 512;
#pragma unroll 4
    for (int ks = 0; ks < 16; ++ks) {
        bf16x8 af[2];
#pragma unroll
        for (int mt = 0; mt < 2; ++mt) af[mt] = *(const LAS bf16x8*)(ybuf + (16 * mt + q) * YB_STRIDE + (32 * ks + 8 * g4) * 2);
#pragma unroll
        for (int nt = 0; nt < 4; ++nt) { const bf16x8 bfr = *(const bf16x8*)(Wg + (size_t)(64 * w + 16 * nt + q) * 512 + 32 * ks + 8 * g4);
#pragma unroll
            for (int mt = 0; mt < 2; ++mt) acc[mt][nt] = MFMA16(bfr, af[mt], acc[mt][nt]); }
    }
#pragma unroll
    for (int mt = 0; mt < 2; ++mt) { const int t = 16 * mt + q; float ss = 0.f;
#pragma unroll
        for (int nt = 0; nt < 4; ++nt) { const int n0 = 64 * w + 16 * nt + 4 * g4; const f32x4 bg = *(const f32x4*)(inp[I_BGLU] + l * SW + n0);
            const v2u yw = *(const LAS v2u*)(ybuf + t * YB_STRIDE + n0 * 2);
            f32x4 o; o.x = bf_lo(yw.x) * pg8::fast_sigmoid(acc[mt][nt].x + bg.x); o.y = bf_hi(yw.x) * pg8::fast_sigmoid(acc[mt][nt].y + bg.y);
            o.z = bf_lo(yw.y) * pg8::fast_sigmoid(acc[mt][nt].z + bg.z); o.w = bf_hi(yw.y) * pg8::fast_sigmoid(acc[mt][nt].w + bg.w);
            acc[mt][nt] = o; ss += (o.x * o.x + o.y * o.y) + (o.z * o.z + o.w * o.w); }
        ss += __shfl_xor(ss, 16); ss += __shfl_xor(ss, 32);
        if (g4 == 0) red[t * 8 + w] = ss; }
    __syncthreads();
#pragma unroll
    for (int mt = 0; mt < 2; ++mt) { const int t = 16 * mt + q; const LAS f32x4* rp = (const LAS f32x4*)(red + t * 8); const f32x4 r0 = rp[0], r1 = rp[1];
        const float r = 1.0f / sqrtf(((r0.x + r0.y) + (r0.z + r0.w) + (r1.x + r1.y) + (r1.z + r1.w)) * (1.0f / SW) + EPS);
        const bool valid = !samp || t < 8;
        if (valid) {
#pragma unroll
            for (int nt = 0; nt < 4; ++nt) { const int n0 = 64 * w + 16 * nt + 4 * g4; const f32x4 gg = *(const f32x4*)(inp[I_GMIXOUT] + l * DM + 1024 + n0);
                v2u ow; ow.x = cvtpk(acc[mt][nt].x * r * gg.x, acc[mt][nt].y * r * gg.y); ow.y = cvtpk(acc[mt][nt].z * r * gg.z, acc[mt][nt].w * r * gg.w);
                *(v2u*)((bf16*)(ws + WS_MIX) + (size_t)(row0 + t) * DM + 1024 + n0) = ow; } } }
    __syncthreads();
}

constexpr int SGU_UNITS = 72, SGU_RED_OFF = LDS_X_OFF + 1024;
__device__ __forceinline__ void sgu_unit(LAS unsigned char* lds, unsigned char* ws, const float* const* inp, float* out, int l, int unit, int tid) {
    const int lane = tid & 63, w = __builtin_amdgcn_readfirstlane(tid >> 6), q = lane & 15, g4 = lane >> 4;
    const bool samp = unit >= 64;
    const int row0 = samp ? MP + 8 * (unit - 64) : (unit >> 5) * SEQ + (unit & 31) * 128, nrows = samp ? 8 : 128;
    LAS float* red = (LAS float*)(lds + SGU_RED_OFF);
    {
        const bf16* GVg = (const bf16*)(ws + WS_GV); const f32x4* sgp = (const f32x4*)(inp[I_SGUG] + l * GW + 8 * lane); const f32x4 sg0 = sgp[0], sg1 = sgp[1];
#pragma unroll 4
        for (int k = 0; k < 16; ++k) { const int s = w + 8 * k; v4u pk = (v4u){0u, 0u, 0u, 0u};
            if (s < nrows) { const v4u raw = *(const v4u*)(GVg + (size_t)(row0 + s) * GW + 8 * lane);
                float x[8] = {bf_lo(raw.x), bf_hi(raw.x), bf_lo(raw.y), bf_hi(raw.y), bf_lo(raw.z), bf_hi(raw.z), bf_lo(raw.w), bf_hi(raw.w)};
                float sm = 0.f;
#pragma unroll
                for (int j = 0; j < 8; ++j) sm += x[j];
                const float mean = wave_sum(sm) * (1.0f / GW); float qq = 0.f;
#pragma unroll
                for (int j = 0; j < 8; ++j) { x[j] -= mean; qq += x[j] * x[j]; }
                const float rstd = 1.0f / sqrtf(wave_sum(qq) * (1.0f / GW) + EPS);
                x[0] *= rstd * sg0.x; x[1] *= rstd * sg0.y; x[2] *= rstd * sg0.z; x[3] *= rstd * sg0.w; x[4] *= rstd * sg1.x; x[5] *= rstd * sg1.y; x[6] *= rstd * sg1.z; x[7] *= rstd * sg1.w;
                if (samp) { f32x4* od = (f32x4*)(out + O_SGV + ((size_t)l * 64 + (row0 + s - MP)) * GW + 8 * lane); od[0] = (f32x4){x[0], x[1], x[2], x[3]}; od[1] = (f32x4){x[4], x[5], x[6], x[7]}; }
                pk.x = pk2(x[0], x[1]); pk.y = pk2(x[2], x[3]); pk.z = pk2(x[4], x[5]); pk.w = pk2(x[6], x[7]); }
            *(LAS v4u*)(lds + (lane >> 4) * 32768 + off_b(s, lane & 15)) = pk; }
    }
    __syncthreads();
    const int hh = w >> 1, th = w & 1;
    LAS unsigned char* img = lds + hh * 32768;
    const bf16* Wm = (const bf16*)(ws + WS_WM) + ((size_t)(l * 4 + hh) * 128) * 128;
    const bf16* GUg = (const bf16*)(ws + WS_GU);
#pragma nounroll
    for (int mp = 0; mp < 2; ++mp) {
        f32x4 acc[2][8];
#pragma unroll
        for (int m2 = 0; m2 < 2; ++m2)
#pragma unroll
            for (int c = 0; c < 8; ++c) acc[m2][c] = (f32x4){0.f, 0.f, 0.f, 0.f};
#pragma nounroll
        for (int ks = 0; ks <= 2 * th + mp; ++ks) {
            bf16x8 gf[8];
#pragma unroll
            for (int c = 0; c < 8; ++c) { const s16x4 lo = vtr((lds_cptr)(img + tr_addr16(lane, c, ks, 0))), hi = vtr((lds_cptr)(img + tr_addr16(lane, c, ks, 1))); gf[c] = __builtin_shufflevector(lo, hi, 0, 1, 2, 3, 4, 5, 6, 7); }
#pragma unroll
            for (int m2 = 0; m2 < 2; ++m2) { const bf16x8 wf = *(const bf16x8*)(Wm + (size_t)(64 * th + 32 * mp + 16 * m2 + q) * 128 + 32 * ks + 8 * g4);
#pragma unroll
                for (int c = 0; c < 8; ++c) acc[m2][c] = MFMA16(gf[c], wf, acc[m2][c]); }
        }
#pragma unroll
        for (int m2 = 0; m2 < 2; ++m2) { const int tl = 64 * th + 32 * mp + 16 * m2 + q; const bool valid = tl < nrows; const float bias = inp[I_SGUB][((size_t)l * 4 + hh) * 128 + tl]; float ss = 0.f;
#pragma unroll
            for (int c = 0; c < 8; ++c) { v2u gw2 = (v2u){0u, 0u}; if (valid) gw2 = *(const v2u*)(GUg + (size_t)(row0 + tl) * GW + hh * 128 + 16 * c + 4 * g4);
                v2u ow; ow.x = cvtpk(bf_lo(gw2.x) * (acc[m2][c].x + bias), bf_hi(gw2.x) * (acc[m2][c].y + bias)); ow.y = cvtpk(bf_lo(gw2.y) * (acc[m2][c].z + bias), bf_hi(gw2.y) * (acc[m2][c].w + bias));
                const float o0 = bf_lo(ow.x), o1 = bf_hi(ow.x), o2 = bf_lo(ow.y), o3 = bf_hi(ow.y); ss += (o0 * o0 + o1 * o1) + (o2 * o2 + o3 * o3);
                if (valid) *(v2u*)((bf16*)(ws + WS_MIX) + (size_t)(row0 + tl) * DM + 1536 + hh * 128 + 16 * c + 4 * g4) = ow; }
            ss += __shfl_xor(ss, 16); ss += __shfl_xor(ss, 32);
            if (g4 == 0) red[tl * 4 + hh] = ss; }
    }
    __syncthreads();
#pragma nounroll
    for (int mt = 0; mt < 4; ++mt) { const int tl = 64 * th + 16 * mt + q; const f32x4 rr = *(const LAS f32x4*)(red + tl * 4);
        const float r = 1.0f / sqrtf(((rr.x + rr.y) + (rr.z + rr.w)) * (1.0f / GW) + EPS);
        if (tl < nrows) {
#pragma unroll
            for (int c = 0; c < 8; ++c) { const int ch = hh * 128 + 16 * c + 4 * g4; const f32x4 gg = *(const f32x4*)(inp[I_GMIXOUT] + l * DM + 1536 + ch);
                v2u* mp_ = (v2u*)((bf16*)(ws + WS_MIX) + (size_t)(row0 + tl) * DM + 1536 + ch); const v2u ow = *mp_;
                v2u nw; nw.x = cvtpk(bf_lo(ow.x) * r * gg.x, bf_hi(ow.x) * r * gg.y); nw.y = cvtpk(bf_lo(ow.y) * r * gg.z, bf_hi(ow.y) * r * gg.w); *mp_ = nw; } } }
    __syncthreads();
}

template <int K>
__device__ __forceinline__ void sample_gemm_n2048(LAS unsigned char* lds, const bf16* A  , const bf16* Wt  , float* T, int c, int tid) {
    const int lane = tid & 63, w = __builtin_amdgcn_readfirstlane(tid >> 6), q = lane & 15, g4 = lane >> 4;
    constexpr int KW = K / 8, NKS = KW / 32;
    const bf16* wp = Wt + (size_t)(8 * c + (q & 7)) * K + w * KW + 8 * g4;
    const bf16* ap = A + (size_t)q * K + w * KW + 8 * g4;
    f32x4 acc[4];
#pragma unroll
    for (int mt = 0; mt < 4; ++mt) acc[mt] = (f32x4){0.f, 0.f, 0.f, 0.f};
#pragma unroll 2
    for (int ks = 0; ks < NKS; ++ks) {
        const bf16x8 wf = *(const bf16x8*)(wp + 32 * ks);
#pragma unroll
        for (int mt = 0; mt < 4; ++mt) { const bf16x8 af = *(const bf16x8*)(ap + (size_t)(16 * mt) * K + 32 * ks); acc[mt] = MFMA16(wf, af, acc[mt]); }
    }
    LAS f32x4* part = (LAS f32x4*)lds;
#pragma unroll
    for (int mt = 0; mt < 4; ++mt) part[(w * 4 + mt) * 64 + lane] = acc[mt];
    __syncthreads();
    if (w < 4 && g4 < 2) { f32x4 s = part[(0 * 4 + w) * 64 + lane];
#pragma unroll
        for (int ww = 1; ww < 8; ++ww) s += part[(ww * 4 + w) * 64 + lane];
        *(f32x4*)(T + (size_t)(MP + 16 * w + q) * DM + 8 * c + 4 * g4) = s; }
    __syncthreads();
}

constexpr int SATT_LDS_PER_WAVE = 4096;
__device__ __forceinline__ const float* samp_row_ptr(const float* cache, const float* fresh, int l, int n, int t, int h, int kk) {
    const int pi = kk >= 258 ? 2 : (kk >= 129 ? 1 : 0), jj = kk - 129 * pi, idx = 2048 + t - (jj << (2 * pi));
    return (idx < 2048) ? cache + ((((size_t)l * 8 + n) * 2048 + idx) * 8 + h) * 128 : fresh + (((size_t)l * 8 + n) * 8 + (idx - 2048)) * 1024 + h * 128;
}
__device__ __forceinline__ void attn_sample_task2(LAS unsigned char* ldsw, unsigned char* ws, const float* const* inp, float* out, int l, int task, int lane) {
    const int rs_ = task >> 3, h = task & 7, n = rs_ >> 3, t = rs_ & 7, row = MP + rs_;
    const int kg = lane >> 4, e0 = 8 * (lane & 15);
    LAS float* sc = (LAS float*)ldsw;
    float qv[8];
    { const v4u qw = *(const v4u*)((const bf16*)(ws + WS_Q) + (size_t)row * AW + h * 128 + e0);
      qv[0] = bf_lo(qw.x); qv[1] = bf_hi(qw.x); qv[2] = bf_lo(qw.y); qv[3] = bf_hi(qw.y); qv[4] = bf_lo(qw.z); qv[5] = bf_hi(qw.z); qv[6] = bf_lo(qw.w); qv[7] = bf_hi(qw.w); }
    const float* ck = inp[I_CK]; const float* cv = inp[I_CV]; const float* fk = out + O_NKS; const float* fv = out + O_NVS;
    const float* bt = (const float*)(ws + WS_BIAS);
#pragma unroll 4
    for (int it = 0; it < 97; ++it) {
        const int kk = 4 * it + kg, kc = kk < 387 ? kk : 386;
        const f32x4* kp = (const f32x4*)(samp_row_ptr(ck, fk, l, n, t, h, kc) + e0);
        const f32x4 k0 = kp[0], k1 = kp[1];
        float dsum = (qv[0] * k0.x + qv[1] * k0.y) + (qv[2] * k0.z + qv[3] * k0.w) + (qv[4] * k1.x + qv[5] * k1.y) + (qv[6] * k1.z + qv[7] * k1.w);
        dsum += __shfl_xor(dsum, 1); dsum += __shfl_xor(dsum, 2); dsum += __shfl_xor(dsum, 4); dsum += __shfl_xor(dsum, 8);
        const int pi = kc >= 258 ? 2 : (kc >= 129 ? 1 : 0), jj = kc - 129 * pi;
        if ((lane & 15) == 0 && kk < 387) sc[kk] = dsum + bt[(pi * 8 + h) * 129 + jj];
    }
    asm volatile("s_waitcnt lgkmcnt(0)" ::: "memory");
    float sv[7]; float m = -3.0e38f;
#pragma unroll
    for (int c = 0; c < 7; ++c) { const int kk = lane + 64 * c; sv[c] = kk < 387 ? sc[kk] : -3.0e38f; m = fmaxf(m, sv[c]); }
#pragma unroll
    for (int o = 1; o < 64; o <<= 1) m = fmaxf(m, __shfl_xor(m, o));
    float ls = 0.f;
#pragma unroll
    for (int c = 0; c < 7; ++c) { const int kk = lane + 64 * c; const float p = kk < 387 ? __builtin_amdgcn_exp2f(sv[c] - m) : 0.f; ls += p; if (kk < 387) sc[kk] = p; }
    ls = wave_sum(ls);
    asm volatile("s_waitcnt lgkmcnt(0)" ::: "memory");
    float o[8];
#pragma unroll
    for (int j = 0; j < 8; ++j) o[j] = 0.f;
#pragma unroll 4
    for (int it = 0; it < 97; ++it) {
        const int kk = 4 * it + kg, kc = kk < 387 ? kk : 386;
        const f32x4* vp = (const f32x4*)(samp_row_ptr(cv, fv, l, n, t, h, kc) + e0);
        const f32x4 v0 = vp[0], v1 = vp[1]; const float p = kk < 387 ? sc[kc] : 0.f;
        o[0] += p * v0.x; o[1] += p * v0.y; o[2] += p * v0.z; o[3] += p * v0.w; o[4] += p * v1.x; o[5] += p * v1.y; o[6] += p * v1.z; o[7] += p * v1.w;
    }
    const float inv = 1.0f / ls;
#pragma unroll
    for (int j = 0; j < 8; ++j) { o[j] += __shfl_xor(o[j], 16); o[j] += __shfl_xor(o[j], 32); o[j] *= inv; }
    if (lane < 16) { f32x4* od = (f32x4*)((float*)(ws + WS_SATT) + (size_t)rs_ * AW + h * 128 + e0); od[0] = (f32x4){o[0], o[1], o[2], o[3]}; od[1] = (f32x4){o[4], o[5], o[6], o[7]}; }
}

__device__ __forceinline__ void attn_sample_wg(LAS unsigned char* lds, unsigned char* ws, const float* const* inp, float* out, int l, int task, int tid) {
    const int lane = tid & 63, w = __builtin_amdgcn_readfirstlane(tid >> 6);
    const int rs_ = task >> 3, h = task & 7, n = rs_ >> 3, t = rs_ & 7, row = MP + rs_;
    const int e0 = 8 * (lane & 15), grp = w * 4 + (lane >> 4);
    float qv[8];
    { const v4u qw = *(const v4u*)((const bf16*)(ws + WS_Q) + (size_t)row * AW + h * 128 + e0);
      qv[0] = bf_lo(qw.x); qv[1] = bf_hi(qw.x); qv[2] = bf_lo(qw.y); qv[3] = bf_hi(qw.y); qv[4] = bf_lo(qw.z); qv[5] = bf_hi(qw.z); qv[6] = bf_lo(qw.w); qv[7] = bf_hi(qw.w); }
    const float* ck = inp[I_CK]; const float* cv = inp[I_CV]; const float* fk = out + O_NKS; const float* fv = out + O_NVS;
    const float* bt = (const float*)(ws + WS_BIAS);
    float m = -3.0e38f, ls = 0.f, o[8];
#pragma unroll
    for (int j = 0; j < 8; ++j) o[j] = 0.f;
#pragma unroll 4
    for (int it = 0; it < 13; ++it) {
        const int kk = grp + 32 * it; const bool valid = kk < 387; const int kc = valid ? kk : 386;
        const f32x4* kp = (const f32x4*)(samp_row_ptr(ck, fk, l, n, t, h, kc) + e0); const f32x4* vp = (const f32x4*)(samp_row_ptr(cv, fv, l, n, t, h, kc) + e0);
        const f32x4 k0 = kp[0], k1 = kp[1], v0 = vp[0], v1 = vp[1];
        float dsum = (qv[0] * k0.x + qv[1] * k0.y) + (qv[2] * k0.z + qv[3] * k0.w) + (qv[4] * k1.x + qv[5] * k1.y) + (qv[6] * k1.z + qv[7] * k1.w);
        dsum += __shfl_xor(dsum, 1); dsum += __shfl_xor(dsum, 2); dsum += __shfl_xor(dsum, 4); dsum += __shfl_xor(dsum, 8);
        const int pi = kc >= 258 ? 2 : (kc >= 129 ? 1 : 0), jj = kc - 129 * pi;
        const float s = valid ? dsum + bt[(pi * 8 + h) * 129 + jj] : -3.0e38f;
        const float mn = fmaxf(m, s), al = __builtin_amdgcn_exp2f(m - mn), p = valid ? __builtin_amdgcn_exp2f(s - mn) : 0.f;
        ls = ls * al + p; m = mn;
        o[0] = o[0] * al + p * v0.x; o[1] = o[1] * al + p * v0.y; o[2] = o[2] * al + p * v0.z; o[3] = o[3] * al + p * v0.w;
        o[4] = o[4] * al + p * v1.x; o[5] = o[5] * al + p * v1.y; o[6] = o[6] * al + p * v1.z; o[7] = o[7] * al + p * v1.w;
    }
    LAS float* pml = (LAS float*)lds;
    LAS float* po = (LAS float*)(lds + 256);
    if ((lane & 15) == 0) { pml[2 * grp] = m; pml[2 * grp + 1] = ls; }
    { LAS f32x4* pd = (LAS f32x4*)(po + grp * 128 + e0); pd[0] = (f32x4){o[0], o[1], o[2], o[3]}; pd[1] = (f32x4){o[4], o[5], o[6], o[7]}; }
    __syncthreads();
    if (tid < 128) {
        float M = -3.0e38f;
#pragma unroll
        for (int i = 0; i < 32; ++i) M = fmaxf(M, pml[2 * i]);
        float L = 0.f, O = 0.f;
#pragma unroll
        for (int i = 0; i < 32; ++i) { const float sc = __builtin_amdgcn_exp2f(pml[2 * i] - M); L += pml[2 * i + 1] * sc; O += po[i * 128 + tid] * sc; }
        ((float*)(ws + WS_SATT))[(size_t)rs_ * AW + h * 128 + tid] = O / L;
    }
    __syncthreads();
}

__device__ __forceinline__ void attn_row_naive(Frame& F, int l, int row) {
    const int lane = F.lane; const bool samp = row >= MP;
    const int n = samp ? ((row - MP) >> 3) : (row >> 12), t = samp ? ((row - MP) & 7) : (row & 4095);
    float ssq = 0.f; float* tmp = F_WS(float, WS_T) + (size_t)row * DM;
#pragma nounroll
    for (int h = 0; h < 8; ++h) {
        const unsigned qw = ((const unsigned*)(F_WS(bf16, WS_Q) + (size_t)row * AW + h * 128))[lane];
        const float q0 = bf_lo(qw), q1 = bf_hi(qw);
        float m = -3.0e38f, ls = 0.f, o0 = 0.f, o1 = 0.f;
#pragma nounroll
        for (int pi = 0; pi < 3; ++pi) {
            const int d = pi == 0 ? 1 : (pi == 1 ? 4 : 16);
            const float* bt = F_WS(float, WS_BIAS) + (pi * 8 + h) * 129;
#pragma nounroll
            for (int jj = 0; jj <= 128; ++jj) {
                float k0, k1, v0, v1;
                if (!samp) { const int tk = t - jj * d; if (tk < 0) break;
                    const size_t off = ((size_t)(n * SEQ + tk)) * AW + h * 128;
                    const unsigned kw = ((const unsigned*)(F_WS(bf16, WS_K) + off))[lane], vw = ((const unsigned*)(F_WS(bf16, WS_V) + off))[lane];
                    k0 = bf_lo(kw); k1 = bf_hi(kw); v0 = bf_lo(vw); v1 = bf_hi(vw);
                } else { const int idx = 2048 + t - jj * d; const float *kp, *vp;
                    if (idx < 2048) { const size_t off = ((((size_t)l * 8 + n) * 2048 + idx) * 8 + h) * 128; kp = F_IN(I_CK) + off; vp = F_IN(I_CV) + off; }
                    else { const size_t off = (((size_t)l * 8 + n) * 8 + (idx - 2048)) * 1024 + h * 128; kp = F.out + O_NKS + off; vp = F.out + O_NVS + off; }
                    const f32x2v kk = ((const f32x2v*)kp)[lane], vv = ((const f32x2v*)vp)[lane]; k0 = kk.x; k1 = kk.y; v0 = vv.x; v1 = vv.y; }
                const float s = wave_sum(q0 * k0 + q1 * k1) + bt[jj];
                const float mn = fmaxf(m, s), al = exp2f(m - mn), p = exp2f(s - mn);
                ls = ls * al + p; o0 = o0 * al + p * v0; o1 = o1 * al + p * v1; m = mn;
            }
        }
        const float inv = 1.0f / ls; o0 *= inv; o1 *= inv; ssq += o0 * o0 + o1 * o1;
        f32x2v ov; ov.x = o0; ov.y = o1; ((f32x2v*)(tmp + h * 128))[lane] = ov;
    }
    const float r = 1.0f / sqrtf(wave_sum(ssq) * (1.0f / AW) + EPS);
    const float* g = F_IN(I_GMIXOUT) + l * DM;
#pragma nounroll
    for (int h = 0; h < 8; ++h) { const int col = h * 128 + 2 * lane; const f32x2v ov = ((const f32x2v*)(tmp + h * 128))[lane];
        ((unsigned*)(F_WS(bf16, WS_MIX) + (size_t)row * DM + col))[0] = pk2(ov.x * r * g[col], ov.y * r * g[col + 1]); }
}

__device__ __forceinline__ void ssm_seq_naive(Frame& F, int l, int seq, int g) {
    const int p = F.lane; const bool samp = seq >= 2; const int n = samp ? seq - 2 : seq;
    const int L = samp ? 8 : SEQ, row0 = samp ? MP + n * 8 : n * SEQ;
    const size_t gp = ((size_t)l * 32 + g) * 64 + p;
    const float lr = F_IN(I_LAMRE)[gp], li = F_IN(I_LAMIM)[gp], step = expf(F_IN(I_LOGSTEP)[l * 32 + g]);
    const float mag = expf(lr * step), are = mag * cosf(li * step), aim = mag * sinf(li * step);
    const float den = lr * lr + li * li, cre_ = ((are - 1.0f) * lr + aim * li) / den, cim_ = (aim * lr - (are - 1.0f) * li) / den;
    float bbr[16], bbi[16], ccr[16], cci[16];
#pragma unroll
    for (int c = 0; c < 16; ++c) { const float br = F_IN(I_BRE)[gp * 16 + c], bi = F_IN(I_BIM)[gp * 16 + c];
        bbr[c] = cre_ * br - cim_ * bi; bbi[c] = cre_ * bi + cim_ * br;
        ccr[c] = F_IN(I_CRE)[(((size_t)l * 32 + g) * 16 + c) * 64 + p]; cci[c] = F_IN(I_CIM)[(((size_t)l * 32 + g) * 16 + c) * 64 + p]; }
    float hr = 0.f, hi = 0.f;
    if (samp) { hr = F_IN(I_SRE)[(((size_t)l * 8 + n) * 32 + g) * 64 + p]; hi = F_IN(I_SIM)[(((size_t)l * 8 + n) * 32 + g) * 64 + p]; }
    const float dsk = (p < 16) ? F_IN(I_SSMD)[l * SW + g * 16 + p] : 0.f;
#pragma nounroll
    for (int t = 0; t < L; ++t) {
        const int row = row0 + t;
        const v4u ua = *(const v4u*)(F_WS(bf16, WS_U) + (size_t)row * SW + g * 16), ub = *(const v4u*)(F_WS(bf16, WS_U) + (size_t)row * SW + g * 16 + 8);
        float u[16];
        u[0] = bf_lo(ua.x); u[1] = bf_hi(ua.x); u[2] = bf_lo(ua.y); u[3] = bf_hi(ua.y); u[4] = bf_lo(ua.z); u[5] = bf_hi(ua.z); u[6] = bf_lo(ua.w); u[7] = bf_hi(ua.w);
        u[8] = bf_lo(ub.x); u[9] = bf_hi(ub.x); u[10] = bf_lo(ub.y); u[11] = bf_hi(ub.y); u[12] = bf_lo(ub.z); u[13] = bf_hi(ub.z); u[14] = bf_lo(ub.w); u[15] = bf_hi(ub.w);
        float xr = 0.f, xi = 0.f;
#pragma unroll
        for (int c = 0; c < 16; ++c) { xr += bbr[c] * u[c]; xi += bbi[c] * u[c]; }
        const float nhr = are * hr - aim * hi + xr, nhi = are * hi + aim * hr + xi; hr = nhr; hi = nhi;
        float ymine = 0.f;
#pragma unroll
        for (int c = 0; c < 16; ++c) { const float yc = wave_sum(ccr[c] * hr - cci[c] * hi) + 0.f; if (p == c) ymine = yc + dsk * u[c]; }
        if (p < 16) F_WS(float, WS_Y)[(size_t)row * SW + g * 16 + p] = ymine;
    }
    if (!samp) { F.out[O_SRP + (((size_t)l * 2 + n) * 32 + g) * 64 + p] = hr; F.out[O_SIP + (((size_t)l * 2 + n) * 32 + g) * 64 + p] = hi; }
    else { F.out[O_SRS + (((size_t)l * 8 + n) * 32 + g) * 64 + p] = hr; F.out[O_SIS + (((size_t)l * 8 + n) * 32 + g) * 64 + p] = hi; }
}

__device__ __forceinline__ void glu_row_naive(Frame& F, int l, int row) {
    const int lane = F.lane; const float* yrow = F_WS(float, WS_Y) + (size_t)row * SW; const float* W = F_IN(I_WGLU) + (size_t)l * SW * SW;
    float acc[8];
#pragma unroll
    for (int i = 0; i < 8; ++i) acc[i] = F_IN(I_BGLU)[l * SW + lane + 64 * i];
#pragma nounroll
    for (int k = 0; k < SW; ++k) { const float yk = yrow[k];
#pragma unroll
        for (int i = 0; i < 8; ++i) acc[i] += yk * W[(size_t)k * SW + lane + 64 * i]; }
    float o[8]; float ss = 0.f;
#pragma unroll
    for (int i = 0; i < 8; ++i) { o[i] = yrow[lane + 64 * i] * (1.0f / (1.0f + expf(-acc[i]))); ss += o[i] * o[i]; }
    const float r = 1.0f / sqrtf(wave_sum(ss) * (1.0f / SW) + EPS);
    const float* g = F_IN(I_GMIXOUT) + l * DM + 1024;
#pragma unroll
    for (int i = 0; i < 8; ++i) F_WS(bf16, WS_MIX)[(size_t)row * DM + 1024 + lane + 64 * i] = (bf16)f2bf(o[i] * r * g[lane + 64 * i]);
}

__device__ __forceinline__ void sgu_row_naive(Frame& F, int l, int row) {
    const int lane = F.lane; const bool samp = row >= MP;
    const int t = samp ? ((row - MP) & 7) : (row & 4095), tl = samp ? t : (t & 127), rowc = row - tl;
    float acc[8];
#pragma unroll
    for (int i = 0; i < 8; ++i) acc[i] = 0.f;
    const float* sg = F_IN(I_SGUG) + l * GW;
#pragma nounroll
    for (int sl = 0; sl <= tl; ++sl) {
        const int srow = rowc + sl; float xv[8]; float s = 0.f;
#pragma unroll
        for (int i = 0; i < 8; ++i) { xv[i] = bf2f(F_WS(bf16, WS_GV)[(size_t)srow * GW + lane + 64 * i]); s += xv[i]; }
        const float mean = wave_sum(s) * (1.0f / GW); float q = 0.f;
#pragma unroll
        for (int i = 0; i < 8; ++i) { xv[i] -= mean; q += xv[i] * xv[i]; }
        const float rstd = 1.0f / sqrtf(wave_sum(q) * (1.0f / GW) + EPS);
#pragma unroll
        for (int i = 0; i < 8; ++i) { const float gvv = xv[i] * rstd * sg[lane + 64 * i];
            const float w = F_IN(I_SGUW)[(((size_t)l * 4 + (i >> 1)) * 128 + tl) * 128 + sl];
            acc[i] += w * gvv;
            if (samp && sl == tl) F.out[O_SGV + ((size_t)l * 64 + (row - MP)) * GW + lane + 64 * i] = gvv; }
    }
    float o[8]; float ss = 0.f;
#pragma unroll
    for (int i = 0; i < 8; ++i) { const float mixed = acc[i] + F_IN(I_SGUB)[((size_t)l * 4 + (i >> 1)) * 128 + tl];
        o[i] = bf2f(F_WS(bf16, WS_GU)[(size_t)row * GW + lane + 64 * i]) * mixed; ss += o[i] * o[i]; }
    const float r = 1.0f / sqrtf(wave_sum(ss) * (1.0f / GW) + EPS);
    const float* g = F_IN(I_GMIXOUT) + l * DM + 1536;
#pragma unroll
    for (int i = 0; i < 8; ++i) F_WS(bf16, WS_MIX)[(size_t)row * DM + 1536 + lane + 64 * i] = (bf16)f2bf(o[i] * r * g[lane + 64 * i]);
}

struct ArgsN { const float* in[30]; float* out; unsigned char* ws; int l, pad; };
__global__ void __launch_bounds__(512) k_p2_naive(ArgsN a) {
    const int l = a.l, lane = threadIdx.x & 63, gw = blockIdx.x * 8 + (threadIdx.x >> 6), NGW = gridDim.x * 8; const float* const* inp = a.in; float* out = a.out; unsigned char* ws = a.ws;
    Frame F; F.lds = nullptr; F.MISC = nullptr; F.ctl = nullptr; F.tid = 0; F.lane = lane; F.wave = 0; F.vcu = 0; F.G = 0; F.inp = inp; F.out = out; F.ws = ws;
#if !FAST_SSM
    for (int k = gw; k < 320 * 6; k += NGW) if (k % 6 == 0) { const int task = k / 6; ssm_seq_naive(F, l, task / 32, task % 32); }
#endif
#if !FAST_ATTN
    for (int row = gw; row < MREAL; row += NGW) attn_row_naive(F, l, row);
#endif
#if !FAST_SGU
    for (int row = gw; row < MREAL; row += NGW) sgu_row_naive(F, l, row);
#endif
}
__global__ void __launch_bounds__(512, 2) k_p2_fast(ArgsN a) {
    extern __shared__ __attribute__((aligned(16))) unsigned char ldsf[];
    const int tid = threadIdx.x, lane = tid & 63, gw = blockIdx.x * 8 + (tid >> 6), NGW = gridDim.x * 8; (void)lane; (void)gw; (void)NGW;
#if FAST_ATTN
    attn_units((LAS unsigned char*)ldsf, a.ws, blockIdx.x, gridDim.x, tid);
    for (int task = gw; task < 512; task += NGW) attn_sample_task(a.ws, a.in, a.out, a.l, task, lane);
#endif
#if FAST_SGU
    __syncthreads();
    for (int u = blockIdx.x; u < SGU_UNITS; u += gridDim.x) sgu_unit((LAS unsigned char*)ldsf, a.ws, a.in, a.out, a.l, u, tid);
#endif
#if FAST_SSM
    __syncthreads();
    for (int wu = gw; wu < 1024; wu += NGW) ssm_pass1_unit((LAS unsigned char*)ldsf + (tid >> 6) * XW_BYTES, a.ws, a.l, wu, lane);
#endif
}
__global__ void __launch_bounds__(512, 2) k_p3_fast(ArgsN a) {
    extern __shared__ __attribute__((aligned(16))) unsigned char ldsf[];
    const int tid = threadIdx.x, lane = tid & 63, gw = blockIdx.x * 8 + (tid >> 6), NGW = gridDim.x * 8; (void)lane; (void)gw; (void)NGW;
#if FAST_ATTN
    for (int row = gw; row < MREAL; row += NGW) attn_combine_row(a.ws, a.in, a.l, row, lane);
#endif
#if FAST_SSM
    __syncthreads();
    for (int u = blockIdx.x; u < SSM2_UNITS; u += gridDim.x) ssm_pass2_unit((LAS unsigned char*)ldsf, a.ws, a.in, a.out, a.l, u, tid);
#endif
}
__global__ void __launch_bounds__(512) k_p3_naive(ArgsN a) {
    const int l = a.l, lane = threadIdx.x & 63, gw = blockIdx.x * 8 + (threadIdx.x >> 6), NGW = gridDim.x * 8; const float* const* inp = a.in; float* out = a.out; unsigned char* ws = a.ws;
    Frame F; F.lds = nullptr; F.MISC = nullptr; F.ctl = nullptr; F.tid = 0; F.lane = lane; F.wave = 0; F.vcu = 0; F.G = 0; F.inp = inp; F.out = out; F.ws = ws;
#if !FAST_SSM
    for (int row = gw; row < MREAL; row += NGW) glu_row_naive(F, l, row);
#endif
}

struct Args { const float* in[30]; float* out; unsigned char* ws; int ph_lo, ph_hi, li, pad; };
__global__ void __launch_bounds__(NWAVES * 64, 2) fwd(Args args) {
    extern __shared__ __attribute__((aligned(16))) unsigned char lds[];
    Frame F;
    F.lds = (LAS unsigned char*)lds;
    F.MISC = (volatile LAS unsigned*)(F.lds + MISC_OFF);
    F.tid = threadIdx.x; F.lane = F.tid & 63; F.wave = __builtin_amdgcn_readfirstlane(F.tid >> 6);
    F.G = gridDim.x; { const int bx = blockIdx.x; F.vcu = (F.G % 8 == 0) ? (bx % 8) * (F.G / 8) + bx / 8 : bx; }
    unsigned char* ws = args.ws;
    F.ctl = (gu32*)(ws + WS_CTL);
    F.inp = args.in; F.out = args.out; F.ws = ws;
    for (int u = F.tid; u < (LDS_BYTES - LDSCTL_OFF) / 4; u += NWAVES * 64) ((LAS unsigned*)(F.lds + LDSCTL_OFF))[u] = 0u;
    __syncthreads();
    XcdBarrier bar; bar.bar = (unsigned*)(F.ctl + CW_BAR); bar.x = 0; bar.st = nullptr;
    if (!MK_PER_PHASE) bar = xcd_barrier_post((unsigned*)(F.ctl + CW_BAR), F.MISC + 8);
#define GRID_BAR() do { if (!MK_PER_PHASE) xcd_barrier(bar); } while (0)
    const int lo = args.ph_lo, hi = args.ph_hi;
#define IN(k) (lo <= (k) && (k) < hi)
#define BOTH(k) (IN(k) && IN((k) + 1))
    const int gw = F.vcu * NWAVES + F.wave, NGW = F.G * NWAVES;

    if (IN(0)) { p0_prologue(F); if (BOTH(0)) GRID_BAR(); }

    for (int l = 0; l < DEPTH; ++l) {
        const int pb = 1 + 8 * l;
        if (IN(pb + 0)) {
            pg8::Gemm g{F_WS(bf16, WS_XN), F_WS(bf16, WS_WIN) + (size_t)l * INC * DM, MTOT, INC, DM}; pg8::StaticOrder S; S.init(MTOT, INC, F.G, (int)blockIdx.x);
            pg8::EpiIn E{F.ws, F.out, l};
            pg8::gemm_phase<pg8::EpiIn, pg8::StaticOrder, true, true>(F.lds + RING_OFF, g, S, E);
            if (BOTH(pb + 0)) GRID_BAR();
        }
        if (IN(pb + 1)) {
#if MK_FUSED_MIXERS
            { int tl_ = threadIdx.x; asm volatile("" : "+v"(tl_));
              const int ln_ = tl_ & 63;
              attn_units(F.lds, F.ws, (int)blockIdx.x, F.G, tl_);
              for (int u = (int)blockIdx.x; u < 512; u += F.G) attn_sample_wg(F.lds, F.ws, F.inp, F.out, l, u, tl_);
              if ((int)blockIdx.x >= 200 && (int)blockIdx.x < 208) ssm_pass2_unit(F.lds, F.ws, F.inp, F.out, l, 256 + ((int)blockIdx.x - 200), tl_);
              for (int u = (int)blockIdx.x; u < SGU_UNITS; u += F.G) sgu_unit(F.lds, F.ws, F.inp, F.out, l, u, tl_);
              for (int wu = ((int)blockIdx.x - SGU_UNITS) * NWAVES + (tl_ >> 6); wu >= 0 && wu < 1024; wu += (F.G - SGU_UNITS) * NWAVES) ssm_pass1_unit(F.lds + (tl_ >> 6) * XW_BYTES, F.ws, l, wu, ln_); }
#endif
            if (BOTH(pb + 1)) GRID_BAR();
        }
        if (IN(pb + 2)) {
#if MK_FUSED_MIXERS
            { int tl_ = threadIdx.x; asm volatile("" : "+v"(tl_));
              const int ln_ = tl_ & 63;
              for (int row = gw; row < MREAL; row += NGW) attn_combine_row(F.ws, F.inp, l, row, ln_);
              __syncthreads();
              for (int u = (int)blockIdx.x; u < 256; u += F.G) ssm_pass2_unit(F.lds, F.ws, F.inp, F.out, l, u, tl_); }
#endif
            if (BOTH(pb + 2)) GRID_BAR();
        }
        if (IN(pb + 3)) {
            { int tl_ = threadIdx.x; asm volatile("" : "+v"(tl_));
              for (int c = (int)blockIdx.x; c < 256; c += F.G) sample_gemm_n2048<DM>(F.lds, F_WS(bf16, WS_MIX) + (size_t)MP * DM, F_WS(bf16, WS_WOUT) + (size_t)l * DM * DM, F_WS(float, WS_T), c, tl_); }
            pg8::Gemm g{F_WS(bf16, WS_MIX), F_WS(bf16, WS_WOUT) + (size_t)l * DM * DM, MP, DM, DM}; pg8::StaticOrder S; S.init(MP, DM, F.G, (int)blockIdx.x);
            pg8::EpiF32 E{F_WS(float, WS_T), DM};
            pg8::gemm_phase<pg8::EpiF32, pg8::StaticOrder, true, true>(F.lds + RING_OFF, g, S, E);
            if (BOTH(pb + 3)) GRID_BAR();
        }
        if (IN(pb + 4)) { { Frame Fn = F; int ln_ = threadIdx.x & 63; asm volatile("" : "+v"(ln_)); Fn.lane = ln_; norm_rows(Fn, F_IN(I_GPOSTMIX) + l * DM); } if (BOTH(pb + 4)) GRID_BAR(); }
        if (IN(pb + 5)) {
            pg8::Gemm g{F_WS(bf16, WS_XN), F_WS(bf16, WS_WGU) + (size_t)l * FF2 * DM, MTOT, FF2, DM}; pg8::StaticOrder S; S.init(MTOT, FF2, F.G, (int)blockIdx.x);
            pg8::EpiGU E{F.ws};
            pg8::gemm_phase<pg8::EpiGU, pg8::StaticOrder, true, true>(F.lds + RING_OFF, g, S, E);
            if (BOTH(pb + 5)) GRID_BAR();
        }
        if (IN(pb + 6)) {
            { int tl_ = threadIdx.x; asm volatile("" : "+v"(tl_));
              for (int c = (int)blockIdx.x; c < 256; c += F.G) sample_gemm_n2048<FF>(F.lds, F_WS(bf16, WS_H) + (size_t)MP * FF, F_WS(bf16, WS_WDN) + (size_t)l * DM * FF, F_WS(float, WS_T), c, tl_); }
            pg8::Gemm g{F_WS(bf16, WS_H), F_WS(bf16, WS_WDN) + (size_t)l * DM * FF, MP, DM, FF}; pg8::StaticOrder S; S.init(MP, DM, F.G, (int)blockIdx.x);
            pg8::EpiF32 E{F_WS(float, WS_T), DM};
            pg8::gemm_phase<pg8::EpiF32, pg8::StaticOrder, true, true>(F.lds + RING_OFF, g, S, E);
            if (BOTH(pb + 6)) GRID_BAR();
        }
        if (IN(pb + 7)) { { Frame Fn = F; int ln_ = threadIdx.x & 63; asm volatile("" : "+v"(ln_)); Fn.lane = ln_; norm_rows(Fn, F_IN(I_GPOSTFFN) + l * DM); } if (BOTH(pb + 7)) GRID_BAR(); }
    }
#undef IN
#undef BOTH
}

extern "C" void kernel_launch(void* const* d_in, const int* in_sizes, int n_in, void* d_out, int out_size, void* d_ws, size_t ws_size, hipStream_t stream) {
    static int grid = 0;
    if (grid == 0) {
        if (n_in != 30 || out_size < (int)O_END || ws_size < WS_END) { fprintf(stderr, "kernel_launch: unexpected problem shape (n_in %d out %d ws %zu)\n", n_in, out_size, ws_size); grid = -1; return; }
        int dev = 0, cus = 0;
        if (hipGetDevice(&dev) != hipSuccess || hipDeviceGetAttribute(&cus, hipDeviceAttributeMultiprocessorCount, dev) != hipSuccess) { grid = -1; return; }
#if MK_PER_PHASE
        (void)hipFuncSetAttribute((const void*)k_p2_fast, hipFuncAttributeMaxDynamicSharedMemorySize, LDS_BYTES); (void)hipFuncSetAttribute((const void*)k_p3_fast, hipFuncAttributeMaxDynamicSharedMemorySize, LDS_BYTES);
#endif
        if (hipFuncSetAttribute((const void*)fwd, hipFuncAttributeMaxDynamicSharedMemorySize, LDS_BYTES) != hipSuccess) { fprintf(stderr, "kernel_launch: hipFuncSetAttribute failed\n"); grid = -1; return; }
        int per_cu = 0;
        if (hipOccupancyMaxActiveBlocksPerMultiprocessor(&per_cu, (const void*)fwd, NWAVES * 64, LDS_BYTES) != hipSuccess || per_cu < 1) { fprintf(stderr, "kernel_launch: occupancy query says %d\n", per_cu); }
        (void)hipGetLastError();
        grid = cus;
    }
    if (grid < 0) return;
    if (hipMemsetAsync((char*)d_ws + WS_CTL, 0, CTL_ZERO_BYTES, stream) != hipSuccess) return;
    Args a{};
    for (int i = 0; i < 30; ++i) a.in[i] = (const float*)d_in[i];
    a.out = (float*)d_out; a.ws = (unsigned char*)d_ws; a.li = 0; a.pad = 0;
#if MK_PER_PHASE
    ArgsN an{}; for (int i = 0; i < 30; ++i) an.in[i] = (const float*)d_in[i]; an.out = (float*)d_out; an.ws = (unsigned char*)d_ws;
    for (int p = 0; p < N_PHASES; ++p) {
        const int k = (p == 0) ? -1 : (p - 1) % 8, l = (p - 1) / 8;
        if (k == 1) { an.l = l; hipLaunchKernelGGL(k_p2_naive, dim3(256), dim3(512), 0, stream, an); hipLaunchKernelGGL(k_p2_fast, dim3(256), dim3(512), LDS_BYTES, stream, an); }
        else if (k == 2) { an.l = l; hipLaunchKernelGGL(k_p3_naive, dim3(256), dim3(512), 0, stream, an); hipLaunchKernelGGL(k_p3_fast, dim3(256), dim3(512), LDS_BYTES, stream, an); }
        else { a.ph_lo = p; a.ph_hi = p + 1; hipLaunchKernelGGL(fwd, dim3(grid), dim3(NWAVES * 64), LDS_BYTES, stream, a); }
    }
#else
#ifdef PROBE_DUP_PHASE
    { int cur = 0;
      auto launch = [&](int lo_, int hi_) { if (lo_ >= hi_) return; (void)hipMemsetAsync((char*)d_ws + WS_CTL, 0, CTL_ZERO_BYTES, stream); a.ph_lo = lo_; a.ph_hi = hi_; hipLaunchKernelGGL(fwd, dim3(grid), dim3(NWAVES * 64), LDS_BYTES, stream, a); };
      if (PROBE_DUP_PHASE == 0) { launch(0, 1); launch(0, 1); cur = 1; }
      else for (int l = 0; l < DEPTH; ++l) { const int p = 8 * l + PROBE_DUP_PHASE; launch(cur, p + 1); launch(p, p + 1); cur = p + 1; }
      launch(cur, N_PHASES); }
#else
    a.ph_lo = 0; a.ph_hi = N_PHASES;
    hipLaunchKernelGGL(fwd, dim3(grid), dim3(NWAVES * 64), LDS_BYTES, stream, a);
#endif
#endif
}
```
